# Optimizing an MI355X kernel written in HIP

```python
import math
import jax, jax.numpy as jnp
from jax import lax
import numpy as np

D_MODEL = 2048
BATCH = 1
SEQ = 16384
DEPTH = 4

N_META = 16
BLK = 128
WINDOW = 128
HA = 8
DHA = 64
HBQ = 16
HBKV = 2
DHB = 64
G_B = HBQ // HBKV
D_FF = 4 * D_MODEL
N_BUCKETS = 32
MAX_DIST = 128
EPS = 1e-6
NEG = -1e30

QA_W = HA * 2 * DHA
KA_W = HA * 2 * DHA
VA_W = HA * 2 * DHA
QB_W = HBQ * DHB
KB_W = HBKV * DHB
VB_W = HBKV * DHB
WA = VA_W
WB = QB_W
IN_W = QA_W + KA_W + VA_W + QB_W + KB_W + VB_W + 2 * D_MODEL
SPLITS = list(np.cumsum([QA_W, KA_W, VA_W, QB_W, KB_W, VB_W, D_MODEL]).tolist())
PAD_FRONT = BLK - N_META

kernel_name = "hybrid_diffattn_swa_sink_gated_block"


def rmsnorm(x, g):
    xf = x.astype(jnp.float32)
    y = xf * lax.rsqrt(jnp.mean(xf * xf, axis=-1, keepdims=True) + EPS)
    return (y * g.astype(jnp.float32)).astype(x.dtype)


def t5_bucket(dist):
    n = jnp.maximum(dist, 0)
    max_exact = N_BUCKETS // 2
    nf = jnp.maximum(n, 1).astype(jnp.float32)
    large = max_exact + (jnp.log(nf / max_exact) / math.log(MAX_DIST / max_exact)
                         * (N_BUCKETS - max_exact)).astype(jnp.int32)
    large = jnp.minimum(large, N_BUCKETS - 1)
    return jnp.where(n < max_exact, n, large)


def diff_attention(q, k, v, rel_a, lam, lam_init, sub_g):
    B, P = q.shape[0], q.shape[1]
    nb = P // BLK
    pos = jnp.arange(P) - PAD_FRONT
    key_ok = pos >= 0
    qb = q.reshape(B, nb, BLK, HA, 2, DHA).transpose(1, 0, 2, 3, 4, 5)
    scale = DHA ** -0.5

    def one_block(args):
        q_blk, n = args
        qpos = n * BLK + jnp.arange(BLK) - PAD_FRONT
        dist = qpos[:, None] - pos[None, :]
        bias = rel_a[t5_bucket(dist)].astype(jnp.float32)
        mask = (dist >= 0) & key_ok[None, :]
        s = jnp.einsum('bqhcd,bkhcd->bhcqk', q_blk, k).astype(jnp.float32) * scale
        s = s + bias.transpose(2, 0, 1)[None, :, None]
        s = jnp.where(mask, s, NEG)
        p = jax.nn.softmax(s, axis=-1)
        a = p[:, :, 0] - lam * p[:, :, 1]
        return jnp.einsum('bhqk,bkhv->bqhv', a.astype(v.dtype), v)

    o = lax.map(one_block, (qb, jnp.arange(nb)))
    o = o.transpose(1, 0, 2, 3, 4).reshape(B, P, HA, 2 * DHA)
    o = rmsnorm(o, sub_g) * (1.0 - lam_init)
    return o.reshape(B, P, HA * 2 * DHA)


def swa_sink_attention(q, k, v, rel_b, sinks):
    B, P = q.shape[0], q.shape[1]
    nb = P // BLK
    scale = DHB ** -0.5
    qb = q.reshape(B, nb, BLK, HBKV, G_B, DHB)

    def band(t):
        tb = t.reshape(B, nb, BLK, HBKV, DHB)
        prev = jnp.concatenate([jnp.zeros_like(tb[:, :1]), tb[:, :-1]], axis=1)
        return jnp.concatenate([prev, tb], axis=2)

    kb, vb = band(k), band(v)
    km = k[:, PAD_FRONT:BLK]
    vm = v[:, PAD_FRONT:BLK]

    i = jnp.arange(BLK)
    j = jnp.arange(2 * BLK)
    m = jnp.arange(N_META)
    blocks = jnp.arange(nb)
    qpos = blocks[:, None] * BLK + i[None, :] - PAD_FRONT
    dist = BLK + i[:, None] - j[None, :]
    kidx = blocks[:, None] * BLK - BLK + j[None, :]
    band_mask = ((dist >= 0) & (dist < WINDOW))[None] & (kidx >= BLK)[:, None, :]
    dist_m = qpos[:, :, None] - m[None, None, :]
    meta_mask = dist_m >= 0

    bias_band = rel_b[t5_bucket(dist)].astype(jnp.float32)
    bias_band = bias_band.reshape(BLK, 2 * BLK, HBKV, G_B).transpose(2, 3, 0, 1)
    bias_meta = rel_b[t5_bucket(dist_m)].astype(jnp.float32)
    bias_meta = bias_meta.reshape(nb, BLK, N_META, HBKV, G_B).transpose(0, 3, 4, 1, 2)

    s_band = jnp.einsum('bnqhgd,bnkhd->bnhgqk', qb, kb).astype(jnp.float32) * scale + bias_band[None, None]
    s_band = jnp.where(band_mask[None, :, None, None], s_band, NEG)
    s_meta = jnp.einsum('bnqhgd,bmhd->bnhgqm', qb, km).astype(jnp.float32) * scale + bias_meta[None]
    s_meta = jnp.where(meta_mask[None, :, None, None], s_meta, NEG)
    sink = jnp.broadcast_to(sinks.astype(jnp.float32).reshape(HBKV, G_B)[None, None, :, :, None, None],
                            s_band.shape[:-1] + (1,))
    p = jax.nn.softmax(jnp.concatenate([s_meta, s_band, sink], axis=-1), axis=-1)
    p_meta = p[..., :N_META].astype(v.dtype)
    p_band = p[..., N_META:N_META + 2 * BLK].astype(v.dtype)
    o = (jnp.einsum('bnhgqm,bmhd->bnqhgd', p_meta, vm)
         + jnp.einsum('bnhgqk,bnkhd->bnqhgd', p_band, vb))
    return o.reshape(B, P, HBQ * DHB)


def setup_inputs(seed: int = 0) -> dict:
    key = jax.random.key(seed)
    ks = jax.random.split(key, 20)
    f32 = jnp.float32

    def nrm(k, shape, scale):
        return jax.random.normal(k, shape, f32) * scale

    def gain(k, shape):
        return 1.0 + 0.05 * jax.random.normal(k, shape, f32)

    return {
        "x": nrm(ks[0], (BATCH, SEQ, D_MODEL), 1.0),
        "meta_tokens": nrm(ks[1], (N_META, D_MODEL), 1.0),
        "rel_bias": nrm(ks[2], (N_BUCKETS, HA + HBQ), 0.5),
        "w_in": nrm(ks[3], (DEPTH, D_MODEL, IN_W), D_MODEL ** -0.5),
        "w_branch_a": nrm(ks[4], (DEPTH, WA, D_MODEL), WA ** -0.5),
        "w_branch_b": nrm(ks[5], (DEPTH, WB, D_MODEL), WB ** -0.5),
        "w_out": nrm(ks[6], (DEPTH, D_MODEL, D_MODEL), D_MODEL ** -0.5),
        "lambda_q1": nrm(ks[7], (DEPTH, DHA), 0.1),
        "lambda_k1": nrm(ks[8], (DEPTH, DHA), 0.1),
        "lambda_q2": nrm(ks[9], (DEPTH, DHA), 0.1),
        "lambda_k2": nrm(ks[10], (DEPTH, DHA), 0.1),
        "diff_norm": gain(ks[11], (DEPTH, 2 * DHA)),
        "sinks": nrm(ks[12], (DEPTH, HBQ), 1.0),
        "norm_attn_pre": gain(ks[13], (DEPTH, D_MODEL)),
        "norm_attn_post": gain(ks[14], (DEPTH, D_MODEL)),
        "w_ff1": nrm(ks[15], (DEPTH, D_MODEL, D_FF), D_MODEL ** -0.5),
        "w_ff2": nrm(ks[16], (DEPTH, D_FF, D_MODEL), D_FF ** -0.5),
        "norm_ff_pre": gain(ks[17], (DEPTH, D_MODEL)),
        "norm_ff_post": gain(ks[18], (DEPTH, D_MODEL)),
    }


def reference(x, meta_tokens, rel_bias, w_in, w_branch_a, w_branch_b, w_out,
              lambda_q1, lambda_k1, lambda_q2, lambda_k2, diff_norm, sinks,
              norm_attn_pre, norm_attn_post, w_ff1, w_ff2, norm_ff_pre, norm_ff_post):
    B = x.shape[0]
    pad = jnp.zeros((B, PAD_FRONT, D_MODEL), x.dtype)
    meta = jnp.broadcast_to(meta_tokens[None].astype(x.dtype), (B, N_META, D_MODEL))
    h = jnp.concatenate([pad, meta, x], axis=1)
    P = h.shape[1]
    rel_a = rel_bias[:, :HA]
    rel_b = rel_bias[:, HA:HA + HBQ]
    for l in range(DEPTH):
        lam_init = 0.8 - 0.6 * math.exp(-0.3 * l)
        lam = (jnp.exp(jnp.sum(lambda_q1[l].astype(jnp.float32) * lambda_k1[l].astype(jnp.float32)))
               - jnp.exp(jnp.sum(lambda_q2[l].astype(jnp.float32) * lambda_k2[l].astype(jnp.float32)))
               + lam_init)
        u = rmsnorm(h, norm_attn_pre[l])
        z = u @ w_in[l]
        qa, ka, va, qb, kb, vb, ga, gb = jnp.split(z, SPLITS, axis=-1)
        ya = diff_attention(qa.reshape(B, P, HA, 2, DHA), ka.reshape(B, P, HA, 2, DHA),
                            va.reshape(B, P, HA, 2 * DHA), rel_a, lam, lam_init, diff_norm[l])
        yb = swa_sink_attention(qb.reshape(B, P, HBQ, DHB), kb.reshape(B, P, HBKV, DHB),
                                vb.reshape(B, P, HBKV, DHB), rel_b, sinks[l])
        mix = jax.nn.sigmoid(ga) * (ya @ w_branch_a[l]) + jax.nn.sigmoid(gb) * (yb @ w_branch_b[l])
        h = h + rmsnorm(mix @ w_out[l], norm_attn_post[l])
        u = rmsnorm(h, norm_ff_pre[l])
        f = jnp.square(jax.nn.relu(u @ w_ff1[l])) @ w_ff2[l]
        h = h + rmsnorm(f, norm_ff_post[l])
    return h[:, BLK:]
```

```cpp
#include <hip/hip_runtime.h>
#include <cstdio>
#include <cstdint>

#ifndef ATTN_NAIVE
#define ATTN_NAIVE 1
#endif
#ifndef ONE_LAUNCH
#define ONE_LAUNCH 0
#endif

constexpr int DM = 2048, SEQ = 16384, DEPTH = 4, NMETA = 16;
constexpr int MA = 16640;
constexpr int ROW_META = 16384, NROWS = 16400;
constexpr int INW = 8448, DFF = 8192;
constexpr int C_QA = 0, C_KA = 1024, C_VA = 2048, C_QB = 3072, C_KB = 4096, C_VB = 4224, C_GA = 4352, C_GB = 6400;
constexpr int NBUCK = 32, NBIAS = 24;
constexpr float EPS = 1e-6f, LOG2E = 1.4426950408889634f, QSCALE = 0.125f * 1.4426950408889634f, NEGBIG = -1e30f;

constexpr size_t MiB = 1u << 20;
constexpr size_t WS_CTL = 0, CTL_ZERO_BYTES = 1 * MiB;
constexpr size_t WS_HMETA = 2 * MiB;
constexpr size_t WS_WIN = 4 * MiB;
constexpr size_t WS_WA = 136 * MiB, WS_WB = 152 * MiB;
constexpr size_t WS_WOUT = 168 * MiB;
constexpr size_t WS_W1 = 200 * MiB;
constexpr size_t WS_W2 = 328 * MiB;
constexpr size_t WS_U = 456 * MiB;
constexpr size_t WS_YAB = 521 * MiB;
constexpr size_t WS_MIX = 586 * MiB;
constexpr size_t WS_T = 651 * MiB;
constexpr size_t WS_Z = 716 * MiB;
constexpr size_t WS_END = 985 * MiB;
static_assert(WS_Z + (size_t)MA * INW * 2 <= WS_END, "ws map");
constexpr int CW_TMO = 0, CW_BAR = 4096;

namespace pg8 {
#define PG8_LAS __attribute__((address_space(3)))
typedef unsigned short bf16_t;
typedef short bf16x8 __attribute__((ext_vector_type(8)));
typedef float f32x4 __attribute__((ext_vector_type(4)));
typedef unsigned u32x4 __attribute__((ext_vector_type(4)));
constexpr int BM = 256, BK = 64, HALF = 128, HTB = HALF * BK * 2  , STAGE_BYTES = 8 * HTB, NXCD = 8, WGM = 8;

__host__ __device__ __forceinline__ int lds_byte(int r, int c) { const int st = (r >> 4) * 2 + (c >> 5), rr = r & 15, cc = c & 31, ob = rr * 64 + cc * 2; return st * 1024 + (ob ^ (((ob >> 9) & 1) << 5)); }
__host__ __device__ __forceinline__ void stage_rc(int b, int& R, int& C) { const int st = b / 1024, sb = b % 1024, swz = sb ^ (((sb >> 9) & 1) << 5); R = (st >> 1) * 16 + swz / 64; C = (st & 1) * 32 + (swz % 64) / 2; }
__host__ __device__ __forceinline__ int perm32(int rho) { const int n = rho >> 4, i = rho & 15; return 8 * (i >> 2) + 4 * n + (i & 3); }

struct Unit { int pm, pn; };
struct Gemm { const bf16_t* A; const bf16_t* Bt; int M, N, K, lda, ldb; };

struct StaticOrder {
    int nM, nN, nwg, G, c;
    __host__ __device__ void init(int M, int N, int G_, int c_) { nM = M / BM; nN = N / BM; nwg = nM * nN; G = G_; c = c_; }
    __host__ __device__ bool next(int i, Unit& u) const {
        const long L = (long)i * G + c; if (L >= nwg) return false;
        int wgid = (int)L; { const int q = nwg / NXCD, r = nwg % NXCD, xcd = wgid % NXCD, off = wgid / NXCD; wgid = (xcd < r ? xcd * (q + 1) : r * (q + 1) + (xcd - r) * q) + off; }
        const int nig = WGM * nN, gid = wgid / nig, fm = gid * WGM, gsz = (nM - fm) < WGM ? (nM - fm) : WGM;
        u.pm = fm + ((wgid % nig) % gsz); u.pn = (wgid % nig) / gsz; return true;
    }
    __device__ __forceinline__ void a_ready(const Unit&) const {}
    __device__ __forceinline__ void done(const Unit&) const {}
};

__device__ __forceinline__ unsigned cvt_pk_bf16(float lo, float hi) { unsigned r; asm volatile("v_cvt_pk_bf16_f32 %0, %1, %2" : "=v"(r) : "v"(lo), "v"(hi)); return r; }
__device__ __forceinline__ float bf_lo(unsigned u) { return __builtin_bit_cast(float, u << 16); }
__device__ __forceinline__ float bf_hi(unsigned u) { return __builtin_bit_cast(float, u & 0xffff0000u); }
__device__ __forceinline__ float sigmoidf_fast(float x) { return __builtin_amdgcn_rcpf(1.0f + __builtin_amdgcn_exp2f(-x * 1.4426950408889634f)); }

struct EpiZ {
    static constexpr bool PERM = true, AFTER_DRAIN = false;
    bf16_t* O; int ldc;
    __device__ __forceinline__ void operator()(const f32x4 (&acc)[2][2][4][2], const Unit& u, int wr, int wc, int fr, int fq) const {
        const int row0 = u.pm * BM + wr * 64 + fr, col0 = u.pn * BM + wc * 32 + 8 * fq;
        const int mode = (u.pn < 4 || (u.pn >= 12 && u.pn < 16)) ? 1 : (u.pn >= 17 ? 2 : 0);
#pragma unroll
        for (int ai = 0; ai < 2; ++ai)
#pragma unroll
            for (int m = 0; m < 4; ++m) { bf16_t* rowp = O + (size_t)(row0 + ai * HALF + m * 16) * ldc + col0;
#pragma unroll
                for (int bj = 0; bj < 2; ++bj) { f32x4 v0 = acc[ai][bj][m][0], v1 = acc[ai][bj][m][1];
                    if (mode == 1) { v0 = v0 * QSCALE; v1 = v1 * QSCALE; }
                    else if (mode == 2) {
#pragma unroll
                        for (int e = 0; e < 4; ++e) { v0[e] = sigmoidf_fast(v0[e]); v1[e] = sigmoidf_fast(v1[e]); } }
                    u32x4 w; w.x = cvt_pk_bf16(v0[0], v0[1]); w.y = cvt_pk_bf16(v0[2], v0[3]); w.z = cvt_pk_bf16(v1[0], v1[1]); w.w = cvt_pk_bf16(v1[2], v1[3]);
                    *(u32x4*)(rowp + bj * HALF) = w; } }
    }
};
template <int ACT  > struct EpiBf16 {
    static constexpr bool PERM = true, AFTER_DRAIN = false;
    bf16_t* O; int ldc;
    __device__ __forceinline__ void operator()(const f32x4 (&acc)[2][2][4][2], const Unit& u, int wr, int wc, int fr, int fq) const {
        const int row0 = u.pm * BM + wr * 64 + fr, col0 = u.pn * BM + wc * 32 + 8 * fq;
#pragma unroll
        for (int ai = 0; ai < 2; ++ai)
#pragma unroll
            for (int m = 0; m < 4; ++m) { bf16_t* rowp = O + (size_t)(row0 + ai * HALF + m * 16) * ldc + col0;
#pragma unroll
                for (int bj = 0; bj < 2; ++bj) { f32x4 v0 = acc[ai][bj][m][0], v1 = acc[ai][bj][m][1];
                    if (ACT == 1) {
#pragma unroll
                        for (int e = 0; e < 4; ++e) { const float a = fmaxf(v0[e], 0.f), b = fmaxf(v1[e], 0.f); v0[e] = a * a; v1[e] = b * b; } }
                    u32x4 w; w.x = cvt_pk_bf16(v0[0], v0[1]); w.y = cvt_pk_bf16(v0[2], v0[3]); w.z = cvt_pk_bf16(v1[0], v1[1]); w.w = cvt_pk_bf16(v1[2], v1[3]);
                    *(u32x4*)(rowp + bj * HALF) = w; } }
    }
};
template <bool ADD_PREV> struct EpiGate {
    static constexpr bool PERM = true, AFTER_DRAIN = false;
    bf16_t* O; int ldc; const bf16_t* G; int ldg; const bf16_t* P;
    __device__ __forceinline__ void operator()(const f32x4 (&acc)[2][2][4][2], const Unit& u, int wr, int wc, int fr, int fq) const {
        const int row0 = u.pm * BM + wr * 64 + fr, col0 = u.pn * BM + wc * 32 + 8 * fq;
#pragma unroll
        for (int ai = 0; ai < 2; ++ai)
#pragma unroll
            for (int m = 0; m < 4; ++m) { const size_t r = (size_t)(row0 + ai * HALF + m * 16); bf16_t* rowp = O + r * ldc + col0; const bf16_t* gp = G + r * ldg + col0; const bf16_t* pp = P + r * ldc + col0;
#pragma unroll
                for (int bj = 0; bj < 2; ++bj) { f32x4 v0 = acc[ai][bj][m][0], v1 = acc[ai][bj][m][1];
                    const u32x4 g = *(const u32x4*)(gp + bj * HALF);
                    v0[0] *= bf_lo(g.x); v0[1] *= bf_hi(g.x); v0[2] *= bf_lo(g.y); v0[3] *= bf_hi(g.y); v1[0] *= bf_lo(g.z); v1[1] *= bf_hi(g.z); v1[2] *= bf_lo(g.w); v1[3] *= bf_hi(g.w);
                    if (ADD_PREV) { const u32x4 p = *(const u32x4*)(pp + bj * HALF);
                        v0[0] += bf_lo(p.x); v0[1] += bf_hi(p.x); v0[2] += bf_lo(p.y); v0[3] += bf_hi(p.y); v1[0] += bf_lo(p.z); v1[1] += bf_hi(p.z); v1[2] += bf_lo(p.w); v1[3] += bf_hi(p.w); }
                    u32x4 w; w.x = cvt_pk_bf16(v0[0], v0[1]); w.y = cvt_pk_bf16(v0[2], v0[3]); w.z = cvt_pk_bf16(v1[0], v1[1]); w.w = cvt_pk_bf16(v1[2], v1[3]);
                    *(u32x4*)(rowp + bj * HALF) = w; } }
    }
};

template <class Epi, class Sched, bool ALIGN_EPI>
__device__ __forceinline__ void gemm_phase(PG8_LAS unsigned char* lds, const Gemm g, const Sched& S, const Epi& E) {
    int tid_ = threadIdx.x; asm volatile("" : "+v"(tid_));
    const int tid = tid_, wid = __builtin_amdgcn_readfirstlane(tid >> 6), lane = tid & 63, wr = wid >> 2, wc = wid & 3, fr = lane & 15, fq = lane >> 4;
    const int K = g.K, nt = K / BK;
    unsigned voffA[2], voffB[2];
#pragma unroll
    for (int i = 0; i < 2; ++i) { int R, C; stage_rc(tid * 16 + i * 8192, R, C); const int Rb = Epi::PERM ? ((R & ~31) + perm32(R & 31)) : R;
        voffA[i] = (unsigned)(R * g.lda + C) * 2u; voffB[i] = (unsigned)(Rb * g.ldb + C) * 2u; }
    const size_t kstep = (size_t)(BK * 2);
    const size_t hstepA = (size_t)HALF * g.lda * 2, hstepB = (size_t)HALF * g.ldb * 2;
    const size_t tstepA = 2 * hstepA, tstepB = 2 * hstepB;
    const unsigned ldsw = (unsigned)wid * 1024u;
    const int aoff = lds_byte(wr * 64 + fr, fq * 8), boff = lds_byte(wc * 32 + fr, fq * 8);
#define PG8_SA(b, h) (((b) * 2 + (h)) * HTB)
#define PG8_SB(b, h) ((4 + (b) * 2 + (h)) * HTB)
#define PG8_STAGE(bufoff, gbase, voff) do { _Pragma("unroll") for (int _i = 0; _i < 2; ++_i) \
        __builtin_amdgcn_global_load_lds((const unsigned*)((const char*)(gbase) + (voff)[_i]), (PG8_LAS unsigned*)(lds + (bufoff) + ldsw + _i * 8192), 16, 0, 0); } while (0)
#define PG8_LDA(dst, b, h) do { _Pragma("unroll") for (int m = 0; m < 4; ++m) _Pragma("unroll") for (int k = 0; k < 2; ++k) dst[m][k] = *(const PG8_LAS bf16x8*)(lds + PG8_SA(b, h) + aoff + m * 2048 + k * 1024); } while (0)
#define PG8_LDB(dst, b, h) do { _Pragma("unroll") for (int n = 0; n < 2; ++n) _Pragma("unroll") for (int k = 0; k < 2; ++k) dst[n][k] = *(const PG8_LAS bf16x8*)(lds + PG8_SB(b, h) + boff + n * 2048 + k * 1024); } while (0)
#define PG8_MMA(ai, bj, At, Bt) do { __builtin_amdgcn_s_setprio(1); _Pragma("unroll") for (int m = 0; m < 4; ++m) _Pragma("unroll") for (int n = 0; n < 2; ++n) _Pragma("unroll") for (int k = 0; k < 2; ++k) \
        acc[ai][bj][m][n] = __builtin_amdgcn_mfma_f32_16x16x32_bf16(Bt[n][k], At[m][k], acc[ai][bj][m][n], 0, 0, 0); __builtin_amdgcn_s_setprio(0); } while (0)
#define PG8_WAIT_V(n) asm volatile("s_waitcnt vmcnt(" #n ")" ::: "memory")
#define PG8_WAIT_L(n) asm volatile("s_waitcnt lgkmcnt(" #n ")" ::: "memory")
#define PG8_BAR __builtin_amdgcn_s_barrier()
#define PG8_SCHED __builtin_amdgcn_sched_barrier(0)
    Unit cur, nxt; int ui = 0;
    if (!S.next(0, cur)) return;
    f32x4 acc[2][2][4][2];
#pragma unroll
    for (int a = 0; a < 2; ++a)
#pragma unroll
        for (int b = 0; b < 2; ++b)
#pragma unroll
            for (int m = 0; m < 4; ++m)
#pragma unroll
                for (int n = 0; n < 2; ++n) acc[a][b][m][n] = (f32x4){0.f, 0.f, 0.f, 0.f};
    bf16x8 At[4][2], B0[2][2], B1[2][2];
    const char* cA = (const char*)g.A + (size_t)cur.pm * tstepA; const char* cB = (const char*)g.Bt + (size_t)cur.pn * tstepB;
    S.a_ready(cur);
    PG8_STAGE(PG8_SB(0, 0), cB, voffB); PG8_STAGE(PG8_SB(0, 1), cB + hstepB, voffB); PG8_STAGE(PG8_SA(0, 0), cA, voffA); PG8_STAGE(PG8_SA(0, 1), cA + hstepA, voffA);
    if (wr == 1) PG8_BAR;
    PG8_WAIT_V(2); PG8_BAR;
    PG8_STAGE(PG8_SB(1, 0), cB + kstep, voffB); PG8_STAGE(PG8_SA(1, 0), cA + kstep, voffA); PG8_STAGE(PG8_SB(1, 1), cB + hstepB + kstep, voffB);
    PG8_WAIT_V(6); PG8_BAR;
    for (;;) {
        const bool has_next = S.next(ui + 1, nxt);
        const char* nA = has_next ? (const char*)g.A + (size_t)nxt.pm * tstepA : cA; const char* nB = has_next ? (const char*)g.Bt + (size_t)nxt.pn * tstepB : cB;
        for (int t = 0; t < nt; t += 2) {
            const bool last = (t == nt - 2);
            const char* a1 = cA + (size_t)(t + 1) * kstep;
            const char* a2 = last ? nA : cA + (size_t)(t + 2) * kstep; const char* b2 = last ? nB : cB + (size_t)(t + 2) * kstep;
            const char* a3 = a2 + kstep; const char* b3 = b2 + kstep;
            if (last && has_next) S.a_ready(nxt);
            PG8_LDB(B0, 0, 0); PG8_LDB(B1, 0, 1); PG8_SCHED; PG8_LDA(At, 0, 0); PG8_STAGE(PG8_SA(1, 1), a1 + hstepA, voffA);
            PG8_WAIT_V(8); PG8_WAIT_L(0); PG8_BAR; PG8_MMA(0, 0, At, B0); PG8_MMA(0, 1, At, B1); PG8_BAR; PG8_SCHED;
            PG8_LDA(At, 0, 1); PG8_STAGE(PG8_SB(0, 0), b2, voffB); PG8_STAGE(PG8_SB(0, 1), b2 + hstepB, voffB); PG8_STAGE(PG8_SA(0, 0), a2, voffA);
            PG8_WAIT_V(8); PG8_WAIT_L(0); PG8_BAR; PG8_MMA(1, 0, At, B0); PG8_MMA(1, 1, At, B1); PG8_BAR; PG8_SCHED;
            PG8_LDB(B0, 1, 0); PG8_LDB(B1, 1, 1); PG8_SCHED; PG8_LDA(At, 1, 0); PG8_STAGE(PG8_SA(0, 1), a2 + hstepA, voffA);
            PG8_WAIT_V(8); PG8_WAIT_L(0); PG8_BAR; PG8_MMA(0, 0, At, B0); PG8_MMA(0, 1, At, B1); PG8_BAR; PG8_SCHED;
            PG8_LDA(At, 1, 1); PG8_STAGE(PG8_SB(1, 0), b3, voffB); PG8_STAGE(PG8_SB(1, 1), b3 + hstepB, voffB); PG8_STAGE(PG8_SA(1, 0), a3, voffA);
            PG8_WAIT_V(8); PG8_WAIT_L(0); PG8_BAR; PG8_MMA(1, 0, At, B0); PG8_MMA(1, 1, At, B1); PG8_BAR; PG8_SCHED;
        }
        if constexpr (ALIGN_EPI) { if (wr == 0) PG8_BAR; }
        E(acc, cur, wr, wc, fr, fq); S.done(cur);
        if (!has_next) break;
#pragma unroll
        for (int a = 0; a < 2; ++a)
#pragma unroll
            for (int b = 0; b < 2; ++b)
#pragma unroll
                for (int m = 0; m < 4; ++m)
#pragma unroll
                    for (int n = 0; n < 2; ++n) acc[a][b][m][n] = (f32x4){0.f, 0.f, 0.f, 0.f};
        cur = nxt; cA = nA; cB = nB; ++ui;
        if constexpr (ALIGN_EPI) { if (wr == 1) PG8_BAR; }
    }
    PG8_WAIT_V(0);
    if constexpr (!ALIGN_EPI) { if (wr == 0) PG8_BAR; }
    PG8_BAR;
#undef PG8_SA
#undef PG8_SB
#undef PG8_STAGE
#undef PG8_LDA
#undef PG8_LDB
#undef PG8_MMA
#undef PG8_WAIT_V
#undef PG8_WAIT_L
#undef PG8_BAR
#undef PG8_SCHED
}
}
#define GAS __attribute__((address_space(1)))
#define LAS __attribute__((address_space(3)))
typedef unsigned short bf16;
typedef unsigned v4u __attribute__((ext_vector_type(4)));
typedef float f32x4 __attribute__((ext_vector_type(4)));
typedef short bf16x8 __attribute__((ext_vector_type(8)));
typedef GAS unsigned gu32;
typedef GAS unsigned long long gu64;
#define RLX_AGENT __ATOMIC_RELAXED, __HIP_MEMORY_SCOPE_AGENT
#define LDS_WAIT() asm volatile("s_waitcnt lgkmcnt(0)" ::: "memory")
#define VM_WAIT() asm volatile("s_waitcnt vmcnt(0)" ::: "memory")
__device__ __forceinline__ unsigned long long rt() { return __builtin_amdgcn_s_memrealtime(); }
__device__ __forceinline__ unsigned f2bf(float f) { unsigned u = __builtin_bit_cast(unsigned, f); return (u + 0x7fffu + ((u >> 16) & 1u)) >> 16; }
__device__ __forceinline__ unsigned pk2(float lo, float hi) { return f2bf(lo) | (f2bf(hi) << 16); }

#define XB_TMO      128
#define XB_XCNT(j)  (256  + 64 * (j))
#define XB_XSUB(j)  (1280 + 64 * (j))
#define XB_XGEN(j)  (2304 + 64 * (j))
#define XB_TOP      3328
#define XB_TOPGEN   3392
#define XCD_BAR_WORDS 3456
#define XB_SPIN_CAP (1u << 18)

__device__ __forceinline__ unsigned xb_ld(unsigned* p)              { return __hip_atomic_load(p, __ATOMIC_RELAXED, __HIP_MEMORY_SCOPE_AGENT); }
__device__ __forceinline__ unsigned xb_add(unsigned* p, unsigned v) { return __hip_atomic_fetch_add(p, v, __ATOMIC_RELAXED, __HIP_MEMORY_SCOPE_AGENT); }
__device__ __forceinline__ unsigned xb_xcc_id() { return (unsigned)__builtin_amdgcn_s_getreg((3 << 11) | 20) & 0xFu; }
#define XB_SPIN(cond, bar) do { unsigned _sp = 0; while (cond) { __builtin_amdgcn_s_sleep(1); \
    if ((++_sp & 255u) == 0u) { if (xb_ld(&(bar)[XB_TMO])) break; if (_sp > XB_SPIN_CAP) { atomicAdd(&(bar)[XB_TMO], 1u); break; } } } } while (0)

struct XcdBarrier {
    unsigned* bar; unsigned x;
    volatile LAS unsigned* st;
};

__device__ __forceinline__ XcdBarrier xcd_barrier_post(unsigned* bar, volatile LAS unsigned* st) {
    XcdBarrier b; b.bar = bar; b.x = xb_xcc_id(); b.st = st;
    if (threadIdx.x == 0) (void)xb_add(&bar[XB_XCNT(b.x)], 1u);
    return b;
}
__device__ __forceinline__ void xcd_barrier_complete(unsigned* bar, unsigned x, unsigned& nloc, unsigned& nx) {
    const unsigned G = gridDim.x * gridDim.y * gridDim.z;
    unsigned sum, cnt, mine, sp = 0u;
    for (;;) {
        sum = 0u; cnt = 0u; mine = 0u;
#pragma unroll
        for (unsigned j = 0; j < 16; ++j) { const unsigned c = xb_ld(&bar[XB_XCNT(j)]); sum += c; cnt += (c > 0u) ? 1u : 0u; mine = (j == x) ? c : mine; }
        if (sum == G) break;
        __builtin_amdgcn_s_sleep(1);
        if ((++sp & 255u) == 0u) { if (xb_ld(&bar[XB_TMO])) break; if (sp > XB_SPIN_CAP) { atomicAdd(&bar[XB_TMO], 1u); break; } }
    }
    nloc = mine > 0u ? mine : 1u; nx = cnt > 0u ? cnt : 1u;
}

__device__ __forceinline__ void xcd_barrier(const XcdBarrier& b) {
    asm volatile("s_waitcnt vmcnt(0)" ::: "memory");
    __syncthreads();
    if (threadIdx.x == 0) {
        unsigned* bar = b.bar;
        __builtin_amdgcn_s_waitcnt(0);
        unsigned nloc = b.st[0], nx = b.st[1];
        if (nloc == 0u) { xcd_barrier_complete(bar, b.x, nloc, nx); b.st[0] = nloc; b.st[1] = nx; }
        const unsigned old = xb_add(&bar[XB_XSUB(b.x)], 1u);
        const unsigned gen = old / nloc;
        if (old + 1u == (gen + 1u) * nloc) {
            __builtin_amdgcn_fence(__ATOMIC_RELEASE, "agent");
            asm volatile("s_waitcnt vmcnt(0)" ::: "memory");
            const unsigned og = xb_add(&bar[XB_TOP], 1u);
            const unsigned tg = og / nx;
            if (og + 1u == (tg + 1u) * nx) xb_add(&bar[XB_TOPGEN], 1u);
            else XB_SPIN(xb_ld(&bar[XB_TOPGEN]) == tg, bar);
            __builtin_amdgcn_fence(__ATOMIC_ACQUIRE, "agent");
            xb_add(&bar[XB_XGEN(b.x)], 1u);
            asm volatile("s_waitcnt vmcnt(0)" ::: "memory");
        } else {
            XB_SPIN(xb_ld(&bar[XB_XGEN(b.x)]) == gen, bar);
            __builtin_amdgcn_fence(__ATOMIC_ACQUIRE, "agent");
            asm volatile("s_waitcnt vmcnt(0)" ::: "memory");
        }
    }
    __syncthreads();
}

constexpr int NWAVES = 8;
constexpr int RING_OFF = 0, RING_BYTES = 131072;
constexpr int LDSCTL_OFF = 143360, MISC_OFF = LDSCTL_OFF + 320;
constexpr int LDS_BYTES = 147456;
static_assert(MISC_OFF + 128 <= LDS_BYTES, "LDS map");

struct Frame {
    LAS unsigned char* lds;
    volatile LAS unsigned* MISC;
    gu32* ctl;
    int tid, lane, wave;
    int vcu, G;
};
__device__ __forceinline__ float wave_sum(float v) {
#pragma unroll
    for (int o = 1; o < 64; o <<= 1) v += __shfl_xor(v, o);
    return v;
}

__device__ __forceinline__ void transpose_item(const float* __restrict__ W, int K, int N, bf16* __restrict__ WT, LAS float* scr, int kb, int nb, int lane) {
    const int k0 = 64 * kb, n0 = 64 * nb;
    f32x4 v[16];
#pragma unroll
    for (int i = 0; i < 16; ++i) { const int kk = 4 * i + (lane >> 4); v[i] = *(const f32x4*)(W + (size_t)(k0 + kk) * N + n0 + 4 * (lane & 15)); }
#pragma unroll
    for (int i = 0; i < 16; ++i) { const int kk = 4 * i + (lane >> 4); LAS float* d = scr + kk * 65 + 4 * (lane & 15); d[0] = v[i].x; d[1] = v[i].y; d[2] = v[i].z; d[3] = v[i].w; }
    LDS_WAIT(); asm volatile("" ::: "memory");
    const int c = lane & 7;
#pragma unroll
    for (int j = 0; j < 8; ++j) { const int n = (lane >> 3) + 8 * j; const LAS float* s = scr + (8 * c) * 65 + n;
        v4u o; o.x = pk2(s[0 * 65], s[1 * 65]); o.y = pk2(s[2 * 65], s[3 * 65]); o.z = pk2(s[4 * 65], s[5 * 65]); o.w = pk2(s[6 * 65], s[7 * 65]);
        *(GAS v4u*)(WT + (size_t)(n0 + n) * K + k0 + 8 * c) = o; }
    LDS_WAIT(); asm volatile("" ::: "memory");
}

struct Ptrs {
    const float* x; const float* meta; const float* relb; const float* w_in; const float* w_a; const float* w_b; const float* w_out;
    const float* lq1; const float* lk1; const float* lq2; const float* lk2; const float* dnorm; const float* sinks;
    const float* n_attn_pre; const float* n_attn_post; const float* w_ff1; const float* w_ff2; const float* n_ff_pre; const float* n_ff_post;
    float* out; unsigned char* ws;
};

__device__ __forceinline__ void p0_transposes(Frame& F, const Ptrs& P) {
    LAS float* scr = (LAS float*)(F.lds + F.wave * 16640);
    const int gw = F.vcu * NWAVES + F.wave, NGW = F.G * NWAVES;
    constexpr int I_IN = 32 * 132, I_A = 16 * 32, I_O = 32 * 32, I_1 = 32 * 128, I_2 = 128 * 32, I_L = I_IN + 2 * I_A + I_O + I_1 + I_2;
    bf16* ws_in = (bf16*)(P.ws + WS_WIN); bf16* ws_a = (bf16*)(P.ws + WS_WA); bf16* ws_b = (bf16*)(P.ws + WS_WB); bf16* ws_o = (bf16*)(P.ws + WS_WOUT);
    bf16* ws_1 = (bf16*)(P.ws + WS_W1); bf16* ws_2 = (bf16*)(P.ws + WS_W2);
    for (int it = gw; it < DEPTH * I_L; it += NGW) {
        const int l = it / I_L; int r = it % I_L;
        if (r < I_IN) { transpose_item(P.w_in + (size_t)l * DM * INW, DM, INW, ws_in + (size_t)l * INW * DM, scr, r / 132, r % 132, F.lane); continue; } r -= I_IN;
        if (r < I_A) { transpose_item(P.w_a + (size_t)l * 1024 * DM, 1024, DM, ws_a + (size_t)l * DM * 1024, scr, r / 32, r % 32, F.lane); continue; } r -= I_A;
        if (r < I_A) { transpose_item(P.w_b + (size_t)l * 1024 * DM, 1024, DM, ws_b + (size_t)l * DM * 1024, scr, r / 32, r % 32, F.lane); continue; } r -= I_A;
        if (r < I_O) { transpose_item(P.w_out + (size_t)l * DM * DM, DM, DM, ws_o + (size_t)l * DM * DM, scr, r / 32, r % 32, F.lane); continue; } r -= I_O;
        if (r < I_1) { transpose_item(P.w_ff1 + (size_t)l * DM * DFF, DM, DFF, ws_1 + (size_t)l * DFF * DM, scr, r / 128, r % 128, F.lane); continue; } r -= I_1;
        transpose_item(P.w_ff2 + (size_t)l * DFF * DM, DFF, DM, ws_2 + (size_t)l * DM * DFF, scr, r / 32, r % 32, F.lane);
    }
}

template <bool HAS_T, bool WRITE_U>
__device__ __forceinline__ void norm_phase(Frame& F, const float* hin_real, const float* hin_meta, float* hout_real, float* hout_meta,
                                           const bf16* T, const float* gpost, const float* gpre, bf16* U) {
    asm volatile("" : "+s"(hin_real), "+s"(hin_meta), "+s"(hout_real), "+s"(hout_meta), "+s"(T), "+s"(U));
    LAS float* gp = (LAS float*)(F.lds); LAS float* gq = gp + 2048;
    for (int i = F.tid; i < 2048; i += NWAVES * 64) { gp[i] = HAS_T ? gpost[i] : 0.f; gq[i] = WRITE_U ? gpre[i] : 0.f; }
    __syncthreads();
    const int gw = F.vcu * NWAVES + F.wave, NGW = F.G * NWAVES;
    for (int row = gw; row < NROWS; row += NGW) {
        const bool real = row < ROW_META;
        const float* hr = real ? hin_real + (size_t)row * DM : hin_meta + (size_t)(row - ROW_META) * DM;
        float* ho = real ? (hout_real ? hout_real + (size_t)row * DM : nullptr) : hout_meta + (size_t)(row - ROW_META) * DM;
        f32x4 hv[4][2]; v4u tv[4];
#pragma unroll
        for (int k = 0; k < 4; ++k) { const int ci = F.lane + 64 * k;
            if (HAS_T) tv[k] = *(const GAS v4u*)(T + (size_t)row * DM + 8 * ci);
            hv[k][0] = *(const GAS f32x4*)(hr + 8 * ci); hv[k][1] = *(const GAS f32x4*)(hr + 8 * ci + 4); }
        if (HAS_T) {
            float ss = 0.f; float tf[4][8];
#pragma unroll
            for (int k = 0; k < 4; ++k) {
                tf[k][0] = pg8::bf_lo(tv[k].x); tf[k][1] = pg8::bf_hi(tv[k].x); tf[k][2] = pg8::bf_lo(tv[k].y); tf[k][3] = pg8::bf_hi(tv[k].y);
                tf[k][4] = pg8::bf_lo(tv[k].z); tf[k][5] = pg8::bf_hi(tv[k].z); tf[k][6] = pg8::bf_lo(tv[k].w); tf[k][7] = pg8::bf_hi(tv[k].w);
#pragma unroll
                for (int e = 0; e < 8; ++e) ss += tf[k][e] * tf[k][e]; }
            const float rstd = 1.0f / sqrtf(wave_sum(ss) * (1.f / DM) + EPS);
#pragma unroll
            for (int k = 0; k < 4; ++k) { const int ci = F.lane + 64 * k; const f32x4 g0 = *(const LAS f32x4*)(gp + 8 * ci), g1 = *(const LAS f32x4*)(gp + 8 * ci + 4);
                hv[k][0].x += tf[k][0] * rstd * g0.x; hv[k][0].y += tf[k][1] * rstd * g0.y; hv[k][0].z += tf[k][2] * rstd * g0.z; hv[k][0].w += tf[k][3] * rstd * g0.w;
                hv[k][1].x += tf[k][4] * rstd * g1.x; hv[k][1].y += tf[k][5] * rstd * g1.y; hv[k][1].z += tf[k][6] * rstd * g1.z; hv[k][1].w += tf[k][7] * rstd * g1.w; }
        }
        if (ho) {
#pragma unroll
            for (int k = 0; k < 4; ++k) { const int ci = F.lane + 64 * k; *(GAS f32x4*)(ho + 8 * ci) = hv[k][0]; *(GAS f32x4*)(ho + 8 * ci + 4) = hv[k][1]; }
        }
        if (WRITE_U) {
            float ss = 0.f;
#pragma unroll
            for (int k = 0; k < 4; ++k) ss += (hv[k][0].x * hv[k][0].x + hv[k][0].y * hv[k][0].y) + (hv[k][0].z * hv[k][0].z + hv[k][0].w * hv[k][0].w)
                                            + (hv[k][1].x * hv[k][1].x + hv[k][1].y * hv[k][1].y) + (hv[k][1].z * hv[k][1].z + hv[k][1].w * hv[k][1].w);
            const float rstd = 1.0f / sqrtf(wave_sum(ss) * (1.f / DM) + EPS);
#pragma unroll
            for (int k = 0; k < 4; ++k) { const int ci = F.lane + 64 * k; const f32x4 g0 = *(const LAS f32x4*)(gq + 8 * ci), g1 = *(const LAS f32x4*)(gq + 8 * ci + 4);
                v4u o; o.x = pk2(hv[k][0].x * rstd * g0.x, hv[k][0].y * rstd * g0.y); o.y = pk2(hv[k][0].z * rstd * g0.z, hv[k][0].w * rstd * g0.w);
                o.z = pk2(hv[k][1].x * rstd * g1.x, hv[k][1].y * rstd * g1.y); o.w = pk2(hv[k][1].z * rstd * g1.z, hv[k][1].w * rstd * g1.w);
                *(GAS v4u*)(U + (size_t)row * DM + 8 * ci) = o; }
        }
    }
    __syncthreads();
}

__device__ __forceinline__ int t5_bucket(int dist) {
    const int n = dist < 0 ? 0 : dist;
    if (n < 16) return n;
    int large = 16 + (int)(logf((float)n * (1.f / 16.f)) / 2.0794415416798357f * 16.f);
    return large > 31 ? 31 : large;
}

#if ATTN_NAIVE
template <bool DIFF>
__global__ void __launch_bounds__(512) naive_attn(const bf16* __restrict__ Z, bf16* __restrict__ YAB, const float* __restrict__ relb, const float* lq1, const float* lk1, const float* lq2, const float* lk2,
                                                   const float* __restrict__ dnorm, const float* __restrict__ sinks, int layer) {
    constexpr int KT = 16, DVT = DIFF ? 64 : 32, KW = DIFF ? 128 : 64, VW = DIFF ? 128 : 64;
    extern __shared__ __attribute__((aligned(16))) unsigned char smem[];
    float* Ksh = (float*)smem;
    float* Vsh = Ksh + 32 * 128;
    float* biasL = Vsh + 32 * 128;
    int* kposs = (int*)(biasL + 2 * 132);
    float* red = (float*)(kposs + 64);
    float* Osh = red + 8;
    const int tid = threadIdx.x, row = tid & 127, cj = (tid >> 7) & 1, dvh = tid >> 8;
    const int unit = blockIdx.x, hh = unit / 129, qb = unit % 129;
    const bool metablk = (qb == 128);
    const int qrow = metablk ? ROW_META + row : 128 * qb + row;
    const int qpos = metablk ? 112 + row : 128 + 128 * qb + row;
    float lam = 0.f, lam_init = 0.f;
    if (DIFF) {
        lam_init = 0.8f - 0.6f * expf(-0.3f * (float)layer);
        if (tid < 64) { float a = lq1[layer * 64 + tid] * lk1[layer * 64 + tid], b = lq2[layer * 64 + tid] * lk2[layer * 64 + tid];
#pragma unroll
            for (int o = 1; o < 64; o <<= 1) { a += __shfl_xor(a, o); b += __shfl_xor(b, o); }
            if (tid == 0) { red[0] = a; red[1] = b; } }
    }
    for (int i = tid; i < 2 * 129; i += 512) { const int j = i / 129, d = i % 129; const int col = DIFF ? hh : 8 + 2 * hh + j; biasL[j * 132 + d] = relb[t5_bucket(d) * NBIAS + col] * LOG2E; }
    __syncthreads();
    if (DIFF) lam = expf(red[0]) - expf(red[1]) + lam_init;
    const int qcol = DIFF ? C_QA + hh * 128 + cj * 64 : C_QB + (2 * hh + cj) * 64;
    const int kcol = DIFF ? C_KA + hh * 128 : C_KB + (hh >> 2) * 64;
    const int vcol = DIFF ? C_VA + hh * 128 : C_VB + (hh >> 2) * 64;
    float q[64];
    { const bf16* qp = Z + (size_t)qrow * INW + qcol;
#pragma unroll
      for (int i = 0; i < 64; ++i) q[i] = pg8::bf_lo((unsigned)qp[i]); }
    float o[DVT];
#pragma unroll
    for (int i = 0; i < DVT; ++i) o[i] = 0.f;
    float m = NEGBIG, l = 0.f;
    if (!DIFF) { m = sinks[layer * 16 + 2 * hh + cj] * LOG2E; l = 1.f; }
    const int t_s = DIFF ? 0 : (qb >= 1 && !metablk ? 128 * (qb - 1) : 0);
    const int nreal = metablk ? 0 : 128 * qb + 128 - t_s;
    const int ns = 16 + nreal;
    const float* bl = biasL + (DIFF ? 0 : cj) * 132;
    for (int s0 = 0; s0 < ns; s0 += KT) {
        __syncthreads();
        for (int i = tid; i < KT * KW; i += 512) { const int kk = i / KW, c = i % KW, s = s0 + kk; float v = 0.f;
            if (s < ns) { const int krow = s < 16 ? ROW_META + s : t_s + s - 16; v = pg8::bf_lo((unsigned)Z[(size_t)krow * INW + kcol + c]); } Ksh[kk * 128 + c] = v; }
        for (int i = tid; i < KT * VW; i += 512) { const int kk = i / VW, c = i % VW, s = s0 + kk; float v = 0.f;
            if (s < ns) { const int krow = s < 16 ? ROW_META + s : t_s + s - 16; v = pg8::bf_lo((unsigned)Z[(size_t)krow * INW + vcol + c]); } Vsh[kk * 128 + c] = v; }
        if (tid < KT) { const int s = s0 + tid; kposs[tid] = s >= ns ? (1 << 30) : (s < 16 ? 112 + s : 128 + t_s + s - 16); kposs[32 + tid] = (s < 16) ? 1 : 0; }
        __syncthreads();
        float sc[KT]; float tmax = NEGBIG;
#pragma unroll
        for (int kk = 0; kk < KT; ++kk) {
            const float* kr = Ksh + kk * 128 + (DIFF ? cj * 64 : 0); float a = 0.f;
#pragma unroll
            for (int i = 0; i < 64; ++i) a += q[i] * kr[i];
            const int dist = qpos - kposs[kk]; const bool ismeta = kposs[32 + kk] != 0;
            bool ok = dist >= 0; if (!DIFF && !ismeta) ok = ok && dist < 128;
            const int di = dist < 0 ? 0 : (dist > 128 ? 128 : dist);
            a = ok ? a + bl[di] : NEGBIG;
            sc[kk] = a; tmax = fmaxf(tmax, a);
        }
        const float mn = fmaxf(m, tmax), alpha = exp2f(m - mn);
        l *= alpha;
#pragma unroll
        for (int i = 0; i < DVT; ++i) o[i] *= alpha;
        m = mn;
#pragma unroll
        for (int kk = 0; kk < KT; ++kk) {
            const float p = sc[kk] > -1e29f ? exp2f(sc[kk] - m) : 0.f;
            l += p; const float* vr = Vsh + kk * 128 + dvh * DVT;
#pragma unroll
            for (int i = 0; i < DVT; ++i) o[i] += p * vr[i];
        }
    }
    const float rl = 1.f / l;
    if (DIFF) {
        __syncthreads();
        if (cj == 1) {
#pragma unroll
            for (int i = 0; i < DVT; ++i) Osh[row * 129 + dvh * 64 + i] = lam * o[i] * rl; }
        __syncthreads();
        if (cj == 0) {
#pragma unroll
            for (int i = 0; i < DVT; ++i) Osh[row * 129 + dvh * 64 + i] = o[i] * rl - Osh[row * 129 + dvh * 64 + i]; }
        __syncthreads();
        if (tid < 128 && (!metablk || tid < 16)) {
            float ss = 0.f;
            for (int d = 0; d < 128; ++d) { const float v = Osh[tid * 129 + d]; ss += v * v; }
            const float rstd = 1.0f / sqrtf(ss * (1.f / 128.f) + EPS) * (1.f - lam_init);
            const int orow = metablk ? ROW_META + tid : 128 * qb + tid;
            for (int d = 0; d < 128; ++d) YAB[(size_t)orow * DM + hh * 128 + d] = (bf16)f2bf(Osh[tid * 129 + d] * rstd * dnorm[layer * 128 + d]);
        }
    } else {
        if (!metablk || row < 16) {
#pragma unroll
            for (int i = 0; i < DVT; ++i) YAB[(size_t)qrow * DM + 1024 + (2 * hh + cj) * 64 + dvh * 32 + i] = (bf16)f2bf(o[i] * rl); }
    }
}
constexpr int NAIVE_LDS = (32 * 128 * 2 + 2 * 132 + 64 + 8 + 128 * 129) * 4;
#endif

constexpr int PH_PER_LAYER = 9, N_PHASES = 1 + DEPTH * PH_PER_LAYER;
struct Args { Ptrs p; int ph_lo, ph_hi; };

__global__ void __launch_bounds__(NWAVES * 64, 2) fwd_kernel(Args args) {
    extern __shared__ __attribute__((aligned(16))) unsigned char lds[];
    Frame F;
    F.lds = (LAS unsigned char*)lds;
    F.MISC = (volatile LAS unsigned*)(F.lds + MISC_OFF);
    F.tid = threadIdx.x; F.lane = F.tid & 63; F.wave = __builtin_amdgcn_readfirstlane(F.tid >> 6);
    F.G = gridDim.x; { const int bx = blockIdx.x; F.vcu = (F.G % 8 == 0) ? (bx % 8) * (F.G / 8) + bx / 8 : bx; }
    const Ptrs& P = args.p;
    unsigned char* ws = P.ws;
    F.ctl = (gu32*)(ws + WS_CTL);
    for (int u = F.tid; u < (LDS_BYTES - LDSCTL_OFF) / 4; u += NWAVES * 64) ((LAS unsigned*)(F.lds + LDSCTL_OFF))[u] = 0u;
    __syncthreads();
    const int lo = args.ph_lo, hi = args.ph_hi;
    const bool multi = (hi - lo) > 1;
    XcdBarrier bar; bar.bar = (unsigned*)(F.ctl + CW_BAR); bar.x = 0; bar.st = nullptr;
    if (multi) bar = xcd_barrier_post((unsigned*)(F.ctl + CW_BAR), F.MISC + 8);
#define IN(k) (lo <= (k) && (k) < hi)
#define SEAM(k) do { if (IN(k) && IN((k) + 1)) xcd_barrier(bar); } while (0)

    bf16* U = (bf16*)(ws + WS_U); bf16* Z = (bf16*)(ws + WS_Z); bf16* YAB = (bf16*)(ws + WS_YAB); bf16* MIX = (bf16*)(ws + WS_MIX); bf16* T = (bf16*)(ws + WS_T);
    bf16* HID = Z; float* HMETA = (float*)(ws + WS_HMETA);

    if (IN(0)) {
        p0_transposes(F, P);
        __syncthreads();
        norm_phase<false, true>(F, P.x, P.meta, nullptr, HMETA, nullptr, nullptr, P.n_attn_pre, U);
        SEAM(0);
    }
    for (int l = 0; l < DEPTH; ++l) {
        const int pb = 1 + PH_PER_LAYER * l;
        if (pb + PH_PER_LAYER <= lo || pb >= hi) continue;
#define OPQ(p) asm volatile("" : "+s"(p))
        if (IN(pb + 0)) {
            const bf16* A_ = U; const bf16* B_ = (const bf16*)(ws + WS_WIN) + (size_t)l * INW * DM; bf16* O_ = Z; OPQ(A_); OPQ(B_); OPQ(O_);
            pg8::Gemm g{A_, B_, MA, INW, DM, DM, DM}; pg8::StaticOrder S; S.init(MA, INW, F.G, (int)blockIdx.x);
            pg8::EpiZ E{O_, INW};
            pg8::gemm_phase<pg8::EpiZ, pg8::StaticOrder, true>(F.lds + RING_OFF, g, S, E);
            SEAM(pb + 0);
        }
        if (IN(pb + 1)) {
            SEAM(pb + 1);
        }
        if (IN(pb + 2)) {
            const bf16* A_ = YAB; const bf16* B_ = (const bf16*)(ws + WS_WA) + (size_t)l * DM * 1024; bf16* O_ = T; const bf16* G_ = Z + C_GA; OPQ(A_); OPQ(B_); OPQ(O_); OPQ(G_);
            pg8::Gemm g{A_, B_, MA, DM, 1024, DM, 1024}; pg8::StaticOrder S; S.init(MA, DM, F.G, (int)blockIdx.x);
            pg8::EpiGate<false> E{O_, DM, G_, INW, O_};
            pg8::gemm_phase<pg8::EpiGate<false>, pg8::StaticOrder, true>(F.lds + RING_OFF, g, S, E);
            SEAM(pb + 2);
        }
        if (IN(pb + 3)) {
            const bf16* A_ = YAB + 1024; const bf16* B_ = (const bf16*)(ws + WS_WB) + (size_t)l * DM * 1024; bf16* O_ = MIX; const bf16* G_ = Z + C_GB; const bf16* P_ = T; OPQ(A_); OPQ(B_); OPQ(O_); OPQ(G_); OPQ(P_);
            pg8::Gemm g{A_, B_, MA, DM, 1024, DM, 1024}; pg8::StaticOrder S; S.init(MA, DM, F.G, (int)blockIdx.x);
            pg8::EpiGate<true> E{O_, DM, G_, INW, P_};
            pg8::gemm_phase<pg8::EpiGate<true>, pg8::StaticOrder, true>(F.lds + RING_OFF, g, S, E);
            SEAM(pb + 3);
        }
        if (IN(pb + 4)) {
            const bf16* A_ = MIX; const bf16* B_ = (const bf16*)(ws + WS_WOUT) + (size_t)l * DM * DM; bf16* O_ = T; OPQ(A_); OPQ(B_); OPQ(O_);
            pg8::Gemm g{A_, B_, MA, DM, DM, DM, DM}; pg8::StaticOrder S; S.init(MA, DM, F.G, (int)blockIdx.x);
            pg8::EpiBf16<0> E{O_, DM};
            pg8::gemm_phase<pg8::EpiBf16<0>, pg8::StaticOrder, true>(F.lds + RING_OFF, g, S, E);
            SEAM(pb + 4);
        }
        if (IN(pb + 5)) {
            norm_phase<true, true>(F, l == 0 ? P.x : P.out, HMETA, P.out, HMETA, T, P.n_attn_post + l * DM, P.n_ff_pre + l * DM, U);
            SEAM(pb + 5);
        }
        if (IN(pb + 6)) {
            const bf16* A_ = U; const bf16* B_ = (const bf16*)(ws + WS_W1) + (size_t)l * DFF * DM; bf16* O_ = HID; OPQ(A_); OPQ(B_); OPQ(O_);
            pg8::Gemm g{A_, B_, MA, DFF, DM, DM, DM}; pg8::StaticOrder S; S.init(MA, DFF, F.G, (int)blockIdx.x);
            pg8::EpiBf16<1> E{O_, DFF};
            pg8::gemm_phase<pg8::EpiBf16<1>, pg8::StaticOrder, true>(F.lds + RING_OFF, g, S, E);
            SEAM(pb + 6);
        }
        if (IN(pb + 7)) {
            const bf16* A_ = HID; const bf16* B_ = (const bf16*)(ws + WS_W2) + (size_t)l * DM * DFF; bf16* O_ = T; OPQ(A_); OPQ(B_); OPQ(O_);
            pg8::Gemm g{A_, B_, MA, DM, DFF, DFF, DFF}; pg8::StaticOrder S; S.init(MA, DM, F.G, (int)blockIdx.x);
            pg8::EpiBf16<0> E{O_, DM};
            pg8::gemm_phase<pg8::EpiBf16<0>, pg8::StaticOrder, true>(F.lds + RING_OFF, g, S, E);
            SEAM(pb + 7);
        }
        if (IN(pb + 8)) {
            if (l + 1 < DEPTH) norm_phase<true, true>(F, P.out, HMETA, P.out, HMETA, T, P.n_ff_post + l * DM, P.n_attn_pre + (l + 1) * DM, U);
            else norm_phase<true, false>(F, P.out, HMETA, P.out, HMETA, T, P.n_ff_post + l * DM, nullptr, U);
            SEAM(pb + 8);
        }
    }
#undef OPQ
#undef IN
#undef SEAM
}

extern "C" void kernel_launch(void* const* d_in, const int* in_sizes, int n_in, void* d_out, int out_size, void* d_ws, size_t ws_size, hipStream_t stream) {
    static int grid = 0;
    if (grid == 0) {
        if (n_in != 19 || in_sizes[0] != SEQ * DM || out_size != SEQ * DM || ws_size < WS_END) { fprintf(stderr, "kernel_launch: unexpected shapes (n_in %d, ws %zu)\n", n_in, ws_size); grid = -1; return; }
        int dev = 0, cus = 0;
        if (hipGetDevice(&dev) != hipSuccess || hipDeviceGetAttribute(&cus, hipDeviceAttributeMultiprocessorCount, dev) != hipSuccess) { grid = -1; return; }
        if (hipFuncSetAttribute((const void*)fwd_kernel, hipFuncAttributeMaxDynamicSharedMemorySize, LDS_BYTES) != hipSuccess) { grid = -1; return; }
#if ATTN_NAIVE
        (void)hipFuncSetAttribute((const void*)naive_attn<true>, hipFuncAttributeMaxDynamicSharedMemorySize, NAIVE_LDS);
        (void)hipFuncSetAttribute((const void*)naive_attn<false>, hipFuncAttributeMaxDynamicSharedMemorySize, NAIVE_LDS);
#endif
        int per_cu = 0;
        (void)hipOccupancyMaxActiveBlocksPerMultiprocessor(&per_cu, (const void*)fwd_kernel, NWAVES * 64, LDS_BYTES);
        (void)hipGetLastError();
        grid = cus;
    }
    if (grid < 0) return;
    if (hipMemsetAsync((char*)d_ws + WS_CTL, 0, CTL_ZERO_BYTES, stream) != hipSuccess) return;
    Args a{};
    a.p.x = (const float*)d_in[0]; a.p.meta = (const float*)d_in[1]; a.p.relb = (const float*)d_in[2]; a.p.w_in = (const float*)d_in[3]; a.p.w_a = (const float*)d_in[4];
    a.p.w_b = (const float*)d_in[5]; a.p.w_out = (const float*)d_in[6]; a.p.lq1 = (const float*)d_in[7]; a.p.lk1 = (const float*)d_in[8]; a.p.lq2 = (const float*)d_in[9];
    a.p.lk2 = (const float*)d_in[10]; a.p.dnorm = (const float*)d_in[11]; a.p.sinks = (const float*)d_in[12]; a.p.n_attn_pre = (const float*)d_in[13]; a.p.n_attn_post = (const float*)d_in[14];
    a.p.w_ff1 = (const float*)d_in[15]; a.p.w_ff2 = (const float*)d_in[16]; a.p.n_ff_pre = (const float*)d_in[17]; a.p.n_ff_post = (const float*)d_in[18];
    a.p.out = (float*)d_out; a.p.ws = (unsigned char*)d_ws;
#if ONE_LAUNCH
    a.ph_lo = 0; a.ph_hi = N_PHASES;
    hipLaunchKernelGGL(fwd_kernel, dim3(grid), dim3(NWAVES * 64), LDS_BYTES, stream, a);
#else
    for (int ph = 0; ph < N_PHASES; ++ph) {
        const int l = (ph - 1) / PH_PER_LAYER, i = (ph - 1) % PH_PER_LAYER;
#if ATTN_NAIVE
        if (ph >= 1 && i == 1) {
            const bf16* Z = (const bf16*)((unsigned char*)d_ws + WS_Z); bf16* YAB = (bf16*)((unsigned char*)d_ws + WS_YAB);
            hipLaunchKernelGGL(naive_attn<true>, dim3(8 * 129), dim3(512), NAIVE_LDS, stream, Z, YAB, a.p.relb, a.p.lq1, a.p.lk1, a.p.lq2, a.p.lk2, a.p.dnorm, a.p.sinks, l);
            hipLaunchKernelGGL(naive_attn<false>, dim3(8 * 129), dim3(512), NAIVE_LDS, stream, Z, YAB, a.p.relb, a.p.lq1, a.p.lk1, a.p.lq2, a.p.lk2, a.p.dnorm, a.p.sinks, l);
            continue;
        }
#endif
        a.ph_lo = ph; a.ph_hi = ph + 1;
        hipLaunchKernelGGL(fwd_kernel, dim3(grid), dim3(NWAVES * 64), LDS_BYTES, stream, a);
    }
#endif
    (void)hipPeekAtLastError();
}
```

```cpp
#include <hip/hip_runtime.h>
#include <cstdio>
#include <cstdint>

#ifndef ATTN_NAIVE
#define ATTN_NAIVE 0
#endif
#ifndef PROBE_MASK
#define PROBE_MASK 0
#endif
#define NREP(i) (((PROBE_MASK >> (i)) & 1) ? 2 : 1)
#ifndef ONE_LAUNCH
#define ONE_LAUNCH 1
#endif

constexpr int DM = 2048, SEQ = 16384, DEPTH = 4, NMETA = 16;
constexpr int MA = 16640;
constexpr int ROW_META = 16384, NROWS = 16400;
constexpr int INW = 8448, DFF = 8192;
constexpr int C_QA = 0, C_KA = 1024, C_VA = 2048, C_QB = 3072, C_KB = 4096, C_VB = 4224, C_GA = 4352, C_GB = 6400;
constexpr int NBUCK = 32, NBIAS = 24;
constexpr float EPS = 1e-6f, LOG2E = 1.4426950408889634f, QSCALE = 0.125f * 1.4426950408889634f, NEGBIG = -1e30f;

constexpr size_t MiB = 1u << 20;
constexpr size_t WS_CTL = 0, CTL_ZERO_BYTES = 1 * MiB;
constexpr size_t WS_HMETA = 2 * MiB;
constexpr size_t WS_LUTG = 2 * MiB + 256 * 1024;
constexpr size_t WS_WIN = 4 * MiB;
constexpr size_t WS_WA = 136 * MiB, WS_WB = 152 * MiB;
constexpr size_t WS_WOUT = 168 * MiB;
constexpr size_t WS_W1 = 200 * MiB;
constexpr size_t WS_W2 = 328 * MiB;
constexpr size_t WS_U = 456 * MiB;
constexpr size_t WS_YAB = 521 * MiB;
constexpr size_t WS_MIX = 586 * MiB;
constexpr size_t WS_T = 651 * MiB;
constexpr size_t WS_Z = 716 * MiB;
constexpr size_t WS_HQ = WS_MIX;
constexpr size_t WS_WQ = 985 * MiB;
constexpr size_t WS_QS = 3 * MiB;
constexpr size_t WS_CS = 3 * MiB + 128 * 1024;
constexpr size_t WS_END = 1018 * MiB;
static_assert(WS_Z + (size_t)MA * INW * 2 <= WS_WQ && WS_WQ + (size_t)4 * 4096 * 2048 <= WS_END && (size_t)MA * 2048 <= 65 * MiB, "ws map");
constexpr int CW_TMO = 0, CW_BAR = 4096, CW_CMAX = 32768;

namespace pg8 {
#define PG8_LAS __attribute__((address_space(3)))
typedef unsigned short bf16_t;
typedef short bf16x8 __attribute__((ext_vector_type(8)));
typedef float f32x4 __attribute__((ext_vector_type(4)));
typedef unsigned u32x4 __attribute__((ext_vector_type(4)));
typedef int i32x4 __attribute__((ext_vector_type(4)));
constexpr int BM = 256, BK = 64, HALF = 128, HTB = HALF * BK * 2  , STAGE_BYTES = 8 * HTB, NXCD = 8, WGM = 8;

__host__ __device__ __forceinline__ int lds_byte(int r, int c) { const int r7 = r & 7; return (r >> 3) * 1024 + r7 * 128 + (((c >> 3) ^ r7) << 4) + (c & 7) * 2; }
__host__ __device__ __forceinline__ void stage_rc(int b, int& R, int& C) { const int blk = b / 1024, sb = b % 1024, r7 = sb / 128, chs = (sb % 128) / 16; R = blk * 8 + r7; C = (chs ^ r7) * 8; }
__host__ __device__ __forceinline__ int perm32(int rho) { const int n = rho >> 4, i = rho & 15; return 8 * (i >> 2) + 4 * n + (i & 3); }

struct Unit { int pm, pn; };
struct Gemm { const bf16_t* A; const bf16_t* Bt; int M, N, K, lda, ldb; };

struct StaticOrder {
    int nM, nN, nwg, G, c;
    __host__ __device__ void init(int M, int N, int G_, int c_) { nM = M / BM; nN = N / BM; nwg = nM * nN; G = G_; c = c_; }
    __host__ __device__ bool next(int i, Unit& u) const {
        const long L = (long)i * G + c; if (L >= nwg) return false;
        int wgid = (int)L; { const int q = nwg / NXCD, r = nwg % NXCD, xcd = wgid % NXCD, off = wgid / NXCD; wgid = (xcd < r ? xcd * (q + 1) : r * (q + 1) + (xcd - r) * q) + off; }
        const int nig = WGM * nN, gid = wgid / nig, fm = gid * WGM, gsz = (nM - fm) < WGM ? (nM - fm) : WGM;
        u.pm = fm + ((wgid % nig) % gsz); u.pn = (wgid % nig) / gsz; return true;
    }
    __device__ __forceinline__ void a_ready(const Unit&) const {}
    __device__ __forceinline__ void done(const Unit&) const {}
};

__device__ __forceinline__ unsigned cvt_pk_bf16(float lo, float hi) { unsigned r; asm volatile("v_cvt_pk_bf16_f32 %0, %1, %2" : "=v"(r) : "v"(lo), "v"(hi)); return r; }
__device__ __forceinline__ float bf_lo(unsigned u) { return __builtin_bit_cast(float, u << 16); }
__device__ __forceinline__ float bf_hi(unsigned u) { return __builtin_bit_cast(float, u & 0xffff0000u); }
__device__ __forceinline__ float sigmoidf_fast(float x) { return __builtin_amdgcn_rcpf(1.0f + __builtin_amdgcn_exp2f(-x * 1.4426950408889634f)); }

#define PG8_GAS __attribute__((address_space(1)))
__device__ __forceinline__ void st_remap(PG8_LAS unsigned char* stg, int fr, int fq, int lane, u32x4 w, PG8_GAS bf16_t* blk, int ldc) {
    *(PG8_LAS u32x4*)(stg + fr * 64 + ((fq ^ ((fr >> 1) & 3)) * 16)) = w;
    const int r = lane >> 2, c = lane & 3;
    const u32x4 v = *(const PG8_LAS u32x4*)(stg + r * 64 + ((c ^ ((r >> 1) & 3)) * 16));
    *(PG8_GAS u32x4*)(blk + (size_t)r * ldc + c * 8) = v;
}
struct EpiZ {
    static constexpr bool PERM = true, AFTER_DRAIN = false;
    bf16_t* O; int ldc; const float* rs; int pn_off; const float* cs = nullptr;
    __device__ __forceinline__ void operator()(const f32x4 (&acc)[2][2][4][2], const Unit& u, int wr, int wc, int fr, int fq, PG8_LAS unsigned char* stg, int lane) const {
        const int tpn = u.pn + pn_off;
        const int rowb = u.pm * BM + wr * 64, colb = tpn * BM + wc * 32;
        const int mode = (tpn < 4 || (tpn >= 12 && tpn < 16)) ? 1 : (tpn >= 17 ? 2 : 0);
        f32x4 c4[2][2];
        if (cs) {
#pragma unroll
            for (int bj = 0; bj < 2; ++bj) { c4[bj][0] = *(const PG8_GAS f32x4*)(cs + u.pn * BM + wc * 32 + bj * HALF + 8 * fq); c4[bj][1] = *(const PG8_GAS f32x4*)(cs + u.pn * BM + wc * 32 + bj * HALF + 8 * fq + 4); } }
        float r8[2][4];
#pragma unroll
        for (int ai = 0; ai < 2; ++ai)
#pragma unroll
            for (int m = 0; m < 4; ++m) r8[ai][m] = ((const PG8_GAS float*)rs)[rowb + fr + ai * HALF + m * 16];
#pragma unroll
        for (int ai = 0; ai < 2; ++ai)
#pragma unroll
            for (int m = 0; m < 4; ++m) { PG8_GAS bf16_t* blk = (PG8_GAS bf16_t*)O + (size_t)(rowb + ai * HALF + m * 16) * ldc + colb; const float r_ = r8[ai][m];
#pragma unroll
                for (int bj = 0; bj < 2; ++bj) { f32x4 v0, v1;
                    if (cs) { const i32x4 a0 = __builtin_bit_cast(i32x4, acc[ai][bj][m][0]), a1 = __builtin_bit_cast(i32x4, acc[ai][bj][m][1]);
#pragma unroll
                        for (int e = 0; e < 4; ++e) { v0[e] = (float)a0[e] * r_ * c4[bj][0][e]; v1[e] = (float)a1[e] * r_ * c4[bj][1][e]; } }
                    else { v0 = acc[ai][bj][m][0] * r_; v1 = acc[ai][bj][m][1] * r_; }
                    if (mode == 1) { v0 = v0 * QSCALE; v1 = v1 * QSCALE; }
                    else if (mode == 2) {
#pragma unroll
                        for (int e = 0; e < 4; ++e) { v0[e] = sigmoidf_fast(v0[e]); v1[e] = sigmoidf_fast(v1[e]); } }
                    u32x4 w; w.x = cvt_pk_bf16(v0[0], v0[1]); w.y = cvt_pk_bf16(v0[2], v0[3]); w.z = cvt_pk_bf16(v1[0], v1[1]); w.w = cvt_pk_bf16(v1[2], v1[3]);
                    st_remap(stg, fr, fq, lane, w, blk + bj * HALF, ldc); } }
    }
};
struct EpiZq {
    static constexpr bool PERM = true, AFTER_DRAIN = false;
    bf16_t* O; int ldc; const float* qs; const float* cs; int col_off;
    __device__ __forceinline__ void operator()(const f32x4 (&acc)[2][2][4][2], const Unit& u, int wr, int wc, int fr, int fq, PG8_LAS unsigned char* stg, int lane) const {
        const int rowb = u.pm * BM + wr * 64, colg = u.pn * BM + wc * 32;
        float r8[2][4]; f32x4 c4[2][2];
#pragma unroll
        for (int ai = 0; ai < 2; ++ai)
#pragma unroll
            for (int m = 0; m < 4; ++m) r8[ai][m] = ((const PG8_GAS float*)qs)[rowb + fr + ai * HALF + m * 16];
#pragma unroll
        for (int bj = 0; bj < 2; ++bj) { c4[bj][0] = *(const PG8_GAS f32x4*)(cs + colg + bj * HALF + 8 * fq); c4[bj][1] = *(const PG8_GAS f32x4*)(cs + colg + bj * HALF + 8 * fq + 4); }
#pragma unroll
        for (int ai = 0; ai < 2; ++ai)
#pragma unroll
            for (int m = 0; m < 4; ++m) { PG8_GAS bf16_t* blk = (PG8_GAS bf16_t*)O + (size_t)(rowb + ai * HALF + m * 16) * ldc + col_off + colg; const float r_ = r8[ai][m];
#pragma unroll
                for (int bj = 0; bj < 2; ++bj) { const i32x4 a0 = __builtin_bit_cast(i32x4, acc[ai][bj][m][0]), a1 = __builtin_bit_cast(i32x4, acc[ai][bj][m][1]); f32x4 v0, v1;
#pragma unroll
                    for (int e = 0; e < 4; ++e) { v0[e] = sigmoidf_fast((float)a0[e] * r_ * c4[bj][0][e]); v1[e] = sigmoidf_fast((float)a1[e] * r_ * c4[bj][1][e]); }
                    u32x4 w; w.x = cvt_pk_bf16(v0[0], v0[1]); w.y = cvt_pk_bf16(v0[2], v0[3]); w.z = cvt_pk_bf16(v1[0], v1[1]); w.w = cvt_pk_bf16(v1[2], v1[3]);
                    st_remap(stg, fr, fq, lane, w, blk + bj * HALF, ldc); } }
    }
};
template <int ACT  > struct EpiBf16 {
    static constexpr bool PERM = true, AFTER_DRAIN = false;
    bf16_t* O; int ldc; const float* rs;
    __device__ __forceinline__ void operator()(const f32x4 (&acc)[2][2][4][2], const Unit& u, int wr, int wc, int fr, int fq, PG8_LAS unsigned char* stg, int lane) const {
        const int rowb = u.pm * BM + wr * 64, colb = u.pn * BM + wc * 32;
        float r8[2][4];
        if (ACT == 1) {
#pragma unroll
            for (int ai = 0; ai < 2; ++ai)
#pragma unroll
                for (int m = 0; m < 4; ++m) r8[ai][m] = ((const PG8_GAS float*)rs)[rowb + fr + ai * HALF + m * 16]; }
#pragma unroll
        for (int ai = 0; ai < 2; ++ai)
#pragma unroll
            for (int m = 0; m < 4; ++m) { PG8_GAS bf16_t* blk = (PG8_GAS bf16_t*)O + (size_t)(rowb + ai * HALF + m * 16) * ldc + colb;
#pragma unroll
                for (int bj = 0; bj < 2; ++bj) { f32x4 v0 = acc[ai][bj][m][0], v1 = acc[ai][bj][m][1];
                    if (ACT == 1) { const float r_ = r8[ai][m];
#pragma unroll
                        for (int e = 0; e < 4; ++e) { const float a = fmaxf(v0[e] * r_, 0.f), b = fmaxf(v1[e] * r_, 0.f); v0[e] = a * a; v1[e] = b * b; } }
                    u32x4 w; w.x = cvt_pk_bf16(v0[0], v0[1]); w.y = cvt_pk_bf16(v0[2], v0[3]); w.z = cvt_pk_bf16(v1[0], v1[1]); w.w = cvt_pk_bf16(v1[2], v1[3]);
                    st_remap(stg, fr, fq, lane, w, blk + bj * HALF, ldc); } }
    }
};
template <bool ADD_PREV> struct EpiGate {
    static constexpr bool PERM = true, AFTER_DRAIN = false;
    bf16_t* O; int ldc; const bf16_t* G; int ldg; const bf16_t* P;
    __device__ __forceinline__ void operator()(const f32x4 (&acc)[2][2][4][2], const Unit& u, int wr, int wc, int fr, int fq, PG8_LAS unsigned char* stg, int lane) const {
        const int rowb = u.pm * BM + wr * 64, colb = u.pn * BM + wc * 32;
        const int row0 = rowb + fr, col0 = colb + 8 * fq;
        u32x4 gv[2][4], pv[2][4];
#define PG8_EG_LOAD(g, b) do { _Pragma("unroll") for (int mm = 0; mm < 2; ++mm) _Pragma("unroll") for (int bj = 0; bj < 2; ++bj) { \
            const size_t r_ = (size_t)(row0 + ((g) >> 1) * HALF + (((g) & 1) * 2 + mm) * 16); \
            gv[b][mm * 2 + bj] = *(const PG8_GAS u32x4*)((const PG8_GAS bf16_t*)G + r_ * ldg + col0 + bj * HALF); \
            if (ADD_PREV) pv[b][mm * 2 + bj] = *(const PG8_GAS u32x4*)((const PG8_GAS bf16_t*)P + r_ * ldc + col0 + bj * HALF); } } while (0)
#define PG8_EG_PROC(g, b) do { _Pragma("unroll") for (int mm = 0; mm < 2; ++mm) _Pragma("unroll") for (int bj = 0; bj < 2; ++bj) { \
            const int ai_ = (g) >> 1, m_ = ((g) & 1) * 2 + mm; \
            f32x4 v0 = acc[ai_][bj][m_][0], v1 = acc[ai_][bj][m_][1]; const u32x4 g_ = gv[b][mm * 2 + bj]; \
            v0[0] *= bf_lo(g_.x); v0[1] *= bf_hi(g_.x); v0[2] *= bf_lo(g_.y); v0[3] *= bf_hi(g_.y); v1[0] *= bf_lo(g_.z); v1[1] *= bf_hi(g_.z); v1[2] *= bf_lo(g_.w); v1[3] *= bf_hi(g_.w); \
            if (ADD_PREV) { const u32x4 p_ = pv[b][mm * 2 + bj]; \
                v0[0] += bf_lo(p_.x); v0[1] += bf_hi(p_.x); v0[2] += bf_lo(p_.y); v0[3] += bf_hi(p_.y); v1[0] += bf_lo(p_.z); v1[1] += bf_hi(p_.z); v1[2] += bf_lo(p_.w); v1[3] += bf_hi(p_.w); } \
            u32x4 w_; w_.x = cvt_pk_bf16(v0[0], v0[1]); w_.y = cvt_pk_bf16(v0[2], v0[3]); w_.z = cvt_pk_bf16(v1[0], v1[1]); w_.w = cvt_pk_bf16(v1[2], v1[3]); \
            st_remap(stg, fr, fq, lane, w_, (PG8_GAS bf16_t*)O + (size_t)(rowb + ai_ * HALF + m_ * 16) * ldc + colb + bj * HALF, ldc); } } while (0)
        PG8_EG_LOAD(0, 0); PG8_EG_LOAD(1, 1);
        PG8_EG_PROC(0, 0); PG8_EG_LOAD(2, 0);
        PG8_EG_PROC(1, 1); PG8_EG_LOAD(3, 1);
        PG8_EG_PROC(2, 0); PG8_EG_PROC(3, 1);
#undef PG8_EG_LOAD
#undef PG8_EG_PROC
    }
};

template <class Epi, class Sched, bool ALIGN_EPI, bool I8 = false>
__device__ __forceinline__ void gemm_phase(PG8_LAS unsigned char* lds, const Gemm g, const Sched& S, const Epi& E) {
    int tid_ = threadIdx.x; asm volatile("" : "+v"(tid_));
    const int tid = tid_, wid = __builtin_amdgcn_readfirstlane(tid >> 6), lane = tid & 63, wr = wid >> 2, wc = wid & 3, fr = lane & 15, fq = lane >> 4;
    const int K = g.K, nt = K / BK;
    unsigned voffA[2], voffB[2];
#pragma unroll
    for (int i = 0; i < 2; ++i) { int R, C; stage_rc(tid * 16 + i * 8192, R, C); const int Rb = Epi::PERM ? ((R & ~31) + perm32(R & 31)) : R;
        voffA[i] = (unsigned)(R * g.lda + C) * 2u; voffB[i] = (unsigned)(Rb * g.ldb + C) * 2u; }
    const size_t kstep = (size_t)(BK * 2);
    const size_t hstepA = (size_t)HALF * g.lda * 2, hstepB = (size_t)HALF * g.ldb * 2;
    const size_t tstepA = 2 * hstepA, tstepB = 2 * hstepB;
    const unsigned ldsw = (unsigned)wid * 1024u;
    const int aoff0 = lds_byte(wr * 64 + fr, fq * 8), aoff1 = lds_byte(wr * 64 + fr, 32 + fq * 8), boff0 = lds_byte(wc * 32 + fr, fq * 8), boff1 = lds_byte(wc * 32 + fr, 32 + fq * 8);
#define PG8_SA(b, h) (((b) * 2 + (h)) * HTB)
#define PG8_SB(b, h) ((4 + (b) * 2 + (h)) * HTB)
#define PG8_STAGE(bufoff, gbase, voff) do { _Pragma("unroll") for (int _i = 0; _i < 2; ++_i) \
        __builtin_amdgcn_global_load_lds((const unsigned*)((const char*)(gbase) + (voff)[_i]), (PG8_LAS unsigned*)(lds + (bufoff) + ldsw + _i * 8192), 16, 0, 0); } while (0)
#define PG8_LDA(dst, b, h) do { _Pragma("unroll") for (int m = 0; m < 4; ++m) _Pragma("unroll") for (int k = 0; k < 2; ++k) dst[m][k] = *(const PG8_LAS bf16x8*)(lds + PG8_SA(b, h) + (k ? aoff1 : aoff0) + m * 2048); } while (0)
#define PG8_LDB(dst, b, h) do { _Pragma("unroll") for (int n = 0; n < 2; ++n) _Pragma("unroll") for (int k = 0; k < 2; ++k) dst[n][k] = *(const PG8_LAS bf16x8*)(lds + PG8_SB(b, h) + (k ? boff1 : boff0) + n * 2048); } while (0)
#define PG8_MMA(ai, bj, At, Bt) do { __builtin_amdgcn_s_setprio(1); _Pragma("unroll") for (int m = 0; m < 4; ++m) _Pragma("unroll") for (int n = 0; n < 2; ++n) _Pragma("unroll") for (int k = 0; k < 2; ++k) \
        { if (I8) acc[ai][bj][m][n] = __builtin_bit_cast(f32x4, __builtin_amdgcn_mfma_i32_16x16x64_i8(__builtin_bit_cast(i32x4, Bt[n][k]), __builtin_bit_cast(i32x4, At[m][k]), __builtin_bit_cast(i32x4, acc[ai][bj][m][n]), 0, 0, 0)); \
          else acc[ai][bj][m][n] = __builtin_amdgcn_mfma_f32_16x16x32_bf16(Bt[n][k], At[m][k], acc[ai][bj][m][n], 0, 0, 0); } __builtin_amdgcn_s_setprio(0); } while (0)
#define PG8_WAIT_V(n) asm volatile("s_waitcnt vmcnt(" #n ")" ::: "memory")
#define PG8_WAIT_L(n) asm volatile("s_waitcnt lgkmcnt(" #n ")" ::: "memory")
#define PG8_BAR __builtin_amdgcn_s_barrier()
#define PG8_SCHED __builtin_amdgcn_sched_barrier(0)
    Unit cur, nxt; int ui = 0;
    if (!S.next(0, cur)) return;
    f32x4 acc[2][2][4][2];
#pragma unroll
    for (int a = 0; a < 2; ++a)
#pragma unroll
        for (int b = 0; b < 2; ++b)
#pragma unroll
            for (int m = 0; m < 4; ++m)
#pragma unroll
                for (int n = 0; n < 2; ++n) acc[a][b][m][n] = (f32x4){0.f, 0.f, 0.f, 0.f};
    bf16x8 At[4][2], B0[2][2], B1[2][2];
    const char* cA = (const char*)g.A + (size_t)cur.pm * tstepA; const char* cB = (const char*)g.Bt + (size_t)cur.pn * tstepB;
    S.a_ready(cur);
    PG8_STAGE(PG8_SB(0, 0), cB, voffB); PG8_STAGE(PG8_SB(0, 1), cB + hstepB, voffB); PG8_STAGE(PG8_SA(0, 0), cA, voffA); PG8_STAGE(PG8_SA(0, 1), cA + hstepA, voffA);
    if (wr == 1) PG8_BAR;
    PG8_WAIT_V(2); PG8_BAR;
    PG8_STAGE(PG8_SB(1, 0), cB + kstep, voffB); PG8_STAGE(PG8_SA(1, 0), cA + kstep, voffA); PG8_STAGE(PG8_SB(1, 1), cB + hstepB + kstep, voffB);
    PG8_WAIT_V(6); PG8_BAR;
    for (;;) {
        const bool has_next = S.next(ui + 1, nxt);
        const char* nA = has_next ? (const char*)g.A + (size_t)nxt.pm * tstepA : cA; const char* nB = has_next ? (const char*)g.Bt + (size_t)nxt.pn * tstepB : cB;
        for (int t = 0; t < nt; t += 2) {
            const bool last = (t == nt - 2);
            const char* a1 = cA + (size_t)(t + 1) * kstep;
            const char* a2 = last ? nA : cA + (size_t)(t + 2) * kstep; const char* b2 = last ? nB : cB + (size_t)(t + 2) * kstep;
            const char* a3 = a2 + kstep; const char* b3 = b2 + kstep;
            if (last && has_next) S.a_ready(nxt);
            PG8_LDB(B0, 0, 0); PG8_LDB(B1, 0, 1); PG8_SCHED; PG8_LDA(At, 0, 0); PG8_STAGE(PG8_SA(1, 1), a1 + hstepA, voffA);
            PG8_WAIT_V(8); PG8_WAIT_L(0); PG8_BAR; PG8_MMA(0, 0, At, B0); PG8_MMA(0, 1, At, B1); PG8_BAR; PG8_SCHED;
            PG8_LDA(At, 0, 1); PG8_STAGE(PG8_SB(0, 0), b2, voffB); PG8_STAGE(PG8_SB(0, 1), b2 + hstepB, voffB); PG8_STAGE(PG8_SA(0, 0), a2, voffA);
            PG8_WAIT_V(8); PG8_WAIT_L(0); PG8_BAR; PG8_MMA(1, 0, At, B0); PG8_MMA(1, 1, At, B1); PG8_BAR; PG8_SCHED;
            PG8_LDB(B0, 1, 0); PG8_LDB(B1, 1, 1); PG8_SCHED; PG8_LDA(At, 1, 0); PG8_STAGE(PG8_SA(0, 1), a2 + hstepA, voffA);
            PG8_WAIT_V(8); PG8_WAIT_L(0); PG8_BAR; PG8_MMA(0, 0, At, B0); PG8_MMA(0, 1, At, B1); PG8_BAR; PG8_SCHED;
            PG8_LDA(At, 1, 1); PG8_STAGE(PG8_SB(1, 0), b3, voffB); PG8_STAGE(PG8_SB(1, 1), b3 + hstepB, voffB); PG8_STAGE(PG8_SA(1, 0), a3, voffA);
            PG8_WAIT_V(8); PG8_WAIT_L(0); PG8_BAR; PG8_MMA(1, 0, At, B0); PG8_MMA(1, 1, At, B1); PG8_BAR; PG8_SCHED;
        }
        if constexpr (ALIGN_EPI) { if (wr == 0) PG8_BAR; }
        E(acc, cur, wr, wc, fr, fq, lds + STAGE_BYTES + wid * 1024, lane); S.done(cur);
        if (!has_next) break;
#pragma unroll
        for (int a = 0; a < 2; ++a)
#pragma unroll
            for (int b = 0; b < 2; ++b)
#pragma unroll
                for (int m = 0; m < 4; ++m)
#pragma unroll
                    for (int n = 0; n < 2; ++n) acc[a][b][m][n] = (f32x4){0.f, 0.f, 0.f, 0.f};
        cur = nxt; cA = nA; cB = nB; ++ui;
        if constexpr (ALIGN_EPI) { if (wr == 1) PG8_BAR; }
    }
    PG8_WAIT_V(0);
    if constexpr (!ALIGN_EPI) { if (wr == 0) PG8_BAR; }
    PG8_BAR;
#undef PG8_SA
#undef PG8_SB
#undef PG8_STAGE
#undef PG8_LDA
#undef PG8_LDB
#undef PG8_MMA
#undef PG8_WAIT_V
#undef PG8_WAIT_L
#undef PG8_BAR
#undef PG8_SCHED
}
}
#define GAS __attribute__((address_space(1)))
#define LAS __attribute__((address_space(3)))
typedef unsigned short bf16;
typedef unsigned v4u __attribute__((ext_vector_type(4)));
typedef float f32x4 __attribute__((ext_vector_type(4)));
typedef short bf16x8 __attribute__((ext_vector_type(8)));
typedef GAS unsigned gu32;
typedef GAS unsigned long long gu64;
#define RLX_AGENT __ATOMIC_RELAXED, __HIP_MEMORY_SCOPE_AGENT
#define LDS_WAIT() asm volatile("s_waitcnt lgkmcnt(0)" ::: "memory")
#define VM_WAIT() asm volatile("s_waitcnt vmcnt(0)" ::: "memory")
__device__ __forceinline__ unsigned long long rt() { return __builtin_amdgcn_s_memrealtime(); }
__device__ __forceinline__ unsigned f2bf(float f) { unsigned u = __builtin_bit_cast(unsigned, f); return (u + 0x7fffu + ((u >> 16) & 1u)) >> 16; }
__device__ __forceinline__ unsigned pk2(float lo, float hi) { return f2bf(lo) | (f2bf(hi) << 16); }

#define XB_TMO      128
#define XB_XCNT(j)  (256  + 64 * (j))
#define XB_XSUB(j)  (1280 + 64 * (j))
#define XB_XGEN(j)  (2304 + 64 * (j))
#define XB_TOP      3328
#define XB_TOPGEN   3392
#define XCD_BAR_WORDS 3456
#define XB_SPIN_CAP (1u << 18)

__device__ __forceinline__ unsigned xb_ld(unsigned* p)              { return __hip_atomic_load(p, __ATOMIC_RELAXED, __HIP_MEMORY_SCOPE_AGENT); }
__device__ __forceinline__ unsigned xb_add(unsigned* p, unsigned v) { return __hip_atomic_fetch_add(p, v, __ATOMIC_RELAXED, __HIP_MEMORY_SCOPE_AGENT); }
__device__ __forceinline__ unsigned xb_xcc_id() { return (unsigned)__builtin_amdgcn_s_getreg((3 << 11) | 20) & 0xFu; }
#define XB_SPIN(cond, bar) do { unsigned _sp = 0; while (cond) { __builtin_amdgcn_s_sleep(1); \
    if ((++_sp & 255u) == 0u) { if (xb_ld(&(bar)[XB_TMO])) break; if (_sp > XB_SPIN_CAP) { atomicAdd(&(bar)[XB_TMO], 1u); break; } } } } while (0)

struct XcdBarrier {
    unsigned* bar; unsigned x;
    volatile LAS unsigned* st;
};

__device__ __forceinline__ XcdBarrier xcd_barrier_post(unsigned* bar, volatile LAS unsigned* st) {
    XcdBarrier b; b.bar = bar; b.x = xb_xcc_id(); b.st = st;
    if (threadIdx.x == 0) (void)xb_add(&bar[XB_XCNT(b.x)], 1u);
    return b;
}
__device__ __forceinline__ void xcd_barrier_complete(unsigned* bar, unsigned x, unsigned& nloc, unsigned& nx) {
    const unsigned G = gridDim.x * gridDim.y * gridDim.z;
    unsigned sum, cnt, mine, sp = 0u;
    for (;;) {
        sum = 0u; cnt = 0u; mine = 0u;
#pragma unroll
        for (unsigned j = 0; j < 16; ++j) { const unsigned c = xb_ld(&bar[XB_XCNT(j)]); sum += c; cnt += (c > 0u) ? 1u : 0u; mine = (j == x) ? c : mine; }
        if (sum == G) break;
        __builtin_amdgcn_s_sleep(1);
        if ((++sp & 255u) == 0u) { if (xb_ld(&bar[XB_TMO])) break; if (sp > XB_SPIN_CAP) { atomicAdd(&bar[XB_TMO], 1u); break; } }
    }
    nloc = mine > 0u ? mine : 1u; nx = cnt > 0u ? cnt : 1u;
}

__device__ __forceinline__ void xcd_barrier(const XcdBarrier& b) {
    asm volatile("s_waitcnt vmcnt(0)" ::: "memory");
    __syncthreads();
    if (threadIdx.x == 0) {
        unsigned* bar = b.bar;
        __builtin_amdgcn_s_waitcnt(0);
        unsigned nloc = b.st[0], nx = b.st[1];
        if (nloc == 0u) { xcd_barrier_complete(bar, b.x, nloc, nx); b.st[0] = nloc; b.st[1] = nx; }
        const unsigned old = xb_add(&bar[XB_XSUB(b.x)], 1u);
        const unsigned gen = old / nloc;
        if (old + 1u == (gen + 1u) * nloc) {
            __builtin_amdgcn_fence(__ATOMIC_RELEASE, "agent");
            asm volatile("s_waitcnt vmcnt(0)" ::: "memory");
            const unsigned og = xb_add(&bar[XB_TOP], 1u);
            const unsigned tg = og / nx;
            if (og + 1u == (tg + 1u) * nx) xb_add(&bar[XB_TOPGEN], 1u);
            else XB_SPIN(xb_ld(&bar[XB_TOPGEN]) == tg, bar);
            __builtin_amdgcn_fence(__ATOMIC_ACQUIRE, "agent");
            xb_add(&bar[XB_XGEN(b.x)], 1u);
            asm volatile("s_waitcnt vmcnt(0)" ::: "memory");
        } else {
            XB_SPIN(xb_ld(&bar[XB_XGEN(b.x)]) == gen, bar);
            __builtin_amdgcn_fence(__ATOMIC_ACQUIRE, "agent");
            asm volatile("s_waitcnt vmcnt(0)" ::: "memory");
        }
    }
    __syncthreads();
}

constexpr int NWAVES = 8;
constexpr int RING_OFF = 0, RING_BYTES = 131072;
constexpr int LDSCTL_OFF = 143360, MISC_OFF = LDSCTL_OFF + 320;
constexpr int LDS_BYTES = 147456;
static_assert(MISC_OFF + 128 <= LDS_BYTES, "LDS map");

struct Frame {
    LAS unsigned char* lds;
    volatile LAS unsigned* MISC;
    gu32* ctl;
    int tid, lane, wave;
    int vcu, G;
};
__device__ __forceinline__ float wave_sum(float v) {
#pragma unroll
    for (int o = 1; o < 64; o <<= 1) v += __shfl_xor(v, o);
    return v;
}

__device__ __forceinline__ float wave_max(float v) {
#pragma unroll
    for (int o = 1; o < 64; o <<= 1) v = fmaxf(v, __shfl_xor(v, o));
    return v;
}
__device__ __forceinline__ unsigned q8pack4(float a, float b, float c, float d) {
    const int ia = (int)__builtin_rintf(a), ib = (int)__builtin_rintf(b), ic = (int)__builtin_rintf(c), id = (int)__builtin_rintf(d);
    return (unsigned)(ia & 255) | ((unsigned)(ib & 255) << 8) | ((unsigned)(ic & 255) << 16) | ((unsigned)(id & 255) << 24);
}
__device__ __forceinline__ void transpose_item(const float* __restrict__ W, int K, int N, bf16* __restrict__ WT, LAS float* scr, int kb, int nb, int lane, const float* __restrict__ gain) {
    const int k0 = 64 * kb, n0 = 64 * nb;
    f32x4 v[16];
#pragma unroll
    for (int i = 0; i < 16; ++i) { const int kk = 4 * i + (lane >> 4); v[i] = *(const f32x4*)(W + (size_t)(k0 + kk) * N + n0 + 4 * (lane & 15)); }
    if (gain) {
#pragma unroll
        for (int i = 0; i < 16; ++i) v[i] = v[i] * gain[k0 + 4 * i + (lane >> 4)]; }
#pragma unroll
    for (int i = 0; i < 16; ++i) { const int kk = 4 * i + (lane >> 4); LAS float* d = scr + kk * 65 + 4 * (lane & 15); d[0] = v[i].x; d[1] = v[i].y; d[2] = v[i].z; d[3] = v[i].w; }
    LDS_WAIT(); asm volatile("" ::: "memory");
    const int c = lane & 7;
#pragma unroll
    for (int j = 0; j < 8; ++j) { const int n = (lane >> 3) + 8 * j; const LAS float* s = scr + (8 * c) * 65 + n;
        v4u o; o.x = pk2(s[0 * 65], s[1 * 65]); o.y = pk2(s[2 * 65], s[3 * 65]); o.z = pk2(s[4 * 65], s[5 * 65]); o.w = pk2(s[6 * 65], s[7 * 65]);
        *(GAS v4u*)(WT + (size_t)(n0 + n) * K + k0 + 8 * c) = o; }
    LDS_WAIT(); asm volatile("" ::: "memory");
}

struct Ptrs {
    const float* x; const float* meta; const float* relb; const float* w_in; const float* w_a; const float* w_b; const float* w_out;
    const float* lq1; const float* lk1; const float* lq2; const float* lk2; const float* dnorm; const float* sinks;
    const float* n_attn_pre; const float* n_attn_post; const float* w_ff1; const float* w_ff2; const float* n_ff_pre; const float* n_ff_post;
    float* out; unsigned char* ws;
};

typedef const __attribute__((address_space(4))) Ptrs* CPtrs;
__device__ __forceinline__ void gate_colmax_pass(Frame& F, const float* __restrict__ w_in, const float* __restrict__ g_in, unsigned* __restrict__ cmax) {
    const int lane = F.lane, w = F.wave;
    LAS f32x4* part = (LAS f32x4*)F.lds;
    for (int it = F.vcu; it < DEPTH * 64; it += F.G) {
        const int l = it / 64, nb = it % 64;
        const float* W = w_in + (size_t)l * DM * INW + C_GA + 64 * nb + 4 * (lane & 15); const float* g = g_in + l * DM;
        f32x4 m = (f32x4){0.f, 0.f, 0.f, 0.f};
        for (int kb = 4 * w; kb < 4 * w + 4; ++kb) {
#pragma unroll
            for (int i = 0; i < 16; ++i) { const int kk = 64 * kb + 4 * i + (lane >> 4); const f32x4 v = *(const f32x4*)(W + (size_t)kk * INW) * g[kk];
                m.x = fmaxf(m.x, fabsf(v.x)); m.y = fmaxf(m.y, fabsf(v.y)); m.z = fmaxf(m.z, fabsf(v.z)); m.w = fmaxf(m.w, fabsf(v.w)); } }
#pragma unroll
        for (int o = 16; o < 64; o <<= 1) { m.x = fmaxf(m.x, __shfl_xor(m.x, o)); m.y = fmaxf(m.y, __shfl_xor(m.y, o)); m.z = fmaxf(m.z, __shfl_xor(m.z, o)); m.w = fmaxf(m.w, __shfl_xor(m.w, o)); }
        if (lane < 16) part[w * 16 + lane] = m;
        __syncthreads();
        if (w == 0 && lane < 16) { f32x4 t = part[lane];
#pragma unroll
            for (int j = 1; j < 8; ++j) { const f32x4 q = part[j * 16 + lane]; t.x = fmaxf(t.x, q.x); t.y = fmaxf(t.y, q.y); t.z = fmaxf(t.z, q.z); t.w = fmaxf(t.w, q.w); }
            unsigned* c = cmax + l * 4096 + 64 * nb + 4 * lane; c[0] = __float_as_uint(t.x); c[1] = __float_as_uint(t.y); c[2] = __float_as_uint(t.z); c[3] = __float_as_uint(t.w); }
        __syncthreads();
    }
}
__device__ __forceinline__ void gate_quant_item(const float* __restrict__ W, signed char* __restrict__ WQ, const unsigned* __restrict__ cmax, float* __restrict__ cs, LAS float* scr, int kb, int nb, int lane, const float* __restrict__ gain) {
    const int k0 = 64 * kb, n0 = 64 * nb;
    f32x4 v[16];
#pragma unroll
    for (int i = 0; i < 16; ++i) { const int kk = 4 * i + (lane >> 4); v[i] = *(const f32x4*)(W + (size_t)(k0 + kk) * INW + C_GA + n0 + 4 * (lane & 15)) * gain[k0 + kk]; }
#pragma unroll
    for (int i = 0; i < 16; ++i) { const int kk = 4 * i + (lane >> 4); LAS float* d = scr + kk * 65 + 4 * (lane & 15); d[0] = v[i].x; d[1] = v[i].y; d[2] = v[i].z; d[3] = v[i].w; }
    LDS_WAIT(); asm volatile("" ::: "memory");
    const int c = lane & 7;
#pragma unroll
    for (int j = 0; j < 8; ++j) { const int n = (lane >> 3) + 8 * j; const LAS float* s = scr + (8 * c) * 65 + n;
        const float mx = __uint_as_float(cmax[n0 + n]), inv = mx > 0.f ? 127.f / mx : 0.f;
        typedef unsigned u32x2 __attribute__((ext_vector_type(2))); u32x2 o;
        o.x = q8pack4(s[0 * 65] * inv, s[1 * 65] * inv, s[2 * 65] * inv, s[3 * 65] * inv); o.y = q8pack4(s[4 * 65] * inv, s[5 * 65] * inv, s[6 * 65] * inv, s[7 * 65] * inv);
        *(GAS u32x2*)(WQ + (size_t)(n0 + n) * DM + k0 + 8 * c) = o;
        if (kb == 0 && c == 0) cs[n0 + n] = mx * (1.f / 127.f); }
    LDS_WAIT(); asm volatile("" ::: "memory");
}
__device__ __forceinline__ void gate_quant_pass(Frame& F, const float* __restrict__ w_in, const float* __restrict__ g_in, signed char* __restrict__ wq, const unsigned* __restrict__ cmax, float* __restrict__ cs) {
    LAS float* scr = (LAS float*)(F.lds + F.wave * 16640);
    const int gw = F.vcu * NWAVES + F.wave, NGW = F.G * NWAVES;
    for (int it = gw; it < DEPTH * 16 * 64; it += NGW) {
        const int l = it / (16 * 64), kb2 = (it / 64) % 16, nb = it % 64;
        gate_quant_item(w_in + (size_t)l * DM * INW, wq + (size_t)l * 4096 * DM, cmax + l * 4096, cs + l * 4096, scr, 2 * kb2, nb, F.lane, g_in + l * DM);
        gate_quant_item(w_in + (size_t)l * DM * INW, wq + (size_t)l * 4096 * DM, cmax + l * 4096, cs + l * 4096, scr, 2 * kb2 + 1, nb, F.lane, g_in + l * DM);
    }
}
__device__ __forceinline__ void p0_transposes(Frame& F, CPtrs PPk) {
    struct { const float *w_in, *w_a, *w_b, *w_out, *w_ff1, *w_ff2, *g_in, *g_ff; unsigned char* ws; } P = {PPk->w_in, PPk->w_a, PPk->w_b, PPk->w_out, PPk->w_ff1, PPk->w_ff2, PPk->n_attn_pre, PPk->n_ff_pre, PPk->ws};
    LAS float* scr = (LAS float*)(F.lds + F.wave * 16640);
    const int gw = F.vcu * NWAVES + F.wave, NGW = F.G * NWAVES;
    constexpr int I_IN = 32 * 132, I_A = 16 * 32, I_O = 32 * 32, I_1 = 32 * 128, I_2 = 128 * 32, I_L = I_IN + 2 * I_A + I_O + I_1 + I_2;
    asm volatile("" ::: "memory");
    bf16* ws_in = (bf16*)(P.ws + WS_WIN); bf16* ws_a = (bf16*)(P.ws + WS_WA); bf16* ws_b = (bf16*)(P.ws + WS_WB); bf16* ws_o = (bf16*)(P.ws + WS_WOUT);
    bf16* ws_1 = (bf16*)(P.ws + WS_W1); bf16* ws_2 = (bf16*)(P.ws + WS_W2);
    for (int it = gw; it < DEPTH * I_L; it += NGW) {
        const int l = it / I_L; int r = it % I_L;
        if (r < I_IN) { transpose_item(P.w_in + (size_t)l * DM * INW, DM, INW, ws_in + (size_t)l * INW * DM, scr, r / 132, r % 132, F.lane, P.g_in + l * DM); continue; } r -= I_IN;
        if (r < I_A) { transpose_item(P.w_a + (size_t)l * 1024 * DM, 1024, DM, ws_a + (size_t)l * DM * 1024, scr, r / 32, r % 32, F.lane, nullptr); continue; } r -= I_A;
        if (r < I_A) { transpose_item(P.w_b + (size_t)l * 1024 * DM, 1024, DM, ws_b + (size_t)l * DM * 1024, scr, r / 32, r % 32, F.lane, nullptr); continue; } r -= I_A;
        if (r < I_O) { transpose_item(P.w_out + (size_t)l * DM * DM, DM, DM, ws_o + (size_t)l * DM * DM, scr, r / 32, r % 32, F.lane, nullptr); continue; } r -= I_O;
        if (r < I_1) { transpose_item(P.w_ff1 + (size_t)l * DM * DFF, DM, DFF, ws_1 + (size_t)l * DFF * DM, scr, r / 128, r % 128, F.lane, P.g_ff + l * DM); continue; } r -= I_1;
        transpose_item(P.w_ff2 + (size_t)l * DFF * DM, DFF, DM, ws_2 + (size_t)l * DM * DFF, scr, r / 32, r % 32, F.lane, nullptr);
    }
}

template <bool HAS_T, bool WRITE_U>
__device__ __forceinline__ void norm_phase(Frame& F, const float* hin_real, const float* hin_meta, float* hout_real, float* hout_meta,
                                           const bf16* T, const float* gpost, const float* gpre, bf16* U, int nrows = NROWS) {
    asm volatile("" : "+s"(hin_real), "+s"(hin_meta), "+s"(hout_real), "+s"(hout_meta), "+s"(T), "+s"(U));
    LAS float* gp = (LAS float*)(F.lds); LAS float* gq = gp + 2048;
    for (int i = F.tid; i < 2048; i += NWAVES * 64) { gp[i] = HAS_T ? gpost[i] : 0.f; gq[i] = WRITE_U ? gpre[i] : 0.f; }
    __syncthreads();
    const int gw = F.vcu * NWAVES + F.wave, NGW = F.G * NWAVES;
    for (int row = gw; row < nrows; row += NGW) {
        const bool real = row < ROW_META;
        const float* hr = real ? hin_real + (size_t)row * DM : hin_meta + (size_t)(row - ROW_META) * DM;
        float* ho = real ? (hout_real ? hout_real + (size_t)row * DM : nullptr) : hout_meta + (size_t)(row - ROW_META) * DM;
        f32x4 hv[4][2]; v4u tv[4];
#pragma unroll
        for (int k = 0; k < 4; ++k) { const int ci = F.lane + 64 * k;
            if (HAS_T) tv[k] = *(const GAS v4u*)(T + (size_t)row * DM + 8 * ci);
            hv[k][0] = *(const GAS f32x4*)(hr + 8 * ci); hv[k][1] = *(const GAS f32x4*)(hr + 8 * ci + 4); }
        if (HAS_T) {
            float ss = 0.f; float tf[4][8];
#pragma unroll
            for (int k = 0; k < 4; ++k) {
                tf[k][0] = pg8::bf_lo(tv[k].x); tf[k][1] = pg8::bf_hi(tv[k].x); tf[k][2] = pg8::bf_lo(tv[k].y); tf[k][3] = pg8::bf_hi(tv[k].y);
                tf[k][4] = pg8::bf_lo(tv[k].z); tf[k][5] = pg8::bf_hi(tv[k].z); tf[k][6] = pg8::bf_lo(tv[k].w); tf[k][7] = pg8::bf_hi(tv[k].w);
#pragma unroll
                for (int e = 0; e < 8; ++e) ss += tf[k][e] * tf[k][e]; }
            const float rstd = 1.0f / sqrtf(wave_sum(ss) * (1.f / DM) + EPS);
#pragma unroll
            for (int k = 0; k < 4; ++k) { const int ci = F.lane + 64 * k; const f32x4 g0 = *(const LAS f32x4*)(gp + 8 * ci), g1 = *(const LAS f32x4*)(gp + 8 * ci + 4);
                hv[k][0].x += tf[k][0] * rstd * g0.x; hv[k][0].y += tf[k][1] * rstd * g0.y; hv[k][0].z += tf[k][2] * rstd * g0.z; hv[k][0].w += tf[k][3] * rstd * g0.w;
                hv[k][1].x += tf[k][4] * rstd * g1.x; hv[k][1].y += tf[k][5] * rstd * g1.y; hv[k][1].z += tf[k][6] * rstd * g1.z; hv[k][1].w += tf[k][7] * rstd * g1.w; }
        }
        if (ho) {
#pragma unroll
            for (int k = 0; k < 4; ++k) { const int ci = F.lane + 64 * k; *(GAS f32x4*)(ho + 8 * ci) = hv[k][0]; *(GAS f32x4*)(ho + 8 * ci + 4) = hv[k][1]; }
        }
        if (WRITE_U) {
            float ss = 0.f;
#pragma unroll
            for (int k = 0; k < 4; ++k) ss += (hv[k][0].x * hv[k][0].x + hv[k][0].y * hv[k][0].y) + (hv[k][0].z * hv[k][0].z + hv[k][0].w * hv[k][0].w)
                                            + (hv[k][1].x * hv[k][1].x + hv[k][1].y * hv[k][1].y) + (hv[k][1].z * hv[k][1].z + hv[k][1].w * hv[k][1].w);
            const float rstd = 1.0f / sqrtf(wave_sum(ss) * (1.f / DM) + EPS);
#pragma unroll
            for (int k = 0; k < 4; ++k) { const int ci = F.lane + 64 * k; const f32x4 g0 = *(const LAS f32x4*)(gq + 8 * ci), g1 = *(const LAS f32x4*)(gq + 8 * ci + 4);
                v4u o; o.x = pk2(hv[k][0].x * rstd * g0.x, hv[k][0].y * rstd * g0.y); o.y = pk2(hv[k][0].z * rstd * g0.z, hv[k][0].w * rstd * g0.w);
                o.z = pk2(hv[k][1].x * rstd * g1.x, hv[k][1].y * rstd * g1.y); o.w = pk2(hv[k][1].z * rstd * g1.z, hv[k][1].w * rstd * g1.w);
                *(GAS v4u*)(U + (size_t)row * DM + 8 * ci) = o; }
        }
    }
    __syncthreads();
}


template <int MODE>
__device__ __forceinline__ void resid_phase(Frame& F, const float* x, const float* meta, bf16* H, float* RS, const bf16* T, const float* gpost, float* out, signed char* HQ = nullptr, float* QS = nullptr) {
    asm volatile("" : "+s"(x), "+s"(meta), "+s"(H), "+s"(RS), "+s"(T), "+s"(out));
    LAS float* gp = (LAS float*)(F.lds);
    if (MODE != 0) { for (int i = F.tid; i < 2048; i += NWAVES * 64) gp[i] = gpost[i]; }
    __syncthreads();
    const int gw = F.vcu * NWAVES + F.wave, NGW = F.G * NWAVES;
    const int nrows = (MODE == 2) ? ROW_META : NROWS;
    for (int row = gw; row < nrows; row += NGW) {
        f32x4 hv[4][2];
        if (MODE == 0) {
            const float* hr = row < ROW_META ? x + (size_t)row * DM : meta + (size_t)(row - ROW_META) * DM;
#pragma unroll
            for (int k = 0; k < 4; ++k) { const int ci = F.lane + 64 * k; hv[k][0] = *(const GAS f32x4*)(hr + 8 * ci); hv[k][1] = *(const GAS f32x4*)(hr + 8 * ci + 4); }
        } else {
            v4u tv[4], hb[4];
#pragma unroll
            for (int k = 0; k < 4; ++k) { const int ci = F.lane + 64 * k; tv[k] = *(const GAS v4u*)(T + (size_t)row * DM + 8 * ci); hb[k] = *(const GAS v4u*)(H + (size_t)row * DM + 8 * ci); }
            float ss = 0.f; float tf[4][8];
#pragma unroll
            for (int k = 0; k < 4; ++k) {
                tf[k][0] = pg8::bf_lo(tv[k].x); tf[k][1] = pg8::bf_hi(tv[k].x); tf[k][2] = pg8::bf_lo(tv[k].y); tf[k][3] = pg8::bf_hi(tv[k].y);
                tf[k][4] = pg8::bf_lo(tv[k].z); tf[k][5] = pg8::bf_hi(tv[k].z); tf[k][6] = pg8::bf_lo(tv[k].w); tf[k][7] = pg8::bf_hi(tv[k].w);
#pragma unroll
                for (int e = 0; e < 8; ++e) ss += tf[k][e] * tf[k][e]; }
            const float rstd = 1.0f / sqrtf(wave_sum(ss) * (1.f / DM) + EPS);
#pragma unroll
            for (int k = 0; k < 4; ++k) { const int ci = F.lane + 64 * k; const f32x4 g0 = *(const LAS f32x4*)(gp + 8 * ci), g1 = *(const LAS f32x4*)(gp + 8 * ci + 4);
                hv[k][0].x = pg8::bf_lo(hb[k].x) + tf[k][0] * rstd * g0.x; hv[k][0].y = pg8::bf_hi(hb[k].x) + tf[k][1] * rstd * g0.y; hv[k][0].z = pg8::bf_lo(hb[k].y) + tf[k][2] * rstd * g0.z; hv[k][0].w = pg8::bf_hi(hb[k].y) + tf[k][3] * rstd * g0.w;
                hv[k][1].x = pg8::bf_lo(hb[k].z) + tf[k][4] * rstd * g1.x; hv[k][1].y = pg8::bf_hi(hb[k].z) + tf[k][5] * rstd * g1.y; hv[k][1].z = pg8::bf_lo(hb[k].w) + tf[k][6] * rstd * g1.z; hv[k][1].w = pg8::bf_hi(hb[k].w) + tf[k][7] * rstd * g1.w; }
        }
        if (MODE == 2) {
            float* ho = out + (size_t)row * DM;
#pragma unroll
            for (int k = 0; k < 4; ++k) { const int ci = F.lane + 64 * k; *(GAS f32x4*)(ho + 8 * ci) = hv[k][0]; *(GAS f32x4*)(ho + 8 * ci + 4) = hv[k][1]; }
        } else {
            float ss = 0.f;
#pragma unroll
            for (int k = 0; k < 4; ++k) ss += (hv[k][0].x * hv[k][0].x + hv[k][0].y * hv[k][0].y) + (hv[k][0].z * hv[k][0].z + hv[k][0].w * hv[k][0].w)
                                            + (hv[k][1].x * hv[k][1].x + hv[k][1].y * hv[k][1].y) + (hv[k][1].z * hv[k][1].z + hv[k][1].w * hv[k][1].w);
            const float rstd = 1.0f / sqrtf(wave_sum(ss) * (1.f / DM) + EPS);
            if (F.lane == 0) RS[row] = rstd;
            if (HQ) {
                float am = 0.f;
#pragma unroll
                for (int k = 0; k < 4; ++k) am = fmaxf(fmaxf(fmaxf(am, fmaxf(fabsf(hv[k][0].x), fabsf(hv[k][0].y))), fmaxf(fabsf(hv[k][0].z), fabsf(hv[k][0].w))), fmaxf(fmaxf(fabsf(hv[k][1].x), fabsf(hv[k][1].y)), fmaxf(fabsf(hv[k][1].z), fabsf(hv[k][1].w))));
                am = wave_max(am);
                const float inv = am > 0.f ? 127.f / am : 0.f;
                if (F.lane == 0) QS[row] = rstd * am * (1.f / 127.f);
#pragma unroll
                for (int k = 0; k < 4; ++k) { const int ci = F.lane + 64 * k; typedef unsigned u32x2 __attribute__((ext_vector_type(2))); u32x2 o;
                    o.x = q8pack4(hv[k][0].x * inv, hv[k][0].y * inv, hv[k][0].z * inv, hv[k][0].w * inv); o.y = q8pack4(hv[k][1].x * inv, hv[k][1].y * inv, hv[k][1].z * inv, hv[k][1].w * inv);
                    *(GAS u32x2*)(HQ + (size_t)row * DM + 8 * ci) = o; }
            }
#pragma unroll
            for (int k = 0; k < 4; ++k) { const int ci = F.lane + 64 * k;
                v4u o; o.x = pk2(hv[k][0].x, hv[k][0].y); o.y = pk2(hv[k][0].z, hv[k][0].w); o.z = pk2(hv[k][1].x, hv[k][1].y); o.w = pk2(hv[k][1].z, hv[k][1].w);
                *(GAS v4u*)(H + (size_t)row * DM + 8 * ci) = o; }
        }
    }
    __syncthreads();
}

template <class Epi>
__device__ __forceinline__ void meta_gemm(LAS unsigned char* lds, const bf16* A, int lda, const bf16* Bt, int ldb, int N, int K, int vcu, int G, int tid, const Epi& E) {
    const int lane = tid & 63, w = __builtin_amdgcn_readfirstlane(tid >> 6), fr = lane & 15, fq = lane >> 4;
    const int kw = K >> 3;
    LAS f32x4* part = (LAS f32x4*)lds;
    for (int tile = vcu; tile < (N >> 4); tile += G) {
        const bf16* ap = A + (size_t)fr * lda + w * kw + 8 * fq;
        const bf16* bp = Bt + (size_t)(tile * 16 + fr) * ldb + w * kw + 8 * fq;
        f32x4 acc = (f32x4){0.f, 0.f, 0.f, 0.f};
        for (int k = 0; k < kw; k += 128) {
            bf16x8 a[4], b[4];
#pragma unroll
            for (int j = 0; j < 4; ++j) { a[j] = *(const GAS bf16x8*)(ap + k + 32 * j); b[j] = *(const GAS bf16x8*)(bp + k + 32 * j); }
#pragma unroll
            for (int j = 0; j < 4; ++j) acc = __builtin_amdgcn_mfma_f32_16x16x32_bf16(b[j], a[j], acc, 0, 0, 0);
        }
        part[w * 64 + lane] = acc;
        __syncthreads();
        if (w == 0) { f32x4 s = part[lane];
#pragma unroll
            for (int j = 1; j < 8; ++j) s += part[j * 64 + lane];
            E(fr, tile * 16 + 4 * fq, s); }
        __syncthreads();
    }
}
__device__ __forceinline__ void st4bf(bf16* p, f32x4 v) { typedef unsigned u32x2 __attribute__((ext_vector_type(2))); u32x2 o; o.x = pk2(v.x, v.y); o.y = pk2(v.z, v.w); *(GAS u32x2*)p = o; }
__device__ __forceinline__ f32x4 ld4bf(const bf16* p) { typedef unsigned u32x2 __attribute__((ext_vector_type(2))); const u32x2 u = *(const GAS u32x2*)p; return (f32x4){pg8::bf_lo(u.x), pg8::bf_hi(u.x), pg8::bf_lo(u.y), pg8::bf_hi(u.y)}; }
struct MEpiZ { bf16* Z; const float* rs; __device__ __forceinline__ void operator()(int r, int c, f32x4 v) const {
    v = v * rs[ROW_META + r];
    if (c < 1024 || (c >= 3072 && c < 4096)) v = v * QSCALE;
    else if (c >= C_GA) { v.x = pg8::sigmoidf_fast(v.x); v.y = pg8::sigmoidf_fast(v.y); v.z = pg8::sigmoidf_fast(v.z); v.w = pg8::sigmoidf_fast(v.w); }
    st4bf(Z + (size_t)(ROW_META + r) * INW + c, v); } };
template <int ACT> struct MEpiPlain { bf16* O; int ldc; const float* rs; __device__ __forceinline__ void operator()(int r, int c, f32x4 v) const {
    if (ACT == 1) { v = v * rs[ROW_META + r]; v.x = fmaxf(v.x, 0.f); v.y = fmaxf(v.y, 0.f); v.z = fmaxf(v.z, 0.f); v.w = fmaxf(v.w, 0.f); v = v * v; }
    st4bf(O + (size_t)(ROW_META + r) * ldc + c, v); } };
template <bool ADD_PREV> struct MEpiGate { bf16* O; const bf16* Gt; const bf16* Pv; __device__ __forceinline__ void operator()(int r, int c, f32x4 v) const {
    const size_t row = (size_t)(ROW_META + r); v = v * ld4bf(Gt + row * INW + c);
    if (ADD_PREV) v = v + ld4bf(Pv + row * DM + c);
    st4bf(O + row * DM + c, v); } };

__device__ __forceinline__ int t5_bucket(int dist) {
    const int n = dist < 0 ? 0 : dist;
    if (n < 16) return n;
    int large = 16 + (int)(logf((float)n * (1.f / 16.f)) / 2.0794415416798357f * 16.f);
    return large > 31 ? 31 : large;
}

constexpr int LUTN_G = 448, N_LUT_TABLES = 40;
__device__ __forceinline__ void build_lut_tables(Frame& F, const float* __restrict__ relb, float* __restrict__ lutg) {
    for (int i = F.vcu * NWAVES * 64 + F.tid; i < N_LUT_TABLES * LUTN_G; i += F.G * NWAVES * 64) {
        const int tb = i / LUTN_G, d = 255 - (i % LUTN_G); float v;
        if (tb < 8) { if (d < 0) v = NEGBIG; else if (d < 128) v = (relb[t5_bucket(d) * NBIAS + tb] - relb[31 * NBIAS + tb]) * LOG2E; else v = 0.f; }
        else { const int col = 8 + ((tb - 8) >> 1), kind = (tb - 8) & 1;
            if (d < 0) v = NEGBIG; else if (d < 128) v = relb[t5_bucket(d) * NBIAS + col] * LOG2E; else v = kind ? relb[31 * NBIAS + col] * LOG2E : NEGBIG; }
        lutg[i] = v;
    }
}

#if ATTN_NAIVE
template <bool DIFF>
__global__ void __launch_bounds__(512) naive_attn(const bf16* __restrict__ Z, bf16* __restrict__ YAB, const float* __restrict__ relb, const float* lq1, const float* lk1, const float* lq2, const float* lk2,
                                                   const float* __restrict__ dnorm, const float* __restrict__ sinks, int layer) {
    constexpr int KT = 16, DVT = DIFF ? 64 : 32, KW = DIFF ? 128 : 64, VW = DIFF ? 128 : 64;
    extern __shared__ __attribute__((aligned(16))) unsigned char smem[];
    float* Ksh = (float*)smem;
    float* Vsh = Ksh + 32 * 128;
    float* biasL = Vsh + 32 * 128;
    int* kposs = (int*)(biasL + 2 * 132);
    float* red = (float*)(kposs + 64);
    float* Osh = red + 8;
    const int tid = threadIdx.x, row = tid & 127, cj = (tid >> 7) & 1, dvh = tid >> 8;
    const int unit = blockIdx.x, hh = unit / 129, qb = unit % 129;
    const bool metablk = (qb == 128);
    const int qrow = metablk ? ROW_META + row : 128 * qb + row;
    const int qpos = metablk ? 112 + row : 128 + 128 * qb + row;
    float lam = 0.f, lam_init = 0.f;
    if (DIFF) {
        lam_init = 0.8f - 0.6f * expf(-0.3f * (float)layer);
        if (tid < 64) { float a = lq1[layer * 64 + tid] * lk1[layer * 64 + tid], b = lq2[layer * 64 + tid] * lk2[layer * 64 + tid];
#pragma unroll
            for (int o = 1; o < 64; o <<= 1) { a += __shfl_xor(a, o); b += __shfl_xor(b, o); }
            if (tid == 0) { red[0] = a; red[1] = b; } }
    }
    for (int i = tid; i < 2 * 129; i += 512) { const int j = i / 129, d = i % 129; const int col = DIFF ? hh : 8 + 2 * hh + j; biasL[j * 132 + d] = relb[t5_bucket(d) * NBIAS + col] * LOG2E; }
    __syncthreads();
    if (DIFF) lam = expf(red[0]) - expf(red[1]) + lam_init;
    const int qcol = DIFF ? C_QA + hh * 128 + cj * 64 : C_QB + (2 * hh + cj) * 64;
    const int kcol = DIFF ? C_KA + hh * 128 : C_KB + (hh >> 2) * 64;
    const int vcol = DIFF ? C_VA + hh * 128 : C_VB + (hh >> 2) * 64;
    float q[64];
    { const bf16* qp = Z + (size_t)qrow * INW + qcol;
#pragma unroll
      for (int i = 0; i < 64; ++i) q[i] = pg8::bf_lo((unsigned)qp[i]); }
    float o[DVT];
#pragma unroll
    for (int i = 0; i < DVT; ++i) o[i] = 0.f;
    float m = NEGBIG, l = 0.f;
    if (!DIFF) { m = sinks[layer * 16 + 2 * hh + cj] * LOG2E; l = 1.f; }
    const int t_s = DIFF ? 0 : (qb >= 1 && !metablk ? 128 * (qb - 1) : 0);
    const int nreal = metablk ? 0 : 128 * qb + 128 - t_s;
    const int ns = 16 + nreal;
    const float* bl = biasL + (DIFF ? 0 : cj) * 132;
    for (int s0 = 0; s0 < ns; s0 += KT) {
        __syncthreads();
        for (int i = tid; i < KT * KW; i += 512) { const int kk = i / KW, c = i % KW, s = s0 + kk; float v = 0.f;
            if (s < ns) { const int krow = s < 16 ? ROW_META + s : t_s + s - 16; v = pg8::bf_lo((unsigned)Z[(size_t)krow * INW + kcol + c]); } Ksh[kk * 128 + c] = v; }
        for (int i = tid; i < KT * VW; i += 512) { const int kk = i / VW, c = i % VW, s = s0 + kk; float v = 0.f;
            if (s < ns) { const int krow = s < 16 ? ROW_META + s : t_s + s - 16; v = pg8::bf_lo((unsigned)Z[(size_t)krow * INW + vcol + c]); } Vsh[kk * 128 + c] = v; }
        if (tid < KT) { const int s = s0 + tid; kposs[tid] = s >= ns ? (1 << 30) : (s < 16 ? 112 + s : 128 + t_s + s - 16); kposs[32 + tid] = (s < 16) ? 1 : 0; }
        __syncthreads();
        float sc[KT]; float tmax = NEGBIG;
#pragma unroll
        for (int kk = 0; kk < KT; ++kk) {
            const float* kr = Ksh + kk * 128 + (DIFF ? cj * 64 : 0); float a = 0.f;
#pragma unroll
            for (int i = 0; i < 64; ++i) a += q[i] * kr[i];
            const int dist = qpos - kposs[kk]; const bool ismeta = kposs[32 + kk] != 0;
            bool ok = dist >= 0; if (!DIFF && !ismeta) ok = ok && dist < 128;
            const int di = dist < 0 ? 0 : (dist > 128 ? 128 : dist);
            a = ok ? a + bl[di] : NEGBIG;
            sc[kk] = a; tmax = fmaxf(tmax, a);
        }
        const float mn = fmaxf(m, tmax), alpha = exp2f(m - mn);
        l *= alpha;
#pragma unroll
        for (int i = 0; i < DVT; ++i) o[i] *= alpha;
        m = mn;
#pragma unroll
        for (int kk = 0; kk < KT; ++kk) {
            const float p = sc[kk] > -1e29f ? exp2f(sc[kk] - m) : 0.f;
            l += p; const float* vr = Vsh + kk * 128 + dvh * DVT;
#pragma unroll
            for (int i = 0; i < DVT; ++i) o[i] += p * vr[i];
        }
    }
    const float rl = 1.f / l;
    if (DIFF) {
        __syncthreads();
        if (cj == 1) {
#pragma unroll
            for (int i = 0; i < DVT; ++i) Osh[row * 129 + dvh * 64 + i] = lam * o[i] * rl; }
        __syncthreads();
        if (cj == 0) {
#pragma unroll
            for (int i = 0; i < DVT; ++i) Osh[row * 129 + dvh * 64 + i] = o[i] * rl - Osh[row * 129 + dvh * 64 + i]; }
        __syncthreads();
        if (tid < 128 && (!metablk || tid < 16)) {
            float ss = 0.f;
            for (int d = 0; d < 128; ++d) { const float v = Osh[tid * 129 + d]; ss += v * v; }
            const float rstd = 1.0f / sqrtf(ss * (1.f / 128.f) + EPS) * (1.f - lam_init);
            const int orow = metablk ? ROW_META + tid : 128 * qb + tid;
            for (int d = 0; d < 128; ++d) YAB[(size_t)orow * DM + hh * 128 + d] = (bf16)f2bf(Osh[tid * 129 + d] * rstd * dnorm[layer * 128 + d]);
        }
    } else {
        if (!metablk || row < 16) {
#pragma unroll
            for (int i = 0; i < DVT; ++i) YAB[(size_t)qrow * DM + 1024 + (2 * hh + cj) * 64 + dvh * 32 + i] = (bf16)f2bf(o[i] * rl); }
    }
}
constexpr int NAIVE_LDS = (32 * 128 * 2 + 2 * 132 + 64 + 8 + 128 * 129) * 4;
#endif

namespace att {
typedef float f32x16 __attribute__((ext_vector_type(16)));
typedef short s16x4 __attribute__((ext_vector_type(4)));
typedef short v4i16_t __attribute__((ext_vector_type(4)));
constexpr int LUTN = 448;
constexpr int SLOT = 16384, CK = 8704, KSLOT = 2 * CK, L_K = 0, L_V = 3 * KSLOT, L_LUT = L_V + 3 * SLOT, L_WSF = L_LUT + 4 * LUTN * 4, L_SUBG = L_WSF + 8 * 256, L_END = L_SUBG + 512;
static_assert(L_END <= RING_BYTES, "attention LDS");
constexpr int XD_STRIDE = 132, XS_STRIDE = 68;
constexpr float THR = 30.0f;
__device__ __forceinline__ int crow(int r, int hi) { return (r & 3) + 8 * (r >> 2) + 4 * hi; }
__device__ __forceinline__ void glds16(const void* gsrc, unsigned lds_dst) { unsigned keep;
    asm volatile("s_mov_b32 %0, m0\n\ts_mov_b32 m0, %2\n\ts_nop 0\n\tglobal_load_lds_dwordx4 %1, off\n\ts_mov_b32 m0, %0" : "=&s"(keep) : "v"(gsrc), "s"(lds_dst) : "memory"); }
template <int IMM> __device__ __forceinline__ void glds16s(const void* sbase, unsigned voff, unsigned lds_dst_) { const unsigned lds_dst = lds_dst_ - (unsigned)IMM;
    asm volatile("s_mov_b32 m0, %2\n\ts_nop 0\n\tglobal_load_lds_dwordx4 %0, %1 offset:%c3" :: "v"(voff), "s"(sbase), "s"(lds_dst), "i"(IMM) : "memory", "m0"); }
__device__ __forceinline__ unsigned cvtpk(float lo, float hi) { typedef float f2 __attribute__((ext_vector_type(2))); typedef __bf16 b2 __attribute__((ext_vector_type(2))); f2 v = {lo, hi}; b2 b = __builtin_convertvector(v, b2); return __builtin_bit_cast(unsigned, b); }
__device__ __forceinline__ s16x4 vtr(const LAS unsigned char* p) { return __builtin_bit_cast(s16x4, __builtin_amdgcn_ds_read_tr16_b64_v4i16((LAS v4i16_t*)p)); }
__device__ __forceinline__ float swap_add(float v) { auto rr = __builtin_amdgcn_permlane32_swap(__float_as_uint(v), __float_as_uint(v), false, false); return __uint_as_float(rr[0]) + __uint_as_float(rr[1]); }
__device__ __forceinline__ float swap_max(float v) { auto rr = __builtin_amdgcn_permlane32_swap(__float_as_uint(v), __float_as_uint(v), false, false); return fmaxf(__uint_as_float(rr[0]), __uint_as_float(rr[1])); }
#define ATT_MFMA(a, b, c) __builtin_amdgcn_mfma_f32_32x32x16_bf16(a, b, c, 0, 0, 0)

template <bool DIFF>
__device__ __forceinline__ void attn_epilogue(LAS unsigned char* lds, bf16* __restrict__ YAB, f32x16 (&o)[DIFF ? 4 : 2], float lsum, int tid, int hh, int qb, float lam, float lam_scale);
template <bool DIFF, bool FAST>
__device__ __forceinline__ bool attn_body(LAS unsigned char* lds, const bf16* __restrict__ Z, bf16* __restrict__ YAB, const float* __restrict__ lutg,
                                          int hh, int qb, float lam, float lam_scale, float sink2, int tid_in, unsigned useq) {
    constexpr int NDB = DIFF ? 4 : 2;
    constexpr bool fast = FAST;
    int tid = tid_in; asm volatile("" : "+v"(tid));
    const int lane = tid & 63, w = __builtin_amdgcn_readfirstlane(tid >> 6), cj = w >> 2, wq = w & 3, l31 = lane & 31, hi = lane >> 5;
    const bool metablk = (qb == 128);
    const int qrow = (metablk ? ROW_META : 128 * qb) + 32 * wq + l31;
    const int qpos = (metablk ? 112 : 128 + 128 * qb) + 32 * wq + l31;
    const int qcol = DIFF ? C_QA + hh * 128 + cj * 64 : C_QB + (2 * hh + cj) * 64;
    const int kcol = DIFF ? C_KA + hh * 128 : C_KB + (hh >> 2) * 64;
    const int vcol = DIFF ? C_VA + hh * 128 : C_VB + (hh >> 2) * 64;
    const int rt0 = DIFF ? 0 : (2 * qb - 2 > 0 ? 2 * qb - 2 : 0);
    const int nreal = metablk ? 0 : 2 * qb + 2 - rt0;
    const int NT = 1 + nreal;
    const int rt_special = 2 * qb - 2;
    LAS float* LUT = (LAS float*)(lds + L_LUT);
    if (DIFF) { if (tid < LUTN) LUT[tid] = lutg[hh * LUTN + tid]; }
    else { for (int i = tid; i < 4 * LUTN; i += NWAVES * 64) { const int k = i / LUTN, e = i % LUTN; LUT[i] = lutg[(8 + 2 * (2 * hh + (k & 1)) + (k >> 1)) * LUTN + e]; } }
    const unsigned lds0 = (unsigned)(uintptr_t)lds;
    auto tile_row0 = [&](int t) { return t == 0 ? ROW_META : 64 * (rt0 + t - 1); };
    const unsigned koff = (unsigned)(((8 * w + (lane >> 3)) * INW + kcol + ((lane & 7) ^ (lane >> 3)) * 8) * 2);
    const unsigned voff = (unsigned)(((8 * w + ((lane >> 2) & 7)) * INW + vcol + (lane >> 5) * 32 + (lane & 3) * 8) * 2);
    const unsigned kgb = (unsigned)(w * 1024 + 128 * ((w >> 1) & 1) + 256 * (w >> 2));
    auto dma_k = [&](int t, int sl) {
        const char* zb = (const char*)Z + (size_t)tile_row0(t) * (INW * 2);
        const unsigned dst = (unsigned)__builtin_amdgcn_readfirstlane(lds0 + L_K + sl + (sl >> 4) + kgb);
        glds16s<0>(zb, koff, dst);
        if (DIFF) glds16s<128>(zb, koff, dst + CK);
    };
    auto dma_v = [&](int t, int sl) {
        const char* zb = (const char*)Z + (size_t)tile_row0(t) * (INW * 2);
        const unsigned dst = (unsigned)__builtin_amdgcn_readfirstlane(lds0 + L_V + sl + w * 2048);
        glds16s<0>(zb, voff, dst);
        if (DIFF) glds16s<128>(zb, voff, dst + 1024);
    };
    bf16x8 qr[4];
#pragma unroll
    for (int d0 = 0; d0 < 4; ++d0) qr[d0] = *(const bf16x8*)(Z + (size_t)qrow * INW + qcol + d0 * 16 + hi * 8);
    dma_k(0, 0); dma_v(0, 0); if (NT > 1) dma_k(1, SLOT); if (NT > 2) dma_k(2, 2 * SLOT);
    bool mz = fast || DIFF || (fabsf(sink2) <= THR);
    float m = mz ? 0.f : sink2, lsum = (!DIFF && hi == 0) ? (mz ? __builtin_amdgcn_exp2f(sink2) : 1.f) : 0.f;
    f32x16 o[NDB];
#pragma unroll
    for (int db = 0; db < NDB; ++db) o[db] = f32x16{};
    float nm = -m;
    LAS float* wsf = (LAS float*)(lds + L_WSF) + w * 64;
    const int kr_ = l31 & 7, kg_ = l31 >> 3, kt_ = kr_ ^ hi;
    const LAS unsigned char* kp0 = lds + L_K + (DIFF ? cj * CK : 0) + kg_ * 1024 + 128 * ((kg_ >> 1) & 1) + 128 * kr_;
    const int kx0 = 16 * (0 ^ kt_), kx1 = 16 * (2 ^ kt_), kx2 = 16 * (4 ^ kt_), kx3 = 16 * (6 ^ kt_);
    const LAS unsigned char* vp0 = lds + L_V + ((lane >> 4) & 1) * 32 + (lane & 3) * 8 + (4 * hi + ((lane & 15) >> 2)) * 64;
    bf16x8 kf[8];
    f32x16 pA0, pA1, pB0, pB1;
    v4u pw0, pw1, pw2, pw3;
    bool resc = false;
    int sl_prev = 0, sl_cur = 0, sl_next = SLOT;
#define ATT_SBAR() __builtin_amdgcn_sched_barrier(0)
#define ATT_PIN(x) asm volatile("" : "+v"(x))
#define ATT_ROT() do { sl_prev = sl_cur; sl_cur = sl_next; sl_next = (sl_next == 2 * SLOT) ? 0 : sl_next + SLOT; } while (0)
#define ATT_WAITBAR(N) asm volatile("s_waitcnt vmcnt(" #N ") lgkmcnt(0)\n\ts_barrier" ::: "memory")
#define ATT_KLD2(kp, j) do { kf[2 * (j)] = *(const LAS bf16x8*)((kp) + kx##j); kf[2 * (j) + 1] = *(const LAS bf16x8*)((kp) + kx##j + 4352); } while (0)
#define ATT_SPECIAL(C0, C1, t) do { const int rt_ = rt0 + (t) - 1; \
        if ((t) == 0) { const LAS float* lut_ = DIFF ? LUT : LUT + (2 + cj) * LUTN; const int base_ = 255 - (qpos - 112 - 4 * hi); \
            _Pragma("unroll") for (int r = 0; r < 16; ++r) { \
                if (r < 8) { int idx_ = base_ + ((r & 3) + 8 * (r >> 2)); idx_ = idx_ < 0 ? 0 : (idx_ > LUTN - 1 ? LUTN - 1 : idx_); C0[r] += lut_[idx_]; } else C0[r] = nb_; \
                C1[r] = nb_; } } \
        else if (!DIFF || rt_ >= rt_special) { int base_ = 255 - (qpos - (128 + 64 * rt_) - 4 * hi); base_ = base_ < 0 ? 0 : (base_ > LUTN - 96 ? LUTN - 96 : base_); \
            const LAS float* lut_ = (DIFF ? LUT : LUT + cj * LUTN) + base_; \
            _Pragma("unroll") for (int r = 0; r < 16; ++r) { C0[r] += lut_[(r & 3) + 8 * (r >> 2)]; C1[r] += lut_[(r & 3) + 8 * (r >> 2) + 32]; } } } while (0)
#define ATT_ROWMAX(C0, C1, rm) do { float a_ = fmaxf(fmaxf(C0[0], C0[1]), C1[0]), b_ = fmaxf(fmaxf(C0[2], C0[3]), C1[1]); a_ = fmaxf(fmaxf(a_, C1[2]), C1[3]); \
        _Pragma("unroll") for (int r = 4; r < 16; r += 4) { a_ = fmaxf(fmaxf(a_, C0[r]), C0[r + 1]); b_ = fmaxf(fmaxf(b_, C0[r + 2]), C0[r + 3]); a_ = fmaxf(fmaxf(a_, C1[r]), C1[r + 1]); b_ = fmaxf(fmaxf(b_, C1[r + 2]), C1[r + 3]); } \
        rm = swap_max(fmaxf(a_, b_)); } while (0)
#define ATT_RESC() do { if (resc) { asm volatile("s_waitcnt lgkmcnt(0)" ::: "memory"); \
        _Pragma("unroll") for (int g = 0; g < 4; ++g) { const f32x4 fv_ = *(const LAS f32x4*)(wsf + 8 * g + 4 * hi); \
            _Pragma("unroll") for (int db = 0; db < NDB; ++db) { o[db][4 * g + 0] *= fv_.x; o[db][4 * g + 1] *= fv_.y; o[db][4 * g + 2] *= fv_.z; o[db][4 * g + 3] *= fv_.w; } } } } while (0)
#define ATT_PK(P, B) cvtpk(P[B], P[(B) + 1])
#define ATT_PAF(k) __builtin_bit_cast(bf16x8, pw##k)
    float nb_ = NEGBIG; asm volatile("" : "+v"(nb_));
    asm volatile("s_waitcnt vmcnt(0)" ::: "memory");
    asm volatile("s_waitcnt lgkmcnt(0)\n\ts_barrier" ::: "memory");
    {
        const LAS unsigned char* kp = kp0;
        ATT_KLD2(kp, 0); ATT_KLD2(kp, 1); ATT_KLD2(kp, 2); ATT_KLD2(kp, 3);
        if (mz) { pA0 = ATT_MFMA(kf[0], qr[0], f32x16{}); pA1 = ATT_MFMA(kf[1], qr[0], f32x16{}); }
        else {
#pragma unroll
            for (int r = 0; r < 16; ++r) { pA0[r] = nm; pA1[r] = nm; }
            pA0 = ATT_MFMA(kf[0], qr[0], pA0); pA1 = ATT_MFMA(kf[1], qr[0], pA1); }
#pragma unroll
        for (int d0 = 1; d0 < 4; ++d0) { pA0 = ATT_MFMA(kf[2 * d0], qr[d0], pA0); pA1 = ATT_MFMA(kf[2 * d0 + 1], qr[d0], pA1); }
        asm volatile("s_waitcnt lgkmcnt(0)\n\ts_barrier" ::: "memory");
        if (3 < NT) dma_k(3, 0);
        if (1 < NT) dma_v(1, SLOT);
        ATT_SPECIAL(pA0, pA1, 0);
        float rm = 0.f; if (!fast) ATT_ROWMAX(pA0, pA1, rm);
        if (!fast && __any(rm > THR || (DIFF && rm < -THR))) {
            const float dl = DIFF ? rm : fmaxf(rm, 0.f);
            m += dl; mz = false;
#pragma unroll
            for (int r = 0; r < 16; ++r) { pA0[r] -= dl; pA1[r] -= dl; }
            nm = -m;
            if (!DIFF) lsum *= __builtin_amdgcn_exp2f(-dl);
        }
#pragma unroll
        for (int r = 0; r < 16; ++r) { pA0[r] = __builtin_amdgcn_exp2f(pA0[r]); pA1[r] = __builtin_amdgcn_exp2f(pA1[r]); }
        if (1 < NT) { const LAS unsigned char* kn = kp0 + KSLOT; ATT_KLD2(kn, 0); ATT_KLD2(kn, 1); ATT_KLD2(kn, 2); ATT_KLD2(kn, 3); }
        if (3 < NT) { if (DIFF) ATT_WAITBAR(4); else ATT_WAITBAR(2); } else if (1 < NT) { if (DIFF) ATT_WAITBAR(2); else ATT_WAITBAR(1); } else ATT_WAITBAR(0);
        ATT_ROT();
    }
#define ATT_GAPA(MF, A0, A1, A2, A3, W0, W1, PW) do { MF; sacc += A0; sacc += A1; sacc += A2; sacc += A3; ATT_PIN(sacc); W0; W1; ATT_PIN(PW); ATT_SBAR(); } while (0)
#define ATT_VRD(i, off) do { vlo##i = vtr(vp_ + (off)); vhi##i = vtr(vp_ + (off) + 2048); } while (0)
#define ATT_VFR(i) (bf16x8){vlo##i[0], vlo##i[1], vlo##i[2], vlo##i[3], vhi##i[0], vhi##i[1], vhi##i[2], vhi##i[3]}
#define ATT_EX2(X, B) do { X[B] = __builtin_amdgcn_exp2f(X[B]); X[(B) + 1] = __builtin_amdgcn_exp2f(X[(B) + 1]); } while (0)
#define ATT_EXF(C0, C1, f) do { if ((f) < 16) C0[(f) & 15] = __builtin_amdgcn_exp2f(C0[(f) & 15]); else C1[(f) & 15] = __builtin_amdgcn_exp2f(C1[(f) & 15]); } while (0)
#define ATT_EX4(X, B) do { ATT_EX2(X, B); ATT_EX2(X, (B) + 2); } while (0)
#define ATT_VOFF(j) (DIFF ? ((4 * ((j) >> 2) + (((j) & 3) >> 1)) * 1024 + ((j) & 1) * 512) : (4 * ((j) >> 1) * 1024 + ((j) & 1) * 512))
#define ATT_PVD(j, R, RN, PWK, X, B) do { if ((j) + 3 < 16) ATT_VRD(RN, ATT_VOFF((j) + 3)); ATT_SBAR(); o[(j) & 3] = ATT_MFMA(ATT_PAF(PWK), ATT_VFR(R), o[(j) & 3]); ATT_EX2(X, B); ATT_PIN(X); ATT_SBAR(); } while (0)
#define ATT_PVS(j, R, RN, PWK, X, B) do { if ((j) + 3 < 8) ATT_VRD(RN, ATT_VOFF((j) + 3)); ATT_SBAR(); o[(j) & 1] = ATT_MFMA(ATT_PAF(PWK), ATT_VFR(R), o[(j) & 1]); ATT_EX4(X, B); ATT_PIN(X); ATT_SBAR(); } while (0)
#define ATT_KRD(G, j) do { if (G) { ATT_KLD2(kn_, j); ATT_SBAR(); } } while (0)
#define ATT_STEP(C0, C1, P0, P1, t, GK, GV) do { ATT_SBAR(); \
        const bool gk_ = (GK), gv_ = (GV); \
        float sacc = P0[0] + P0[1]; \
        if (mz) { C0 = ATT_MFMA(kf[0], qr[0], f32x16{}); C1 = ATT_MFMA(kf[1], qr[0], f32x16{}); } \
        else { _Pragma("unroll") for (int r = 0; r < 16; ++r) { C0[r] = nm; C1[r] = nm; } C0 = ATT_MFMA(kf[0], qr[0], C0); C1 = ATT_MFMA(kf[1], qr[0], C1); } \
        ATT_SBAR(); \
        ATT_GAPA((void)0, P0[2], P0[3], P0[4], P0[5],     pw0[0] = ATT_PK(P0, 0),  pw0[1] = ATT_PK(P0, 2),  pw0); \
        ATT_GAPA((void)0, P0[6], P0[7], P0[8], P0[9],     pw0[2] = ATT_PK(P0, 4),  pw0[3] = ATT_PK(P0, 6),  pw0); \
        ATT_GAPA(C0 = ATT_MFMA(kf[2], qr[1], C0),   P0[10], P0[11], P0[12], P0[13], pw1[0] = ATT_PK(P0, 8),  pw1[1] = ATT_PK(P0, 10), pw1); \
        ATT_GAPA(C1 = ATT_MFMA(kf[3], qr[1], C1),   P0[14], P0[15], P1[0], P1[1],   pw1[2] = ATT_PK(P0, 12), pw1[3] = ATT_PK(P0, 14), pw1); \
        ATT_GAPA(C0 = ATT_MFMA(kf[4], qr[2], C0),   P1[2], P1[3], P1[4], P1[5],     pw2[0] = ATT_PK(P1, 0),  pw2[1] = ATT_PK(P1, 2),  pw2); \
        ATT_GAPA(C1 = ATT_MFMA(kf[5], qr[2], C1),   P1[6], P1[7], P1[8], P1[9],     pw2[2] = ATT_PK(P1, 4),  pw2[3] = ATT_PK(P1, 6),  pw2); \
        ATT_GAPA(C0 = ATT_MFMA(kf[6], qr[3], C0),   P1[10], P1[11], P1[12], P1[13], pw3[0] = ATT_PK(P1, 8),  pw3[1] = ATT_PK(P1, 10), pw3); \
        ATT_GAPA(C1 = ATT_MFMA(kf[7], qr[3], C1),   P1[14], P1[15], 0.f, 0.f,       pw3[2] = ATT_PK(P1, 12), pw3[3] = ATT_PK(P1, 14), pw3); \
        lsum += sacc; \
        ATT_SBAR(); \
          \
        { const LAS unsigned char* vp_ = vp0 + sl_prev; const LAS unsigned char* kn_ = kp0 + sl_next + (sl_next >> 4); s16x4 vlo0, vhi0, vlo1, vhi1, vlo2, vhi2, vlo3, vhi3; float rm_ = 0.f; \
          ATT_VRD(0, ATT_VOFF(0)); ATT_VRD(1, ATT_VOFF(1)); ATT_VRD(2, ATT_VOFF(2)); \
          if (DIFF) { \
            ATT_VRD(3, ATT_VOFF(3)); ATT_SBAR(); o[0] = ATT_MFMA(ATT_PAF(0), ATT_VFR(0), o[0]); ATT_SBAR(); \
            if (gk_) dma_k((t) + 3, sl_cur); if (gv_) dma_v((t) + 1, sl_next); \
            ATT_VRD(0, ATT_VOFF(4)); ATT_SBAR(); o[1] = ATT_MFMA(ATT_PAF(0), ATT_VFR(1), o[1]); ATT_SBAR(); \
            ATT_SPECIAL(C0, C1, t); \
            ATT_VRD(1, ATT_VOFF(5)); ATT_SBAR(); o[2] = ATT_MFMA(ATT_PAF(0), ATT_VFR(2), o[2]); ATT_SBAR(); \
            if (!fast) ATT_ROWMAX(C0, C1, rm_); \
            ATT_VRD(2, ATT_VOFF(6)); ATT_SBAR(); o[3] = ATT_MFMA(ATT_PAF(0), ATT_VFR(3), o[3]); ATT_SBAR(); \
            { resc = false; \
              if (!fast && __builtin_expect(__any(rm_ > THR), 0)) { const float dl_ = fmaxf(rm_, 0.f); m += dl_; mz = false; \
                  _Pragma("unroll") for (int r = 0; r < 16; ++r) { C0[r] -= dl_; C1[r] -= dl_; } \
                  nm = -m; \
                  const float f_ = __builtin_amdgcn_exp2f(-dl_); lsum *= f_; if (hi == 0) wsf[l31] = f_; resc = true; } } \
            ATT_SBAR(); \
            ATT_KRD(gv_, 0); ATT_VRD(3, ATT_VOFF(7)); ATT_SBAR(); o[0] = ATT_MFMA(ATT_PAF(1), ATT_VFR(0), o[0]); ATT_SBAR(); ATT_EXF(C0, C1, 0); ATT_EXF(C0, C1, 1); ATT_EXF(C0, C1, 2); ATT_PIN(C0); ATT_PIN(C1); ATT_SBAR(); \
            ATT_KRD(gv_, 1); ATT_VRD(0, ATT_VOFF(8)); ATT_SBAR(); o[1] = ATT_MFMA(ATT_PAF(1), ATT_VFR(1), o[1]); ATT_SBAR(); ATT_EXF(C0, C1, 3); ATT_EXF(C0, C1, 4); ATT_EXF(C0, C1, 5); ATT_PIN(C0); ATT_PIN(C1); ATT_SBAR(); \
            ATT_KRD(gv_, 2); ATT_VRD(1, ATT_VOFF(9)); ATT_SBAR(); o[2] = ATT_MFMA(ATT_PAF(1), ATT_VFR(2), o[2]); ATT_SBAR(); ATT_EXF(C0, C1, 6); ATT_EXF(C0, C1, 7); ATT_EXF(C0, C1, 8); ATT_PIN(C0); ATT_PIN(C1); ATT_SBAR(); \
            ATT_KRD(gv_, 3); ATT_VRD(2, ATT_VOFF(10)); ATT_SBAR(); o[3] = ATT_MFMA(ATT_PAF(1), ATT_VFR(3), o[3]); ATT_SBAR(); ATT_EXF(C0, C1, 9); ATT_EXF(C0, C1, 10); ATT_EXF(C0, C1, 11); ATT_PIN(C0); ATT_PIN(C1); ATT_SBAR(); \
            ATT_VRD(3, ATT_VOFF(11)); ATT_SBAR(); o[0] = ATT_MFMA(ATT_PAF(2), ATT_VFR(0), o[0]); ATT_SBAR(); ATT_EXF(C0, C1, 12); ATT_EXF(C0, C1, 13); ATT_EXF(C0, C1, 14); ATT_PIN(C0); ATT_PIN(C1); ATT_SBAR(); \
            ATT_VRD(0, ATT_VOFF(12)); ATT_SBAR(); o[1] = ATT_MFMA(ATT_PAF(2), ATT_VFR(1), o[1]); ATT_SBAR(); ATT_EXF(C0, C1, 15); ATT_EXF(C0, C1, 16); ATT_EXF(C0, C1, 17); ATT_PIN(C0); ATT_PIN(C1); ATT_SBAR(); \
            ATT_VRD(1, ATT_VOFF(13)); ATT_SBAR(); o[2] = ATT_MFMA(ATT_PAF(2), ATT_VFR(2), o[2]); ATT_SBAR(); ATT_EXF(C0, C1, 18); ATT_EXF(C0, C1, 19); ATT_EXF(C0, C1, 20); ATT_PIN(C0); ATT_PIN(C1); ATT_SBAR(); \
            ATT_VRD(2, ATT_VOFF(14)); ATT_SBAR(); o[3] = ATT_MFMA(ATT_PAF(2), ATT_VFR(3), o[3]); ATT_SBAR(); ATT_EXF(C0, C1, 21); ATT_EXF(C0, C1, 22); ATT_EXF(C0, C1, 23); ATT_PIN(C0); ATT_PIN(C1); ATT_SBAR(); \
            ATT_VRD(3, ATT_VOFF(15)); ATT_SBAR(); o[0] = ATT_MFMA(ATT_PAF(3), ATT_VFR(0), o[0]); ATT_SBAR(); ATT_EXF(C0, C1, 24); ATT_EXF(C0, C1, 25); ATT_PIN(C0); ATT_PIN(C1); ATT_SBAR(); \
            ATT_SBAR(); o[1] = ATT_MFMA(ATT_PAF(3), ATT_VFR(1), o[1]); ATT_SBAR(); ATT_EXF(C0, C1, 26); ATT_EXF(C0, C1, 27); ATT_PIN(C0); ATT_PIN(C1); ATT_SBAR(); \
            ATT_SBAR(); o[2] = ATT_MFMA(ATT_PAF(3), ATT_VFR(2), o[2]); ATT_SBAR(); ATT_EXF(C0, C1, 28); ATT_EXF(C0, C1, 29); ATT_PIN(C0); ATT_PIN(C1); ATT_SBAR(); \
            ATT_SBAR(); o[3] = ATT_MFMA(ATT_PAF(3), ATT_VFR(3), o[3]); ATT_SBAR(); ATT_EXF(C0, C1, 30); ATT_EXF(C0, C1, 31); ATT_PIN(C0); ATT_PIN(C1); ATT_SBAR(); \
          } else { \
            ATT_VRD(3, ATT_VOFF(3)); ATT_SBAR(); o[0] = ATT_MFMA(ATT_PAF(0), ATT_VFR(0), o[0]); ATT_SBAR(); \
            if (gk_) dma_k((t) + 3, sl_cur); if (gv_) dma_v((t) + 1, sl_next); \
            ATT_SPECIAL(C0, C1, t); \
            ATT_VRD(0, ATT_VOFF(4)); ATT_SBAR(); o[1] = ATT_MFMA(ATT_PAF(0), ATT_VFR(1), o[1]); ATT_SBAR(); \
            if (!fast) ATT_ROWMAX(C0, C1, rm_); \
            { resc = false; \
              if (!fast && __builtin_expect(__any(rm_ > THR), 0)) { const float dl_ = fmaxf(rm_, 0.f); m += dl_; mz = false; \
                  _Pragma("unroll") for (int r = 0; r < 16; ++r) { C0[r] -= dl_; C1[r] -= dl_; } \
                  nm = -m; \
                  const float f_ = __builtin_amdgcn_exp2f(-dl_); lsum *= f_; if (hi == 0) wsf[l31] = f_; resc = true; } } \
            ATT_SBAR(); \
            ATT_KRD(gv_, 0); ATT_VRD(1, ATT_VOFF(5)); ATT_SBAR(); o[0] = ATT_MFMA(ATT_PAF(1), ATT_VFR(2), o[0]); ATT_SBAR(); ATT_EXF(C0, C1, 0); ATT_EXF(C0, C1, 1); ATT_EXF(C0, C1, 2); ATT_EXF(C0, C1, 3); ATT_EXF(C0, C1, 4); ATT_EXF(C0, C1, 5); ATT_PIN(C0); ATT_PIN(C1); ATT_SBAR(); \
            ATT_KRD(gv_, 1); ATT_VRD(2, ATT_VOFF(6)); ATT_SBAR(); o[1] = ATT_MFMA(ATT_PAF(1), ATT_VFR(3), o[1]); ATT_SBAR(); ATT_EXF(C0, C1, 6); ATT_EXF(C0, C1, 7); ATT_EXF(C0, C1, 8); ATT_EXF(C0, C1, 9); ATT_EXF(C0, C1, 10); ATT_EXF(C0, C1, 11); ATT_PIN(C0); ATT_PIN(C1); ATT_SBAR(); \
            ATT_KRD(gv_, 2); ATT_VRD(3, ATT_VOFF(7)); ATT_SBAR(); o[0] = ATT_MFMA(ATT_PAF(2), ATT_VFR(0), o[0]); ATT_SBAR(); ATT_EXF(C0, C1, 12); ATT_EXF(C0, C1, 13); ATT_EXF(C0, C1, 14); ATT_EXF(C0, C1, 15); ATT_EXF(C0, C1, 16); ATT_PIN(C0); ATT_PIN(C1); ATT_SBAR(); \
            ATT_KRD(gv_, 3); ATT_SBAR(); o[1] = ATT_MFMA(ATT_PAF(2), ATT_VFR(1), o[1]); ATT_SBAR(); ATT_EXF(C0, C1, 17); ATT_EXF(C0, C1, 18); ATT_EXF(C0, C1, 19); ATT_EXF(C0, C1, 20); ATT_EXF(C0, C1, 21); ATT_PIN(C0); ATT_PIN(C1); ATT_SBAR(); \
            ATT_SBAR(); o[0] = ATT_MFMA(ATT_PAF(3), ATT_VFR(2), o[0]); ATT_SBAR(); ATT_EXF(C0, C1, 22); ATT_EXF(C0, C1, 23); ATT_EXF(C0, C1, 24); ATT_EXF(C0, C1, 25); ATT_EXF(C0, C1, 26); ATT_PIN(C0); ATT_PIN(C1); ATT_SBAR(); \
            ATT_SBAR(); o[1] = ATT_MFMA(ATT_PAF(3), ATT_VFR(3), o[1]); ATT_SBAR(); ATT_EXF(C0, C1, 27); ATT_EXF(C0, C1, 28); ATT_EXF(C0, C1, 29); ATT_EXF(C0, C1, 30); ATT_EXF(C0, C1, 31); ATT_PIN(C0); ATT_PIN(C1); ATT_SBAR(); \
          } } \
        if (gk_) { if (DIFF) ATT_WAITBAR(4); else ATT_WAITBAR(2); } else if (gv_) { if (DIFF) ATT_WAITBAR(2); else ATT_WAITBAR(1); } else ATT_WAITBAR(0); \
        ATT_RESC(); ATT_ROT(); } while (0)
    int t = 1;
    if (fast) for (; t + 4 < NT; t += 2) { ATT_STEP(pB0, pB1, pA0, pA1, t, true, true); ATT_STEP(pA0, pA1, pB0, pB1, t + 1, true, true); }
    for (; t + 1 < NT; t += 2) { ATT_STEP(pB0, pB1, pA0, pA1, t, (t) + 3 < NT, (t) + 1 < NT); ATT_STEP(pA0, pA1, pB0, pB1, t + 1, (t) + 4 < NT, (t) + 2 < NT); }
    if (t < NT) {
        ATT_STEP(pB0, pB1, pA0, pA1, t, (t) + 3 < NT, (t) + 1 < NT);
#pragma unroll
        for (int r = 0; r < 16; ++r) { pA0[r] = pB0[r]; pA1[r] = pB1[r]; }
    }
    {
        float sacc = 0.f;
#pragma unroll
        for (int r = 0; r < 16; ++r) sacc += pA0[r] + pA1[r];
        lsum += sacc;
        pw0 = (v4u){ATT_PK(pA0, 0), ATT_PK(pA0, 2), ATT_PK(pA0, 4), ATT_PK(pA0, 6)}; pw1 = (v4u){ATT_PK(pA0, 8), ATT_PK(pA0, 10), ATT_PK(pA0, 12), ATT_PK(pA0, 14)};
        pw2 = (v4u){ATT_PK(pA1, 0), ATT_PK(pA1, 2), ATT_PK(pA1, 4), ATT_PK(pA1, 6)}; pw3 = (v4u){ATT_PK(pA1, 8), ATT_PK(pA1, 10), ATT_PK(pA1, 12), ATT_PK(pA1, 14)};
        const LAS unsigned char* vb = vp0 + sl_prev;
#pragma unroll
        for (int db = 0; db < NDB; ++db) {
#pragma unroll
            for (int ks = 0; ks < 4; ++ks) {
                const s16x4 lo = vtr(vb + (4 * ks + (db >> 1)) * 1024 + (db & 1) * 512), hh4 = vtr(vb + (4 * ks + (db >> 1)) * 1024 + (db & 1) * 512 + 2048);
                const bf16x8 vf = (bf16x8){lo[0], lo[1], lo[2], lo[3], hh4[0], hh4[1], hh4[2], hh4[3]};
                const v4u pk = ks == 0 ? pw0 : ks == 1 ? pw1 : ks == 2 ? pw2 : pw3;
                o[db] = ATT_MFMA(__builtin_bit_cast(bf16x8, pk), vf, o[db]);
            }
        }
    }
#undef ATT_SBAR
#undef ATT_PIN
#undef ATT_ROT
#undef ATT_WAITBAR
#undef ATT_KLD2
#undef ATT_SPECIAL
#undef ATT_ROWMAX
#undef ATT_RESC
#undef ATT_PK
#undef ATT_PAF
#undef ATT_GAPA
#undef ATT_VRD
#undef ATT_VFR
#undef ATT_EX2
#undef ATT_EX4
#undef ATT_EXF
#undef ATT_VOFF
#undef ATT_PVD
#undef ATT_PVS
#undef ATT_KRD
#undef ATT_STEP
    int tid2 = tid; asm volatile("" : "+v"(tid2));
    if (fast) {
        volatile LAS unsigned* retry_ = (volatile LAS unsigned*)(lds + MISC_OFF + 96);
        const int l31b = tid2 & 31, wqb = (tid2 >> 6) & 3;
        const float lt = swap_add(lsum);
        const bool bad = (!metablk || (wqb == 0 && l31b < 16)) && !(lt > 0x1p-100f && lt < 0x1p100f);
        if (__any(bad)) { if ((tid2 & 63) == 0) retry_[0] = useq; }
        asm volatile("s_waitcnt lgkmcnt(0)\n\ts_barrier" ::: "memory");
        if ((unsigned)__builtin_amdgcn_readfirstlane((int)retry_[0]) == useq) return true;
    }
    attn_epilogue<DIFF>(lds, YAB, o, lsum, tid2, hh, qb, lam, lam_scale);
    return false;
}
template <bool DIFF>
__device__ __forceinline__ void attn_unit(LAS unsigned char* lds, const bf16* __restrict__ Z, bf16* __restrict__ YAB, const float* __restrict__ lutg,
                                          int hh, int qb, float lam, float lam_scale, float sink2, int tid_in, unsigned useq) {
    if (attn_body<DIFF, true>(lds, Z, YAB, lutg, hh, qb, lam, lam_scale, sink2, tid_in, useq))
        (void)attn_body<DIFF, false>(lds, Z, YAB, lutg, hh, qb, lam, lam_scale, sink2, tid_in, useq);
}
template <bool DIFF>
__device__ __forceinline__ void attn_epilogue(LAS unsigned char* lds, bf16* __restrict__ YAB, att::f32x16 (&o)[DIFF ? 4 : 2], float lsum, int tid, int hh, int qb, float lam, float lam_scale) {
    constexpr int NDB = DIFF ? 4 : 2;
    const int lane = tid & 63, w = __builtin_amdgcn_readfirstlane(tid >> 6), cj = w >> 2, wq = w & 3, l31 = lane & 31, hi = lane >> 5;
    const bool metablk = (qb == 128);
    const int qrow = (metablk ? ROW_META : 128 * qb) + 32 * wq + l31;
    LAS float* wsf = (LAS float*)(lds + L_WSF) + w * 64;
    const float ltot = swap_add(lsum);
    float sc = 1.0f / ltot; if (DIFF && cj == 1) sc *= lam;
    if (hi == 0) wsf[l31] = sc;
    asm volatile("s_waitcnt lgkmcnt(0)" ::: "memory");
#pragma unroll
    for (int g = 0; g < 4; ++g) { const f32x4 fv = *(const LAS f32x4*)(wsf + 8 * g + 4 * hi);
#pragma unroll
        for (int db = 0; db < NDB; ++db) { o[db][4 * g + 0] *= fv.x; o[db][4 * g + 1] *= fv.y; o[db][4 * g + 2] *= fv.z; o[db][4 * g + 3] *= fv.w; } }
    asm volatile("s_waitcnt lgkmcnt(0)\n\ts_barrier" ::: "memory");
    const bool store_ok = !metablk || (wq == 0 && l31 < 16);
    if (DIFF) {
        LAS float* X = (LAS float*)lds + wq * 32 * XD_STRIDE;
        if (cj == 1) {
#pragma unroll
            for (int db = 0; db < NDB; ++db)
#pragma unroll
                for (int r = 0; r < 16; ++r) X[crow(r, hi) * XD_STRIDE + 32 * db + l31] = o[db][r];
        }
        asm volatile("s_waitcnt lgkmcnt(0)\n\ts_barrier" ::: "memory");
        if (cj == 0) {
#pragma unroll
            for (int db = 0; db < NDB; ++db)
#pragma unroll
                for (int r = 0; r < 16; ++r) { LAS float* xp = X + crow(r, hi) * XD_STRIDE + 32 * db + l31; *xp = o[db][r] - *xp; }
            asm volatile("s_waitcnt lgkmcnt(0)" ::: "memory");
            const LAS float* xr = X + l31 * XD_STRIDE + 64 * hi; const LAS float* sg = (const LAS float*)(lds + L_SUBG) + 64 * hi;
            f32x4 xv[16]; float ss = 0.f;
#pragma unroll
            for (int i = 0; i < 16; ++i) { xv[i] = *(const LAS f32x4*)(xr + 4 * i); ss += (xv[i].x * xv[i].x + xv[i].y * xv[i].y) + (xv[i].z * xv[i].z + xv[i].w * xv[i].w); }
            ss = swap_add(ss);
            const float rstd = lam_scale / sqrtf(ss * (1.f / 128.f) + EPS);
            if (store_ok) {
                bf16* op = YAB + (size_t)qrow * DM + hh * 128 + 64 * hi;
#pragma unroll
                for (int k = 0; k < 8; ++k) { const f32x4 g0 = *(const LAS f32x4*)(sg + 8 * k), g1 = *(const LAS f32x4*)(sg + 8 * k + 4); const f32x4 a = xv[2 * k], b = xv[2 * k + 1];
                    v4u ov; ov.x = cvtpk(a.x * rstd * g0.x, a.y * rstd * g0.y); ov.y = cvtpk(a.z * rstd * g0.z, a.w * rstd * g0.w); ov.z = cvtpk(b.x * rstd * g1.x, b.y * rstd * g1.y); ov.w = cvtpk(b.z * rstd * g1.z, b.w * rstd * g1.w);
                    *(GAS v4u*)(op + 8 * k) = ov; }
            }
        }
    } else {
        LAS float* X = (LAS float*)lds + w * 32 * XS_STRIDE;
#pragma unroll
        for (int db = 0; db < NDB; ++db)
#pragma unroll
            for (int r = 0; r < 16; ++r) X[crow(r, hi) * XS_STRIDE + 32 * db + l31] = o[db][r];
        asm volatile("s_waitcnt lgkmcnt(0)" ::: "memory");
        const LAS float* xr = X + l31 * XS_STRIDE + 32 * hi;
        if (store_ok) {
            bf16* op = YAB + (size_t)qrow * DM + 1024 + (2 * hh + cj) * 64 + 32 * hi;
#pragma unroll
            for (int k = 0; k < 4; ++k) { const f32x4 a = *(const LAS f32x4*)(xr + 8 * k), b = *(const LAS f32x4*)(xr + 8 * k + 4);
                v4u ov; ov.x = cvtpk(a.x, a.y); ov.y = cvtpk(a.z, a.w); ov.z = cvtpk(b.x, b.y); ov.w = cvtpk(b.z, b.w);
                *(GAS v4u*)(op + 8 * k) = ov; }
        }
    }
    asm volatile("s_waitcnt lgkmcnt(0)\n\ts_barrier" ::: "memory");
}

__device__ __forceinline__ void attn_phase(Frame& F, const bf16* Z, bf16* YAB, CPtrs PP, int layer, int bx) {
    const int tid = F.tid;
    asm volatile("" : "+s"(Z), "+s"(YAB));
    const int lane = tid & 63;
    auto uni = [](float v) { return __builtin_bit_cast(float, __builtin_amdgcn_readfirstlane(__builtin_bit_cast(int, v))); };
    const float lam_init = uni(0.8f - 0.6f * expf(-0.3f * (float)layer));
    asm volatile("" : "+s"(PP));
    const float lam = uni(expf(wave_sum(PP->lq1[layer * 64 + lane] * PP->lk1[layer * 64 + lane])) - expf(wave_sum(PP->lq2[layer * 64 + lane] * PP->lk2[layer * 64 + lane])) + lam_init);
    if (tid < 128) ((LAS float*)(F.lds + L_SUBG))[tid] = PP->dnorm[layer * 128 + tid];
    const float* relb = (const float*)(PP->ws + WS_LUTG); const float* sinks = PP->sinks;
    __syncthreads();
    const int w = __builtin_amdgcn_readfirstlane(tid >> 6);
    const bool deal256 = (F.G == 256);
    unsigned useq = (unsigned)layer * 4096u;
    for (int it = F.vcu; it < 512; it += F.G) {
        for (int sub = 0; sub < 2; ++sub) { const int s = it & 63; attn_unit<true>(F.lds, Z, YAB, relb, it >> 6, sub ? s : 127 - s, lam, 1.f - lam_init, 0.f, tid, ++useq); }
    }
    constexpr int EH = 302;
    const int e0 = deal256 ? (bx < 128 ? bx : EH + (bx - 128)) : F.vcu, estep = deal256 ? 128 : F.G, elim = (deal256 && bx < 128) ? EH : 1040;
    const bool last_layer = (layer == DEPTH - 1);
    for (int e = e0; e < elim; e += estep) {
        if (last_layer && (e >= 1032 || (e % 129) == 128)) continue;
        if (e < 1032) attn_unit<false>(F.lds, Z, YAB, relb, e / 129, e % 129, 0.f, 0.f, uni(sinks[layer * 16 + 2 * (e / 129) + (w >> 2)] * LOG2E), tid, ++useq);
        else attn_unit<true>(F.lds, Z, YAB, relb, e - 1032, 128, lam, 1.f - lam_init, 0.f, tid, ++useq);
    }
}
#undef ATT_MFMA
}

#ifndef FFN_SPLIT_N
#define FFN_SPLIT_N 2
#endif
constexpr int FFN_SPLIT = ONE_LAUNCH ? FFN_SPLIT_N : 1;
constexpr int NT_IN_A = 23;
constexpr int PH_PER_LAYER = 9, N_PHASES = 1 + DEPTH * PH_PER_LAYER;
struct Args { Ptrs p; int ph_lo, ph_hi; };

__global__ void __launch_bounds__(NWAVES * 64, 2) fwd_kernel(Args args) {
    extern __shared__ __attribute__((aligned(16))) unsigned char lds[];
    Frame F;
    F.lds = (LAS unsigned char*)lds;
    F.MISC = (volatile LAS unsigned*)(F.lds + MISC_OFF);
    F.tid = threadIdx.x; F.lane = F.tid & 63; F.wave = __builtin_amdgcn_readfirstlane(F.tid >> 6);
    F.G = gridDim.x; { const int bx = blockIdx.x; F.vcu = (F.G % 8 == 0) ? (bx % 8) * (F.G / 8) + bx / 8 : bx; }
    CPtrs PP = (CPtrs)__builtin_amdgcn_kernarg_segment_ptr();
#define LDP(field) ({ CPtrs q_ = PP; asm volatile("" : "+s"(q_)); q_->field; })
#define WSP(off) ({ unsigned char* w_ = LDP(ws); (bf16*)(w_ + (off)); })
    F.ctl = (gu32*)(LDP(ws) + WS_CTL);
    for (int u = F.tid; u < (LDS_BYTES - LDSCTL_OFF) / 4; u += NWAVES * 64) ((LAS unsigned*)(F.lds + LDSCTL_OFF))[u] = 0u;
    __syncthreads();
    const int lo = args.ph_lo, hi = args.ph_hi;
    const bool multi = (hi - lo) > 1;
    XcdBarrier bar; bar.bar = (unsigned*)(F.ctl + CW_BAR); bar.x = 0; bar.st = nullptr;
    if (multi) bar = xcd_barrier_post((unsigned*)(F.ctl + CW_BAR), F.MISC + 8);
#define IN(k) (lo <= (k) && (k) < hi)
#define SEAM(k) do { if (IN(k) && IN((k) + 1)) { xcd_barrier(bar); if (NREP(10) == 2) xcd_barrier(bar); } } while (0)

#define RSP ((float*)(LDP(ws) + WS_HMETA))

    if (IN(0)) {
        gate_colmax_pass(F, LDP(w_in), LDP(n_attn_pre), (unsigned*)(F.ctl + CW_CMAX));
        if (multi) xcd_barrier(bar);
        p0_transposes(F, PP);
        gate_quant_pass(F, LDP(w_in), LDP(n_attn_pre), (signed char*)(LDP(ws) + WS_WQ), (const unsigned*)(F.ctl + CW_CMAX), (float*)(LDP(ws) + WS_CS));
        build_lut_tables(F, LDP(relb), (float*)(LDP(ws) + WS_LUTG));
        __syncthreads();
        resid_phase<0>(F, LDP(x), LDP(meta), WSP(WS_U), RSP, nullptr, nullptr, nullptr, (signed char*)(LDP(ws) + WS_HQ), (float*)(LDP(ws) + WS_QS));
        SEAM(0);
    }
    for (int l = 0; l < DEPTH; ++l) {
        const int pb = 1 + PH_PER_LAYER * l;
        if (pb + PH_PER_LAYER <= lo || pb >= hi) continue;
#define FRESH(Fs) Frame Fs = F; asm volatile("" : "+s"(Fs.vcu), "+s"(Fs.G), "+s"(Fs.wave), "+v"(Fs.tid)); Fs.lane = Fs.tid & 63; int bx_ = blockIdx.x; asm volatile("" : "+s"(bx_))
#define OPQ(p) asm volatile("" : "+s"(p))
        if (IN(pb + 0)) {
            for (int rep = 0; rep < NREP(0); ++rep) {
            const bf16* A_ = WSP(WS_U); const bf16* B_ = WSP(WS_WIN) + (size_t)l * INW * DM; bf16* O_ = WSP(WS_Z); OPQ(A_); OPQ(B_); OPQ(O_);
            FRESH(Fs); for (int mrep = 0; mrep < NREP(11); ++mrep) meta_gemm(Fs.lds, A_ + (size_t)ROW_META * DM, DM, B_, DM, INW, DM, Fs.vcu, Fs.G, Fs.tid, MEpiZ{O_, RSP});
            pg8::Gemm g{A_, B_, SEQ, 17 * 256, DM, DM, DM}; pg8::StaticOrder S; S.init(SEQ, 17 * 256, Fs.G, bx_);
            pg8::EpiZ E{O_, INW, RSP, 0};
            pg8::gemm_phase<pg8::EpiZ, pg8::StaticOrder, true>(F.lds + RING_OFF, g, S, E);
            if (Fs.G != 256 || bx_ >= 64) {
                const bf16* AQ_ = WSP(WS_HQ); const bf16* BQ_ = (const bf16*)(LDP(ws) + WS_WQ + (size_t)l * 4096 * DM); const float* QS_ = (const float*)(LDP(ws) + WS_QS); const float* CS_ = (const float*)(LDP(ws) + WS_CS) + l * 4096; OPQ(AQ_); OPQ(BQ_); OPQ(QS_); OPQ(CS_);
                pg8::Gemm gq{AQ_, BQ_, SEQ, (NT_IN_A - 17) * 256, 1024, 1024, 1024}; pg8::StaticOrder Sq; if (Fs.G == 256) Sq.init(SEQ, (NT_IN_A - 17) * 256, 192, bx_ - 64); else Sq.init(SEQ, (NT_IN_A - 17) * 256, Fs.G, bx_);
                pg8::EpiZ Eq{O_, INW, QS_, 17, CS_};
                pg8::gemm_phase<pg8::EpiZ, pg8::StaticOrder, true, true>(F.lds + RING_OFF, gq, Sq, Eq);
            }
            }
            SEAM(pb + 0);
        }
        if (IN(pb + 1)) {
#if !ATTN_NAIVE
            for (int rep = 0; rep < NREP(1); ++rep) { FRESH(Fs);
                att::attn_phase(Fs, WSP(WS_Z), WSP(WS_YAB), PP, l, bx_);
                {
                    constexpr int GC0 = (NT_IN_A - 17) * 256;
                    const bf16* AQ_ = WSP(WS_HQ); const bf16* BQ_ = (const bf16*)(LDP(ws) + WS_WQ + ((size_t)l * 4096 + GC0) * DM); bf16* O_ = WSP(WS_Z); const float* QS_ = (const float*)(LDP(ws) + WS_QS); const float* CS_ = (const float*)(LDP(ws) + WS_CS) + l * 4096 + GC0; OPQ(AQ_); OPQ(BQ_); OPQ(O_); OPQ(QS_); OPQ(CS_);
                    pg8::Gemm gq{AQ_, BQ_, SEQ, (33 - NT_IN_A) * 256, 1024, 1024, 1024}; pg8::StaticOrder Sq; Sq.init(SEQ, (33 - NT_IN_A) * 256, Fs.G, bx_);
                    pg8::EpiZ Eq{O_, INW, QS_, NT_IN_A, CS_};
                    pg8::gemm_phase<pg8::EpiZ, pg8::StaticOrder, true, true>(F.lds + RING_OFF, gq, Sq, Eq);
                } }
#endif
            SEAM(pb + 1);
        }
        if (IN(pb + 2)) {
            for (int rep = 0; rep < NREP(2); ++rep) {
            const bf16* A_ = WSP(WS_YAB); const bf16* B_ = WSP(WS_WA) + (size_t)l * DM * 1024; bf16* O_ = WSP(WS_T); const bf16* G_ = WSP(WS_Z) + C_GA; OPQ(A_); OPQ(B_); OPQ(O_); OPQ(G_);
            FRESH(Fs); if (l + 1 < DEPTH) for (int mrep = 0; mrep < NREP(11); ++mrep) meta_gemm(Fs.lds, A_ + (size_t)ROW_META * DM, DM, B_, 1024, DM, 1024, Fs.vcu, Fs.G, Fs.tid, MEpiGate<false>{O_, G_, O_});
            pg8::Gemm g{A_, B_, SEQ, DM, 1024, DM, 1024}; pg8::StaticOrder S; S.init(SEQ, DM, Fs.G, bx_);
            pg8::EpiGate<false> E{O_, DM, G_, INW, O_};
            pg8::gemm_phase<pg8::EpiGate<false>, pg8::StaticOrder, true>(F.lds + RING_OFF, g, S, E);
            }
            SEAM(pb + 2);
        }
        if (IN(pb + 3)) {
            for (int rep = 0; rep < NREP(3); ++rep) {
            const bf16* A_ = WSP(WS_YAB) + 1024; const bf16* B_ = WSP(WS_WB) + (size_t)l * DM * 1024; bf16* O_ = WSP(WS_MIX); const bf16* G_ = WSP(WS_Z) + C_GB; const bf16* P_ = WSP(WS_T); OPQ(A_); OPQ(B_); OPQ(O_); OPQ(G_); OPQ(P_);
            FRESH(Fs); if (l + 1 < DEPTH) for (int mrep = 0; mrep < NREP(11); ++mrep) meta_gemm(Fs.lds, A_ + (size_t)ROW_META * DM, DM, B_, 1024, DM, 1024, Fs.vcu, Fs.G, Fs.tid, MEpiGate<true>{O_, G_, P_});
            pg8::Gemm g{A_, B_, SEQ, DM, 1024, DM, 1024}; pg8::StaticOrder S; S.init(SEQ, DM, Fs.G, bx_);
            pg8::EpiGate<true> E{O_, DM, G_, INW, P_};
            pg8::gemm_phase<pg8::EpiGate<true>, pg8::StaticOrder, true>(F.lds + RING_OFF, g, S, E);
            }
            SEAM(pb + 3);
        }
        if (IN(pb + 4)) {
            for (int rep = 0; rep < NREP(4); ++rep) {
            const bf16* A_ = WSP(WS_MIX); const bf16* B_ = WSP(WS_WOUT) + (size_t)l * DM * DM; bf16* O_ = WSP(WS_T); OPQ(A_); OPQ(B_); OPQ(O_);
            FRESH(Fs); if (l + 1 < DEPTH) for (int mrep = 0; mrep < NREP(11); ++mrep) meta_gemm(Fs.lds, A_ + (size_t)ROW_META * DM, DM, B_, DM, DM, DM, Fs.vcu, Fs.G, Fs.tid, MEpiPlain<0>{O_, DM, nullptr});
            pg8::Gemm g{A_, B_, SEQ, DM, DM, DM, DM}; pg8::StaticOrder S; S.init(SEQ, DM, Fs.G, bx_);
            pg8::EpiBf16<0> E{O_, DM, nullptr};
            pg8::gemm_phase<pg8::EpiBf16<0>, pg8::StaticOrder, true>(F.lds + RING_OFF, g, S, E);
            }
            SEAM(pb + 4);
        }
        if (IN(pb + 5)) {
            for (int rep = 0; rep < ((l == 0) ? NREP(5) : 1); ++rep) {
            FRESH(Fs); resid_phase<1>(Fs, nullptr, nullptr, WSP(WS_U), RSP, WSP(WS_T), LDP(n_attn_post) + l * DM, nullptr);
            }
            SEAM(pb + 5);
        }
        if (IN(pb + 6) || IN(pb + 7)) {
            constexpr int PROWS = SEQ / FFN_SPLIT;
            for (int part = 0; part < FFN_SPLIT; ++part) {
                if (IN(pb + 6)) {
                    for (int rep = 0; rep < NREP(6); ++rep) {
                    const bf16* A_ = WSP(WS_U); const bf16* B_ = WSP(WS_W1) + (size_t)l * DFF * DM; bf16* O_ = WSP(WS_Z); const float* R_ = RSP; OPQ(A_); OPQ(B_); OPQ(O_); OPQ(R_);
                    FRESH(Fs); if (l + 1 < DEPTH && part == 0) for (int mrep = 0; mrep < NREP(11); ++mrep) meta_gemm(Fs.lds, A_ + (size_t)ROW_META * DM, DM, B_, DM, DFF, DM, Fs.vcu, Fs.G, Fs.tid, MEpiPlain<1>{O_, DFF, R_});
                    pg8::Gemm g{A_ + (size_t)part * PROWS * DM, B_, PROWS, DFF, DM, DM, DM}; pg8::StaticOrder S; S.init(PROWS, DFF, Fs.G, bx_);
                    pg8::EpiBf16<1> E{O_ + (size_t)part * PROWS * DFF, DFF, R_ + part * PROWS};
                    pg8::gemm_phase<pg8::EpiBf16<1>, pg8::StaticOrder, true>(F.lds + RING_OFF, g, S, E);
                    }
                    if (IN(pb + 7) && multi) xcd_barrier(bar);
                }
                if (IN(pb + 7)) {
                    for (int rep = 0; rep < NREP(7); ++rep) {
                    const bf16* A_ = WSP(WS_Z); const bf16* B_ = WSP(WS_W2) + (size_t)l * DM * DFF; bf16* O_ = WSP(WS_T); OPQ(A_); OPQ(B_); OPQ(O_);
                    FRESH(Fs); if (l + 1 < DEPTH && part == 0) for (int mrep = 0; mrep < NREP(11); ++mrep) meta_gemm(Fs.lds, A_ + (size_t)ROW_META * DFF, DFF, B_, DFF, DM, DFF, Fs.vcu, Fs.G, Fs.tid, MEpiPlain<0>{O_, DM, nullptr});
                    pg8::Gemm g{A_ + (size_t)part * PROWS * DFF, B_, PROWS, DM, DFF, DFF, DFF}; pg8::StaticOrder S; S.init(PROWS, DM, Fs.G, bx_);
                    pg8::EpiBf16<0> E{O_ + (size_t)part * PROWS * DM, DM, nullptr};
                    pg8::gemm_phase<pg8::EpiBf16<0>, pg8::StaticOrder, true>(F.lds + RING_OFF, g, S, E);
                    }
                    if (part + 1 < FFN_SPLIT && IN(pb + 6) && multi) xcd_barrier(bar);
                }
            }
            SEAM(pb + 7);
        }
        if (IN(pb + 8)) {
            FRESH(Fs);
            if (l + 1 < DEPTH) resid_phase<1>(Fs, nullptr, nullptr, WSP(WS_U), RSP, WSP(WS_T), LDP(n_ff_post) + l * DM, nullptr, (signed char*)(LDP(ws) + WS_HQ), (float*)(LDP(ws) + WS_QS));
            else resid_phase<2>(Fs, nullptr, nullptr, WSP(WS_U), RSP, WSP(WS_T), LDP(n_ff_post) + l * DM, LDP(out));
            SEAM(pb + 8);
        }
    }
#undef OPQ
#undef FRESH
#undef LDP
#undef WSP
#undef RSP
#undef IN
#undef SEAM
}

extern "C" void kernel_launch(void* const* d_in, const int* in_sizes, int n_in, void* d_out, int out_size, void* d_ws, size_t ws_size, hipStream_t stream) {
    static int grid = 0;
    if (grid == 0) {
        if (n_in != 19 || in_sizes[0] != SEQ * DM || out_size != SEQ * DM || ws_size < WS_END) { fprintf(stderr, "kernel_launch: unexpected shapes (n_in %d, ws %zu)\n", n_in, ws_size); grid = -1; return; }
        int dev = 0, cus = 0;
        if (hipGetDevice(&dev) != hipSuccess || hipDeviceGetAttribute(&cus, hipDeviceAttributeMultiprocessorCount, dev) != hipSuccess) { grid = -1; return; }
        if (hipFuncSetAttribute((const void*)fwd_kernel, hipFuncAttributeMaxDynamicSharedMemorySize, LDS_BYTES) != hipSuccess) { grid = -1; return; }
#if ATTN_NAIVE
        (void)hipFuncSetAttribute((const void*)naive_attn<true>, hipFuncAttributeMaxDynamicSharedMemorySize, NAIVE_LDS);
        (void)hipFuncSetAttribute((const void*)naive_attn<false>, hipFuncAttributeMaxDynamicSharedMemorySize, NAIVE_LDS);
#endif
        int per_cu = 0;
        (void)hipOccupancyMaxActiveBlocksPerMultiprocessor(&per_cu, (const void*)fwd_kernel, NWAVES * 64, LDS_BYTES);
        (void)hipGetLastError();
        grid = cus;
    }
    if (grid < 0) return;
    if (hipMemsetAsync((char*)d_ws + WS_CTL, 0, CTL_ZERO_BYTES, stream) != hipSuccess) return;
    Args a{};
    a.p.x = (const float*)d_in[0]; a.p.meta = (const float*)d_in[1]; a.p.relb = (const float*)d_in[2]; a.p.w_in = (const float*)d_in[3]; a.p.w_a = (const float*)d_in[4];
    a.p.w_b = (const float*)d_in[5]; a.p.w_out = (const float*)d_in[6]; a.p.lq1 = (const float*)d_in[7]; a.p.lk1 = (const float*)d_in[8]; a.p.lq2 = (const float*)d_in[9];
    a.p.lk2 = (const float*)d_in[10]; a.p.dnorm = (const float*)d_in[11]; a.p.sinks = (const float*)d_in[12]; a.p.n_attn_pre = (const float*)d_in[13]; a.p.n_attn_post = (const float*)d_in[14];
    a.p.w_ff1 = (const float*)d_in[15]; a.p.w_ff2 = (const float*)d_in[16]; a.p.n_ff_pre = (const float*)d_in[17]; a.p.n_ff_post = (const float*)d_in[18];
    a.p.out = (float*)d_out; a.p.ws = (unsigned char*)d_ws;
#if ONE_LAUNCH
    a.ph_lo = 0; a.ph_hi = N_PHASES;
    hipLaunchKernelGGL(fwd_kernel, dim3(grid), dim3(NWAVES * 64), LDS_BYTES, stream, a);
#else
    for (int ph = 0; ph < N_PHASES; ++ph) {
        const int l = (ph - 1) / PH_PER_LAYER, i = (ph - 1) % PH_PER_LAYER;
#if ATTN_NAIVE
        if (ph >= 1 && i == 1) {
            const bf16* Z = (const bf16*)((unsigned char*)d_ws + WS_Z); bf16* YAB = (bf16*)((unsigned char*)d_ws + WS_YAB);
            hipLaunchKernelGGL(naive_attn<true>, dim3(8 * 129), dim3(512), NAIVE_LDS, stream, Z, YAB, a.p.relb, a.p.lq1, a.p.lk1, a.p.lq2, a.p.lk2, a.p.dnorm, a.p.sinks, l);
            hipLaunchKernelGGL(naive_attn<false>, dim3(8 * 129), dim3(512), NAIVE_LDS, stream, Z, YAB, a.p.relb, a.p.lq1, a.p.lk1, a.p.lq2, a.p.lk2, a.p.dnorm, a.p.sinks, l);
            continue;
        }
#endif
        a.ph_lo = ph; a.ph_hi = ph + 1;
        hipLaunchKernelGGL(fwd_kernel, dim3(grid), dim3(NWAVES * 64), LDS_BYTES, stream, a);
    }
#endif
    (void)hipPeekAtLastError();
}
```

```cpp
#include <hip/hip_runtime.h>
#include <cstdio>
#include <cstdint>

#ifndef ATTN_NAIVE
#define ATTN_NAIVE 0
#endif
#ifndef PROBE_MASK
#define PROBE_MASK 0
#endif
#define NREP(i) (((PROBE_MASK >> (i)) & 1) ? 2 : 1)
#ifndef ONE_LAUNCH
#define ONE_LAUNCH 1
#endif

constexpr int DM = 2048, SEQ = 16384, DEPTH = 4, NMETA = 16;
constexpr int MA = 16640;
constexpr int ROW_META = 16384, NROWS = 16400;
constexpr int INW = 8448, DFF = 8192;
constexpr int C_QA = 0, C_KA = 1024, C_VA = 2048, C_QB = 3072, C_KB = 4096, C_VB = 4224, C_GA = 4352, C_GB = 6400;
constexpr int NBUCK = 32, NBIAS = 24;
constexpr float EPS = 1e-6f, LOG2E = 1.4426950408889634f, QSCALE = 0.125f * 1.4426950408889634f, NEGBIG = -1e30f;

constexpr size_t MiB = 1u << 20;
constexpr size_t WS_CTL = 0, CTL_ZERO_BYTES = 1 * MiB;
constexpr size_t WS_HMETA = 2 * MiB;
constexpr size_t WS_LUTG = 2 * MiB + 256 * 1024;
constexpr size_t WS_WIN = 4 * MiB;
constexpr size_t WS_WA = 136 * MiB, WS_WB = 152 * MiB;
constexpr size_t WS_WOUT = 168 * MiB;
constexpr size_t WS_W1 = 200 * MiB;
constexpr size_t WS_W2 = 328 * MiB;
constexpr size_t WS_U = 456 * MiB;
constexpr size_t WS_YAB = 521 * MiB;
constexpr size_t WS_MIX = 586 * MiB;
constexpr size_t WS_T = 651 * MiB;
constexpr size_t WS_Z = 716 * MiB;
constexpr size_t WS_HQ = WS_MIX;
constexpr size_t WS_WQ = 985 * MiB;
constexpr size_t WS_QS = 3 * MiB;
constexpr size_t WS_CS = 3 * MiB + 128 * 1024;
constexpr size_t WS_END = 1018 * MiB;
static_assert(WS_Z + (size_t)MA * INW * 2 <= WS_WQ && WS_WQ + (size_t)4 * 4096 * 2048 <= WS_END && (size_t)MA * 2048 <= 65 * MiB, "ws map");
constexpr int CW_TMO = 0, CW_BAR = 4096, CW_CMAX = 32768;

namespace pg8 {
#define PG8_LAS __attribute__((address_space(3)))
typedef unsigned short bf16_t;
typedef short bf16x8 __attribute__((ext_vector_type(8)));
typedef float f32x4 __attribute__((ext_vector_type(4)));
typedef unsigned u32x4 __attribute__((ext_vector_type(4)));
typedef int i32x4 __attribute__((ext_vector_type(4)));
constexpr int BM = 256, BK = 64, HALF = 128, HTB = HALF * BK * 2  , STAGE_BYTES = 8 * HTB, NXCD = 8, WGM = 8;

__host__ __device__ __forceinline__ int lds_byte(int r, int c) { const int r7 = r & 7; return (r >> 3) * 1024 + r7 * 128 + (((c >> 3) ^ r7) << 4) + (c & 7) * 2; }
__host__ __device__ __forceinline__ void stage_rc(int b, int& R, int& C) { const int blk = b / 1024, sb = b % 1024, r7 = sb / 128, chs = (sb % 128) / 16; R = blk * 8 + r7; C = (chs ^ r7) * 8; }
__host__ __device__ __forceinline__ int perm32(int rho) { const int n = rho >> 4, i = rho & 15; return 8 * (i >> 2) + 4 * n + (i & 3); }

struct Unit { int pm, pn; };
struct Gemm { const bf16_t* A; const bf16_t* Bt; int M, N, K, lda, ldb; };

struct StaticOrder {
    int nM, nN, nwg, G, c;
    __host__ __device__ void init(int M, int N, int G_, int c_) { nM = M / BM; nN = N / BM; nwg = nM * nN; G = G_; c = c_; }
    __host__ __device__ bool next(int i, Unit& u) const {
        const long L = (long)i * G + c; if (L >= nwg) return false;
        int wgid = (int)L; { const int q = nwg / NXCD, r = nwg % NXCD, xcd = wgid % NXCD, off = wgid / NXCD; wgid = (xcd < r ? xcd * (q + 1) : r * (q + 1) + (xcd - r) * q) + off; }
        const int nig = WGM * nN, gid = wgid / nig, fm = gid * WGM, gsz = (nM - fm) < WGM ? (nM - fm) : WGM;
        u.pm = fm + ((wgid % nig) % gsz); u.pn = (wgid % nig) / gsz; return true;
    }
    __device__ __forceinline__ void a_ready(const Unit&) const {}
    __device__ __forceinline__ void done(const Unit&) const {}
};

__device__ __forceinline__ unsigned cvt_pk_bf16(float lo, float hi) { unsigned r; asm volatile("v_cvt_pk_bf16_f32 %0, %1, %2" : "=v"(r) : "v"(lo), "v"(hi)); return r; }
__device__ __forceinline__ float bf_lo(unsigned u) { return __builtin_bit_cast(float, u << 16); }
__device__ __forceinline__ float bf_hi(unsigned u) { return __builtin_bit_cast(float, u & 0xffff0000u); }
__device__ __forceinline__ float sigmoidf_fast(float x) { return __builtin_amdgcn_rcpf(1.0f + __builtin_amdgcn_exp2f(-x * 1.4426950408889634f)); }

#define PG8_GAS __attribute__((address_space(1)))
__device__ __forceinline__ void st_remap(PG8_LAS unsigned char* stg, int fr, int fq, int lane, u32x4 w, PG8_GAS bf16_t* blk, int ldc) {
    *(PG8_LAS u32x4*)(stg + fr * 64 + ((fq ^ ((fr >> 1) & 3)) * 16)) = w;
    const int r = lane >> 2, c = lane & 3;
    const u32x4 v = *(const PG8_LAS u32x4*)(stg + r * 64 + ((c ^ ((r >> 1) & 3)) * 16));
    *(PG8_GAS u32x4*)(blk + (size_t)r * ldc + c * 8) = v;
}
struct EpiZ {
    static constexpr bool PERM = true, AFTER_DRAIN = false;
    bf16_t* O; int ldc; const float* rs; int pn_off; const float* cs = nullptr;
    __device__ __forceinline__ void operator()(const f32x4 (&acc)[2][2][4][2], const Unit& u, int wr, int wc, int fr, int fq, PG8_LAS unsigned char* stg, int lane) const {
        const int tpn = u.pn + pn_off;
        const int rowb = u.pm * BM + wr * 64, colb = tpn * BM + wc * 32;
        const int mode = (tpn < 4 || (tpn >= 12 && tpn < 16)) ? 1 : (tpn >= 17 ? 2 : 0);
        f32x4 c4[2][2];
        if (cs) {
#pragma unroll
            for (int bj = 0; bj < 2; ++bj) { c4[bj][0] = *(const PG8_GAS f32x4*)(cs + u.pn * BM + wc * 32 + bj * HALF + 8 * fq); c4[bj][1] = *(const PG8_GAS f32x4*)(cs + u.pn * BM + wc * 32 + bj * HALF + 8 * fq + 4); } }
        float r8[2][4];
#pragma unroll
        for (int ai = 0; ai < 2; ++ai)
#pragma unroll
            for (int m = 0; m < 4; ++m) r8[ai][m] = ((const PG8_GAS float*)rs)[rowb + fr + ai * HALF + m * 16];
#pragma unroll
        for (int ai = 0; ai < 2; ++ai)
#pragma unroll
            for (int m = 0; m < 4; ++m) { PG8_GAS bf16_t* blk = (PG8_GAS bf16_t*)O + (size_t)(rowb + ai * HALF + m * 16) * ldc + colb; const float r_ = r8[ai][m];
#pragma unroll
                for (int bj = 0; bj < 2; ++bj) { f32x4 v0, v1;
                    if (cs) { const i32x4 a0 = __builtin_bit_cast(i32x4, acc[ai][bj][m][0]), a1 = __builtin_bit_cast(i32x4, acc[ai][bj][m][1]);
#pragma unroll
                        for (int e = 0; e < 4; ++e) { v0[e] = (float)a0[e] * r_ * c4[bj][0][e]; v1[e] = (float)a1[e] * r_ * c4[bj][1][e]; } }
                    else { v0 = acc[ai][bj][m][0] * r_; v1 = acc[ai][bj][m][1] * r_; }
                    if (mode == 1) { v0 = v0 * QSCALE; v1 = v1 * QSCALE; }
                    else if (mode == 2) {
#pragma unroll
                        for (int e = 0; e < 4; ++e) { v0[e] = sigmoidf_fast(v0[e]); v1[e] = sigmoidf_fast(v1[e]); } }
                    u32x4 w; w.x = cvt_pk_bf16(v0[0], v0[1]); w.y = cvt_pk_bf16(v0[2], v0[3]); w.z = cvt_pk_bf16(v1[0], v1[1]); w.w = cvt_pk_bf16(v1[2], v1[3]);
                    st_remap(stg, fr, fq, lane, w, blk + bj * HALF, ldc); } }
    }
};
struct EpiZq {
    static constexpr bool PERM = true, AFTER_DRAIN = false;
    bf16_t* O; int ldc; const float* qs; const float* cs; int col_off;
    __device__ __forceinline__ void operator()(const f32x4 (&acc)[2][2][4][2], const Unit& u, int wr, int wc, int fr, int fq, PG8_LAS unsigned char* stg, int lane) const {
        const int rowb = u.pm * BM + wr * 64, colg = u.pn * BM + wc * 32;
        float r8[2][4]; f32x4 c4[2][2];
#pragma unroll
        for (int ai = 0; ai < 2; ++ai)
#pragma unroll
            for (int m = 0; m < 4; ++m) r8[ai][m] = ((const PG8_GAS float*)qs)[rowb + fr + ai * HALF + m * 16];
#pragma unroll
        for (int bj = 0; bj < 2; ++bj) { c4[bj][0] = *(const PG8_GAS f32x4*)(cs + colg + bj * HALF + 8 * fq); c4[bj][1] = *(const PG8_GAS f32x4*)(cs + colg + bj * HALF + 8 * fq + 4); }
#pragma unroll
        for (int ai = 0; ai < 2; ++ai)
#pragma unroll
            for (int m = 0; m < 4; ++m) { PG8_GAS bf16_t* blk = (PG8_GAS bf16_t*)O + (size_t)(rowb + ai * HALF + m * 16) * ldc + col_off + colg; const float r_ = r8[ai][m];
#pragma unroll
                for (int bj = 0; bj < 2; ++bj) { const i32x4 a0 = __builtin_bit_cast(i32x4, acc[ai][bj][m][0]), a1 = __builtin_bit_cast(i32x4, acc[ai][bj][m][1]); f32x4 v0, v1;
#pragma unroll
                    for (int e = 0; e < 4; ++e) { v0[e] = sigmoidf_fast((float)a0[e] * r_ * c4[bj][0][e]); v1[e] = sigmoidf_fast((float)a1[e] * r_ * c4[bj][1][e]); }
                    u32x4 w; w.x = cvt_pk_bf16(v0[0], v0[1]); w.y = cvt_pk_bf16(v0[2], v0[3]); w.z = cvt_pk_bf16(v1[0], v1[1]); w.w = cvt_pk_bf16(v1[2], v1[3]);
                    st_remap(stg, fr, fq, lane, w, blk + bj * HALF, ldc); } }
    }
};
template <int ACT  > struct EpiBf16 {
    static constexpr bool PERM = true, AFTER_DRAIN = false;
    bf16_t* O; int ldc; const float* rs;
    __device__ __forceinline__ void operator()(const f32x4 (&acc)[2][2][4][2], const Unit& u, int wr, int wc, int fr, int fq, PG8_LAS unsigned char* stg, int lane) const {
        const int rowb = u.pm * BM + wr * 64, colb = u.pn * BM + wc * 32;
        float r8[2][4];
        if (ACT == 1) {
#pragma unroll
            for (int ai = 0; ai < 2; ++ai)
#pragma unroll
                for (int m = 0; m < 4; ++m) r8[ai][m] = ((const PG8_GAS float*)rs)[rowb + fr + ai * HALF + m * 16]; }
#pragma unroll
        for (int ai = 0; ai < 2; ++ai)
#pragma unroll
            for (int m = 0; m < 4; ++m) { PG8_GAS bf16_t* blk = (PG8_GAS bf16_t*)O + (size_t)(rowb + ai * HALF + m * 16) * ldc + colb;
#pragma unroll
                for (int bj = 0; bj < 2; ++bj) { f32x4 v0 = acc[ai][bj][m][0], v1 = acc[ai][bj][m][1];
                    if (ACT == 1) { const float r_ = r8[ai][m];
#pragma unroll
                        for (int e = 0; e < 4; ++e) { const float a = fmaxf(v0[e] * r_, 0.f), b = fmaxf(v1[e] * r_, 0.f); v0[e] = a * a; v1[e] = b * b; } }
                    u32x4 w; w.x = cvt_pk_bf16(v0[0], v0[1]); w.y = cvt_pk_bf16(v0[2], v0[3]); w.z = cvt_pk_bf16(v1[0], v1[1]); w.w = cvt_pk_bf16(v1[2], v1[3]);
                    st_remap(stg, fr, fq, lane, w, blk + bj * HALF, ldc); } }
    }
};
template <bool ADD_PREV> struct EpiGate {
    static constexpr bool PERM = true, AFTER_DRAIN = false;
    bf16_t* O; int ldc; const bf16_t* G; int ldg; const bf16_t* P;
    __device__ __forceinline__ void operator()(const f32x4 (&acc)[2][2][4][2], const Unit& u, int wr, int wc, int fr, int fq, PG8_LAS unsigned char* stg, int lane) const {
        const int rowb = u.pm * BM + wr * 64, colb = u.pn * BM + wc * 32;
        const int row0 = rowb + fr, col0 = colb + 8 * fq;
        u32x4 gv[2][4], pv[2][4];
#define PG8_EG_LOAD(g, b) do { _Pragma("unroll") for (int mm = 0; mm < 2; ++mm) _Pragma("unroll") for (int bj = 0; bj < 2; ++bj) { \
            const size_t r_ = (size_t)(row0 + ((g) >> 1) * HALF + (((g) & 1) * 2 + mm) * 16); \
            gv[b][mm * 2 + bj] = *(const PG8_GAS u32x4*)((const PG8_GAS bf16_t*)G + r_ * ldg + col0 + bj * HALF); \
            if (ADD_PREV) pv[b][mm * 2 + bj] = *(const PG8_GAS u32x4*)((const PG8_GAS bf16_t*)P + r_ * ldc + col0 + bj * HALF); } } while (0)
#define PG8_EG_PROC(g, b) do { _Pragma("unroll") for (int mm = 0; mm < 2; ++mm) _Pragma("unroll") for (int bj = 0; bj < 2; ++bj) { \
            const int ai_ = (g) >> 1, m_ = ((g) & 1) * 2 + mm; \
            f32x4 v0 = acc[ai_][bj][m_][0], v1 = acc[ai_][bj][m_][1]; const u32x4 g_ = gv[b][mm * 2 + bj]; \
            v0[0] *= bf_lo(g_.x); v0[1] *= bf_hi(g_.x); v0[2] *= bf_lo(g_.y); v0[3] *= bf_hi(g_.y); v1[0] *= bf_lo(g_.z); v1[1] *= bf_hi(g_.z); v1[2] *= bf_lo(g_.w); v1[3] *= bf_hi(g_.w); \
            if (ADD_PREV) { const u32x4 p_ = pv[b][mm * 2 + bj]; \
                v0[0] += bf_lo(p_.x); v0[1] += bf_hi(p_.x); v0[2] += bf_lo(p_.y); v0[3] += bf_hi(p_.y); v1[0] += bf_lo(p_.z); v1[1] += bf_hi(p_.z); v1[2] += bf_lo(p_.w); v1[3] += bf_hi(p_.w); } \
            u32x4 w_; w_.x = cvt_pk_bf16(v0[0], v0[1]); w_.y = cvt_pk_bf16(v0[2], v0[3]); w_.z = cvt_pk_bf16(v1[0], v1[1]); w_.w = cvt_pk_bf16(v1[2], v1[3]); \
            st_remap(stg, fr, fq, lane, w_, (PG8_GAS bf16_t*)O + (size_t)(rowb + ai_ * HALF + m_ * 16) * ldc + colb + bj * HALF, ldc); } } while (0)
        PG8_EG_LOAD(0, 0); PG8_EG_LOAD(1, 1);
        PG8_EG_PROC(0, 0); PG8_EG_LOAD(2, 0);
        PG8_EG_PROC(1, 1); PG8_EG_LOAD(3, 1);
        PG8_EG_PROC(2, 0); PG8_EG_PROC(3, 1);
#undef PG8_EG_LOAD
#undef PG8_EG_PROC
    }
};

template <class Epi, class Sched, bool ALIGN_EPI, bool I8 = false>
__device__ __forceinline__ void gemm_phase(PG8_LAS unsigned char* lds, const Gemm g, const Sched& S, const Epi& E) {
    int tid_ = threadIdx.x; asm volatile("" : "+v"(tid_));
    const int tid = tid_, wid = __builtin_amdgcn_readfirstlane(tid >> 6), lane = tid & 63, wr = wid >> 2, wc = wid & 3, fr = lane & 15, fq = lane >> 4;
    const int K = g.K, nt = K / BK;
    unsigned voffA[2], voffB[2];
#pragma unroll
    for (int i = 0; i < 2; ++i) { int R, C; stage_rc(tid * 16 + i * 8192, R, C); const int Rb = Epi::PERM ? ((R & ~31) + perm32(R & 31)) : R;
        voffA[i] = (unsigned)(R * g.lda + C) * 2u; voffB[i] = (unsigned)(Rb * g.ldb + C) * 2u; }
    const size_t kstep = (size_t)(BK * 2);
    const size_t hstepA = (size_t)HALF * g.lda * 2, hstepB = (size_t)HALF * g.ldb * 2;
    const size_t tstepA = 2 * hstepA, tstepB = 2 * hstepB;
    const unsigned ldsw = (unsigned)wid * 1024u;
    const int aoff0 = lds_byte(wr * 64 + fr, fq * 8), aoff1 = lds_byte(wr * 64 + fr, 32 + fq * 8), boff0 = lds_byte(wc * 32 + fr, fq * 8), boff1 = lds_byte(wc * 32 + fr, 32 + fq * 8);
#define PG8_SA(b, h) (((b) * 2 + (h)) * HTB)
#define PG8_SB(b, h) ((4 + (b) * 2 + (h)) * HTB)
#define PG8_STAGE(bufoff, gbase, voff) do { _Pragma("unroll") for (int _i = 0; _i < 2; ++_i) \
        __builtin_amdgcn_global_load_lds((const unsigned*)((const char*)(gbase) + (voff)[_i]), (PG8_LAS unsigned*)(lds + (bufoff) + ldsw + _i * 8192), 16, 0, 0); } while (0)
#define PG8_LDA(dst, b, h) do { _Pragma("unroll") for (int m = 0; m < 4; ++m) _Pragma("unroll") for (int k = 0; k < 2; ++k) dst[m][k] = *(const PG8_LAS bf16x8*)(lds + PG8_SA(b, h) + (k ? aoff1 : aoff0) + m * 2048); } while (0)
#define PG8_LDB(dst, b, h) do { _Pragma("unroll") for (int n = 0; n < 2; ++n) _Pragma("unroll") for (int k = 0; k < 2; ++k) dst[n][k] = *(const PG8_LAS bf16x8*)(lds + PG8_SB(b, h) + (k ? boff1 : boff0) + n * 2048); } while (0)
#define PG8_MMA(ai, bj, At, Bt) do { __builtin_amdgcn_s_setprio(1); _Pragma("unroll") for (int m = 0; m < 4; ++m) _Pragma("unroll") for (int n = 0; n < 2; ++n) _Pragma("unroll") for (int k = 0; k < 2; ++k) \
        { if (I8) acc[ai][bj][m][n] = __builtin_bit_cast(f32x4, __builtin_amdgcn_mfma_i32_16x16x64_i8(__builtin_bit_cast(i32x4, Bt[n][k]), __builtin_bit_cast(i32x4, At[m][k]), __builtin_bit_cast(i32x4, acc[ai][bj][m][n]), 0, 0, 0)); \
          else acc[ai][bj][m][n] = __builtin_amdgcn_mfma_f32_16x16x32_bf16(Bt[n][k], At[m][k], acc[ai][bj][m][n], 0, 0, 0); } __builtin_amdgcn_s_setprio(0); } while (0)
#define PG8_WAIT_V(n) asm volatile("s_waitcnt vmcnt(" #n ")" ::: "memory")
#define PG8_WAIT_L(n) asm volatile("s_waitcnt lgkmcnt(" #n ")" ::: "memory")
#define PG8_BAR __builtin_amdgcn_s_barrier()
#define PG8_SCHED __builtin_amdgcn_sched_barrier(0)
    Unit cur, nxt; int ui = 0;
    if (!S.next(0, cur)) return;
    f32x4 acc[2][2][4][2];
#pragma unroll
    for (int a = 0; a < 2; ++a)
#pragma unroll
        for (int b = 0; b < 2; ++b)
#pragma unroll
            for (int m = 0; m < 4; ++m)
#pragma unroll
                for (int n = 0; n < 2; ++n) acc[a][b][m][n] = (f32x4){0.f, 0.f, 0.f, 0.f};
    bf16x8 At[4][2], B0[2][2], B1[2][2];
    const char* cA = (const char*)g.A + (size_t)cur.pm * tstepA; const char* cB = (const char*)g.Bt + (size_t)cur.pn * tstepB;
    S.a_ready(cur);
    PG8_STAGE(PG8_SB(0, 0), cB, voffB); PG8_STAGE(PG8_SB(0, 1), cB + hstepB, voffB); PG8_STAGE(PG8_SA(0, 0), cA, voffA); PG8_STAGE(PG8_SA(0, 1), cA + hstepA, voffA);
    if (wr == 1) PG8_BAR;
    PG8_WAIT_V(2); PG8_BAR;
    PG8_STAGE(PG8_SB(1, 0), cB + kstep, voffB); PG8_STAGE(PG8_SA(1, 0), cA + kstep, voffA); PG8_STAGE(PG8_SB(1, 1), cB + hstepB + kstep, voffB);
    PG8_WAIT_V(6); PG8_BAR;
    for (;;) {
        const bool has_next = S.next(ui + 1, nxt);
        const char* nA = has_next ? (const char*)g.A + (size_t)nxt.pm * tstepA : cA; const char* nB = has_next ? (const char*)g.Bt + (size_t)nxt.pn * tstepB : cB;
        for (int t = 0; t < nt; t += 2) {
            const bool last = (t == nt - 2);
            const char* a1 = cA + (size_t)(t + 1) * kstep;
            const char* a2 = last ? nA : cA + (size_t)(t + 2) * kstep; const char* b2 = last ? nB : cB + (size_t)(t + 2) * kstep;
            const char* a3 = a2 + kstep; const char* b3 = b2 + kstep;
            if (last && has_next) S.a_ready(nxt);
            PG8_LDB(B0, 0, 0); PG8_LDB(B1, 0, 1); PG8_SCHED; PG8_LDA(At, 0, 0); PG8_STAGE(PG8_SA(1, 1), a1 + hstepA, voffA);
            PG8_WAIT_V(8); PG8_WAIT_L(0); PG8_BAR; PG8_MMA(0, 0, At, B0); PG8_MMA(0, 1, At, B1); PG8_BAR; PG8_SCHED;
            PG8_LDA(At, 0, 1); PG8_STAGE(PG8_SB(0, 0), b2, voffB); PG8_STAGE(PG8_SB(0, 1), b2 + hstepB, voffB); PG8_STAGE(PG8_SA(0, 0), a2, voffA);
            PG8_WAIT_V(8); PG8_WAIT_L(0); PG8_BAR; PG8_MMA(1, 0, At, B0); PG8_MMA(1, 1, At, B1); PG8_BAR; PG8_SCHED;
            PG8_LDB(B0, 1, 0); PG8_LDB(B1, 1, 1); PG8_SCHED; PG8_LDA(At, 1, 0); PG8_STAGE(PG8_SA(0, 1), a2 + hstepA, voffA);
            PG8_WAIT_V(8); PG8_WAIT_L(0); PG8_BAR; PG8_MMA(0, 0, At, B0); PG8_MMA(0, 1, At, B1); PG8_BAR; PG8_SCHED;
            PG8_LDA(At, 1, 1); PG8_STAGE(PG8_SB(1, 0), b3, voffB); PG8_STAGE(PG8_SB(1, 1), b3 + hstepB, voffB); PG8_STAGE(PG8_SA(1, 0), a3, voffA);
            PG8_WAIT_V(8); PG8_WAIT_L(0); PG8_BAR; PG8_MMA(1, 0, At, B0); PG8_MMA(1, 1, At, B1); PG8_BAR; PG8_SCHED;
        }
        if constexpr (ALIGN_EPI) { if (wr == 0) PG8_BAR; }
        E(acc, cur, wr, wc, fr, fq, lds + STAGE_BYTES + wid * 1024, lane); S.done(cur);
        if (!has_next) break;
#pragma unroll
        for (int a = 0; a < 2; ++a)
#pragma unroll
            for (int b = 0; b < 2; ++b)
#pragma unroll
                for (int m = 0; m < 4; ++m)
#pragma unroll
                    for (int n = 0; n < 2; ++n) acc[a][b][m][n] = (f32x4){0.f, 0.f, 0.f, 0.f};
        cur = nxt; cA = nA; cB = nB; ++ui;
        if constexpr (ALIGN_EPI) { if (wr == 1) PG8_BAR; }
    }
    PG8_WAIT_V(0);
    if constexpr (!ALIGN_EPI) { if (wr == 0) PG8_BAR; }
    PG8_BAR;
#undef PG8_SA
#undef PG8_SB
#undef PG8_STAGE
#undef PG8_LDA
#undef PG8_LDB
#undef PG8_MMA
#undef PG8_WAIT_V
#undef PG8_WAIT_L
#undef PG8_BAR
#undef PG8_SCHED
}
}
#define GAS __attribute__((address_space(1)))
#define LAS __attribute__((address_space(3)))
typedef unsigned short bf16;
typedef unsigned v4u __attribute__((ext_vector_type(4)));
typedef float f32x4 __attribute__((ext_vector_type(4)));
typedef short bf16x8 __attribute__((ext_vector_type(8)));
typedef GAS unsigned gu32;
typedef GAS unsigned long long gu64;
#define RLX_AGENT __ATOMIC_RELAXED, __HIP_MEMORY_SCOPE_AGENT
#define LDS_WAIT() asm volatile("s_waitcnt lgkmcnt(0)" ::: "memory")
#define VM_WAIT() asm volatile("s_waitcnt vmcnt(0)" ::: "memory")
__device__ __forceinline__ unsigned long long rt() { return __builtin_amdgcn_s_memrealtime(); }
__device__ __forceinline__ unsigned f2bf(float f) { unsigned u = __builtin_bit_cast(unsigned, f); return (u + 0x7fffu + ((u >> 16) & 1u)) >> 16; }
__device__ __forceinline__ unsigned pk2(float lo, float hi) { return f2bf(lo) | (f2bf(hi) << 16); }

#define XB_TMO      128
#define XB_XCNT(j)  (256  + 64 * (j))
#define XB_XSUB(j)  (1280 + 64 * (j))
#define XB_XGEN(j)  (2304 + 64 * (j))
#define XB_TOP      3328
#define XB_TOPGEN   3392
#define XCD_BAR_WORDS 3456
#define XB_SPIN_CAP (1u << 18)

__device__ __forceinline__ unsigned xb_ld(unsigned* p)              { return __hip_atomic_load(p, __ATOMIC_RELAXED, __HIP_MEMORY_SCOPE_AGENT); }
__device__ __forceinline__ unsigned xb_add(unsigned* p, unsigned v) { return __hip_atomic_fetch_add(p, v, __ATOMIC_RELAXED, __HIP_MEMORY_SCOPE_AGENT); }
__device__ __forceinline__ unsigned xb_xcc_id() { return (unsigned)__builtin_amdgcn_s_getreg((3 << 11) | 20) & 0xFu; }
#define XB_SPIN(cond, bar) do { unsigned _sp = 0; while (cond) { __builtin_amdgcn_s_sleep(1); \
    if ((++_sp & 255u) == 0u) { if (xb_ld(&(bar)[XB_TMO])) break; if (_sp > XB_SPIN_CAP) { atomicAdd(&(bar)[XB_TMO], 1u); break; } } } } while (0)

struct XcdBarrier {
    unsigned* bar; unsigned x;
    volatile LAS unsigned* st;
};

__device__ __forceinline__ XcdBarrier xcd_barrier_post(unsigned* bar, volatile LAS unsigned* st) {
    XcdBarrier b; b.bar = bar; b.x = xb_xcc_id(); b.st = st;
    if (threadIdx.x == 0) (void)xb_add(&bar[XB_XCNT(b.x)], 1u);
    return b;
}
__device__ __forceinline__ void xcd_barrier_complete(unsigned* bar, unsigned x, unsigned& nloc, unsigned& nx) {
    const unsigned G = gridDim.x * gridDim.y * gridDim.z;
    unsigned sum, cnt, mine, sp = 0u;
    for (;;) {
        sum = 0u; cnt = 0u; mine = 0u;
#pragma unroll
        for (unsigned j = 0; j < 16; ++j) { const unsigned c = xb_ld(&bar[XB_XCNT(j)]); sum += c; cnt += (c > 0u) ? 1u : 0u; mine = (j == x) ? c : mine; }
        if (sum == G) break;
        __builtin_amdgcn_s_sleep(1);
        if ((++sp & 255u) == 0u) { if (xb_ld(&bar[XB_TMO])) break; if (sp > XB_SPIN_CAP) { atomicAdd(&bar[XB_TMO], 1u); break; } }
    }
    nloc = mine > 0u ? mine : 1u; nx = cnt > 0u ? cnt : 1u;
}

__device__ __forceinline__ void xcd_barrier(const XcdBarrier& b) {
    asm volatile("s_waitcnt vmcnt(0)" ::: "memory");
    __syncthreads();
    if (threadIdx.x == 0) {
        unsigned* bar = b.bar;
        __builtin_amdgcn_s_waitcnt(0);
        unsigned nloc = b.st[0], nx = b.st[1];
        if (nloc == 0u) { xcd_barrier_complete(bar, b.x, nloc, nx); b.st[0] = nloc; b.st[1] = nx; }
        const unsigned old = xb_add(&bar[XB_XSUB(b.x)], 1u);
        const unsigned gen = old / nloc;
        if (old + 1u == (gen + 1u) * nloc) {
            __builtin_amdgcn_fence(__ATOMIC_RELEASE, "agent");
            asm volatile("s_waitcnt vmcnt(0)" ::: "memory");
            const unsigned og = xb_add(&bar[XB_TOP], 1u);
            const unsigned tg = og / nx;
            if (og + 1u == (tg + 1u) * nx) xb_add(&bar[XB_TOPGEN], 1u);
            else XB_SPIN(xb_ld(&bar[XB_TOPGEN]) == tg, bar);
            __builtin_amdgcn_fence(__ATOMIC_ACQUIRE, "agent");
            xb_add(&bar[XB_XGEN(b.x)], 1u);
            asm volatile("s_waitcnt vmcnt(0)" ::: "memory");
        } else {
            XB_SPIN(xb_ld(&bar[XB_XGEN(b.x)]) == gen, bar);
            __builtin_amdgcn_fence(__ATOMIC_ACQUIRE, "agent");
            asm volatile("s_waitcnt vmcnt(0)" ::: "memory");
        }
    }
    __syncthreads();
}

constexpr int NWAVES = 8;
constexpr int RING_OFF = 0, RING_BYTES = 131072;
constexpr int LDSCTL_OFF = 143360, MISC_OFF = LDSCTL_OFF + 320;
constexpr int LDS_BYTES = 147456;
static_assert(MISC_OFF + 128 <= LDS_BYTES, "LDS map");

struct Frame {
    LAS unsigned char* lds;
    volatile LAS unsigned* MISC;
    gu32* ctl;
    int tid, lane, wave;
    int vcu, G;
};
__device__ __forceinline__ float wave_sum(float v) {
#pragma unroll
    for (int o = 1; o < 64; o <<= 1) v += __shfl_xor(v, o);
    return v;
}

__device__ __forceinline__ float wave_max(float v) {
#pragma unroll
    for (int o = 1; o < 64; o <<= 1) v = fmaxf(v, __shfl_xor(v, o));
    return v;
}
__device__ __forceinline__ unsigned q8pack4(float a, float b, float c, float d) {
    const int ia = (int)__builtin_rintf(a), ib = (int)__builtin_rintf(b), ic = (int)__builtin_rintf(c), id = (int)__builtin_rintf(d);
    return (unsigned)(ia & 255) | ((unsigned)(ib & 255) << 8) | ((unsigned)(ic & 255) << 16) | ((unsigned)(id & 255) << 24);
}
__device__ __forceinline__ void transpose_item(const float* __restrict__ W, int K, int N, bf16* __restrict__ WT, LAS float* scr, int kb, int nb, int lane, const float* __restrict__ gain) {
    const int k0 = 64 * kb, n0 = 64 * nb;
    f32x4 v[16];
#pragma unroll
    for (int i = 0; i < 16; ++i) { const int kk = 4 * i + (lane >> 4); v[i] = *(const f32x4*)(W + (size_t)(k0 + kk) * N + n0 + 4 * (lane & 15)); }
    if (gain) {
#pragma unroll
        for (int i = 0; i < 16; ++i) v[i] = v[i] * gain[k0 + 4 * i + (lane >> 4)]; }
#pragma unroll
    for (int i = 0; i < 16; ++i) { const int kk = 4 * i + (lane >> 4); LAS float* d = scr + kk * 65 + 4 * (lane & 15); d[0] = v[i].x; d[1] = v[i].y; d[2] = v[i].z; d[3] = v[i].w; }
    LDS_WAIT(); asm volatile("" ::: "memory");
    const int c = lane & 7;
#pragma unroll
    for (int j = 0; j < 8; ++j) { const int n = (lane >> 3) + 8 * j; const LAS float* s = scr + (8 * c) * 65 + n;
        v4u o; o.x = pk2(s[0 * 65], s[1 * 65]); o.y = pk2(s[2 * 65], s[3 * 65]); o.z = pk2(s[4 * 65], s[5 * 65]); o.w = pk2(s[6 * 65], s[7 * 65]);
        *(GAS v4u*)(WT + (size_t)(n0 + n) * K + k0 + 8 * c) = o; }
    LDS_WAIT(); asm volatile("" ::: "memory");
}

struct Ptrs {
    const float* x; const float* meta; const float* relb; const float* w_in; const float* w_a; const float* w_b; const float* w_out;
    const float* lq1; const float* lk1; const float* lq2; const float* lk2; const float* dnorm; const float* sinks;
    const float* n_attn_pre; const float* n_attn_post; const float* w_ff1; const float* w_ff2; const float* n_ff_pre; const float* n_ff_post;
    float* out; unsigned char* ws;
};

typedef const __attribute__((address_space(4))) Ptrs* CPtrs;
__device__ __forceinline__ void gate_colmax_pass(Frame& F, const float* __restrict__ w_in, const float* __restrict__ g_in, unsigned* __restrict__ cmax) {
    const int lane = F.lane, w = F.wave;
    LAS f32x4* part = (LAS f32x4*)F.lds;
    for (int it = F.vcu; it < DEPTH * 64; it += F.G) {
        const int l = it / 64, nb = it % 64;
        const float* W = w_in + (size_t)l * DM * INW + C_GA + 64 * nb + 4 * (lane & 15); const float* g = g_in + l * DM;
        f32x4 m = (f32x4){0.f, 0.f, 0.f, 0.f};
        for (int kb = 4 * w; kb < 4 * w + 4; ++kb) {
#pragma unroll
            for (int i = 0; i < 16; ++i) { const int kk = 64 * kb + 4 * i + (lane >> 4); const f32x4 v = *(const f32x4*)(W + (size_t)kk * INW) * g[kk];
                m.x = fmaxf(m.x, fabsf(v.x)); m.y = fmaxf(m.y, fabsf(v.y)); m.z = fmaxf(m.z, fabsf(v.z)); m.w = fmaxf(m.w, fabsf(v.w)); } }
#pragma unroll
        for (int o = 16; o < 64; o <<= 1) { m.x = fmaxf(m.x, __shfl_xor(m.x, o)); m.y = fmaxf(m.y, __shfl_xor(m.y, o)); m.z = fmaxf(m.z, __shfl_xor(m.z, o)); m.w = fmaxf(m.w, __shfl_xor(m.w, o)); }
        if (lane < 16) part[w * 16 + lane] = m;
        __syncthreads();
        if (w == 0 && lane < 16) { f32x4 t = part[lane];
#pragma unroll
            for (int j = 1; j < 8; ++j) { const f32x4 q = part[j * 16 + lane]; t.x = fmaxf(t.x, q.x); t.y = fmaxf(t.y, q.y); t.z = fmaxf(t.z, q.z); t.w = fmaxf(t.w, q.w); }
            unsigned* c = cmax + l * 4096 + 64 * nb + 4 * lane; c[0] = __float_as_uint(t.x); c[1] = __float_as_uint(t.y); c[2] = __float_as_uint(t.z); c[3] = __float_as_uint(t.w); }
        __syncthreads();
    }
}
__device__ __forceinline__ void gate_quant_item(const float* __restrict__ W, signed char* __restrict__ WQ, const unsigned* __restrict__ cmax, float* __restrict__ cs, LAS float* scr, int kb, int nb, int lane, const float* __restrict__ gain) {
    const int k0 = 64 * kb, n0 = 64 * nb;
    f32x4 v[16];
#pragma unroll
    for (int i = 0; i < 16; ++i) { const int kk = 4 * i + (lane >> 4); v[i] = *(const f32x4*)(W + (size_t)(k0 + kk) * INW + C_GA + n0 + 4 * (lane & 15)) * gain[k0 + kk]; }
#pragma unroll
    for (int i = 0; i < 16; ++i) { const int kk = 4 * i + (lane >> 4); LAS float* d = scr + kk * 65 + 4 * (lane & 15); d[0] = v[i].x; d[1] = v[i].y; d[2] = v[i].z; d[3] = v[i].w; }
    LDS_WAIT(); asm volatile("" ::: "memory");
    const int c = lane & 7;
#pragma unroll
    for (int j = 0; j < 8; ++j) { const int n = (lane >> 3) + 8 * j; const LAS float* s = scr + (8 * c) * 65 + n;
        const float mx = __uint_as_float(cmax[n0 + n]), inv = mx > 0.f ? 127.f / mx : 0.f;
        typedef unsigned u32x2 __attribute__((ext_vector_type(2))); u32x2 o;
        o.x = q8pack4(s[0 * 65] * inv, s[1 * 65] * inv, s[2 * 65] * inv, s[3 * 65] * inv); o.y = q8pack4(s[4 * 65] * inv, s[5 * 65] * inv, s[6 * 65] * inv, s[7 * 65] * inv);
        *(GAS u32x2*)(WQ + (size_t)(n0 + n) * DM + k0 + 8 * c) = o;
        if (kb == 0 && c == 0) cs[n0 + n] = mx * (1.f / 127.f); }
    LDS_WAIT(); asm volatile("" ::: "memory");
}
__device__ __forceinline__ void gate_quant_pass(Frame& F, const float* __restrict__ w_in, const float* __restrict__ g_in, signed char* __restrict__ wq, const unsigned* __restrict__ cmax, float* __restrict__ cs) {
    LAS float* scr = (LAS float*)(F.lds + F.wave * 16640);
    const int gw = F.vcu * NWAVES + F.wave, NGW = F.G * NWAVES;
    for (int it = gw; it < DEPTH * 16 * 64; it += NGW) {
        const int l = it / (16 * 64), kb2 = (it / 64) % 16, nb = it % 64;
        gate_quant_item(w_in + (size_t)l * DM * INW, wq + (size_t)l * 4096 * DM, cmax + l * 4096, cs + l * 4096, scr, 2 * kb2, nb, F.lane, g_in + l * DM);
        gate_quant_item(w_in + (size_t)l * DM * INW, wq + (size_t)l * 4096 * DM, cmax + l * 4096, cs + l * 4096, scr, 2 * kb2 + 1, nb, F.lane, g_in + l * DM);
    }
}
__device__ __forceinline__ void p0_transposes(Frame& F, CPtrs PPk) {
    struct { const float *w_in, *w_a, *w_b, *w_out, *w_ff1, *w_ff2, *g_in, *g_ff; unsigned char* ws; } P = {PPk->w_in, PPk->w_a, PPk->w_b, PPk->w_out, PPk->w_ff1, PPk->w_ff2, PPk->n_attn_pre, PPk->n_ff_pre, PPk->ws};
    LAS float* scr = (LAS float*)(F.lds + F.wave * 16640);
    const int gw = F.vcu * NWAVES + F.wave, NGW = F.G * NWAVES;
    constexpr int I_IN = 32 * 132, I_A = 16 * 32, I_O = 32 * 32, I_1 = 32 * 128, I_2 = 128 * 32, I_L = I_IN + 2 * I_A + I_O + I_1 + I_2;
    asm volatile("" ::: "memory");
    bf16* ws_in = (bf16*)(P.ws + WS_WIN); bf16* ws_a = (bf16*)(P.ws + WS_WA); bf16* ws_b = (bf16*)(P.ws + WS_WB); bf16* ws_o = (bf16*)(P.ws + WS_WOUT);
    bf16* ws_1 = (bf16*)(P.ws + WS_W1); bf16* ws_2 = (bf16*)(P.ws + WS_W2);
    for (int it = gw; it < DEPTH * I_L; it += NGW) {
        const int l = it / I_L; int r = it % I_L;
        if (r < I_IN) { transpose_item(P.w_in + (size_t)l * DM * INW, DM, INW, ws_in + (size_t)l * INW * DM, scr, r / 132, r % 132, F.lane, P.g_in + l * DM); continue; } r -= I_IN;
        if (r < I_A) { transpose_item(P.w_a + (size_t)l * 1024 * DM, 1024, DM, ws_a + (size_t)l * DM * 1024, scr, r / 32, r % 32, F.lane, nullptr); continue; } r -= I_A;
        if (r < I_A) { transpose_item(P.w_b + (size_t)l * 1024 * DM, 1024, DM, ws_b + (size_t)l * DM * 1024, scr, r / 32, r % 32, F.lane, nullptr); continue; } r -= I_A;
        if (r < I_O) { transpose_item(P.w_out + (size_t)l * DM * DM, DM, DM, ws_o + (size_t)l * DM * DM, scr, r / 32, r % 32, F.lane, nullptr); continue; } r -= I_O;
        if (r < I_1) { transpose_item(P.w_ff1 + (size_t)l * DM * DFF, DM, DFF, ws_1 + (size_t)l * DFF * DM, scr, r / 128, r % 128, F.lane, P.g_ff + l * DM); continue; } r -= I_1;
        transpose_item(P.w_ff2 + (size_t)l * DFF * DM, DFF, DM, ws_2 + (size_t)l * DM * DFF, scr, r / 32, r % 32, F.lane, nullptr);
    }
}

template <bool HAS_T, bool WRITE_U>
__device__ __forceinline__ void norm_phase(Frame& F, const float* hin_real, const float* hin_meta, float* hout_real, float* hout_meta,
                                           const bf16* T, const float* gpost, const float* gpre, bf16* U, int nrows = NROWS) {
    asm volatile("" : "+s"(hin_real), "+s"(hin_meta), "+s"(hout_real), "+s"(hout_meta), "+s"(T), "+s"(U));
    LAS float* gp = (LAS float*)(F.lds); LAS float* gq = gp + 2048;
    for (int i = F.tid; i < 2048; i += NWAVES * 64) { gp[i] = HAS_T ? gpost[i] : 0.f; gq[i] = WRITE_U ? gpre[i] : 0.f; }
    __syncthreads();
    const int gw = F.vcu * NWAVES + F.wave, NGW = F.G * NWAVES;
    for (int row = gw; row < nrows; row += NGW) {
        const bool real = row < ROW_META;
        const float* hr = real ? hin_real + (size_t)row * DM : hin_meta + (size_t)(row - ROW_META) * DM;
        float* ho = real ? (hout_real ? hout_real + (size_t)row * DM : nullptr) : hout_meta + (size_t)(row - ROW_META) * DM;
        f32x4 hv[4][2]; v4u tv[4];
#pragma unroll
        for (int k = 0; k < 4; ++k) { const int ci = F.lane + 64 * k;
            if (HAS_T) tv[k] = *(const GAS v4u*)(T + (size_t)row * DM + 8 * ci);
            hv[k][0] = *(const GAS f32x4*)(hr + 8 * ci); hv[k][1] = *(const GAS f32x4*)(hr + 8 * ci + 4); }
        if (HAS_T) {
            float ss = 0.f; float tf[4][8];
#pragma unroll
            for (int k = 0; k < 4; ++k) {
                tf[k][0] = pg8::bf_lo(tv[k].x); tf[k][1] = pg8::bf_hi(tv[k].x); tf[k][2] = pg8::bf_lo(tv[k].y); tf[k][3] = pg8::bf_hi(tv[k].y);
                tf[k][4] = pg8::bf_lo(tv[k].z); tf[k][5] = pg8::bf_hi(tv[k].z); tf[k][6] = pg8::bf_lo(tv[k].w); tf[k][7] = pg8::bf_hi(tv[k].w);
#pragma unroll
                for (int e = 0; e < 8; ++e) ss += tf[k][e] * tf[k][e]; }
            const float rstd = 1.0f / sqrtf(wave_sum(ss) * (1.f / DM) + EPS);
#pragma unroll
            for (int k = 0; k < 4; ++k) { const int ci = F.lane + 64 * k; const f32x4 g0 = *(const LAS f32x4*)(gp + 8 * ci), g1 = *(const LAS f32x4*)(gp + 8 * ci + 4);
                hv[k][0].x += tf[k][0] * rstd * g0.x; hv[k][0].y += tf[k][1] * rstd * g0.y; hv[k][0].z += tf[k][2] * rstd * g0.z; hv[k][0].w += tf[k][3] * rstd * g0.w;
                hv[k][1].x += tf[k][4] * rstd * g1.x; hv[k][1].y += tf[k][5] * rstd * g1.y; hv[k][1].z += tf[k][6] * rstd * g1.z; hv[k][1].w += tf[k][7] * rstd * g1.w; }
        }
        if (ho) {
#pragma unroll
            for (int k = 0; k < 4; ++k) { const int ci = F.lane + 64 * k; *(GAS f32x4*)(ho + 8 * ci) = hv[k][0]; *(GAS f32x4*)(ho + 8 * ci + 4) = hv[k][1]; }
        }
        if (WRITE_U) {
            float ss = 0.f;
#pragma unroll
            for (int k = 0; k < 4; ++k) ss += (hv[k][0].x * hv[k][0].x + hv[k][0].y * hv[k][0].y) + (hv[k][0].z * hv[k][0].z + hv[k][0].w * hv[k][0].w)
                                            + (hv[k][1].x * hv[k][1].x + hv[k][1].y * hv[k][1].y) + (hv[k][1].z * hv[k][1].z + hv[k][1].w * hv[k][1].w);
            const float rstd = 1.0f / sqrtf(wave_sum(ss) * (1.f / DM) + EPS);
#pragma unroll
            for (int k = 0; k < 4; ++k) { const int ci = F.lane + 64 * k; const f32x4 g0 = *(const LAS f32x4*)(gq + 8 * ci), g1 = *(const LAS f32x4*)(gq + 8 * ci + 4);
                v4u o; o.x = pk2(hv[k][0].x * rstd * g0.x, hv[k][0].y * rstd * g0.y); o.y = pk2(hv[k][0].z * rstd * g0.z, hv[k][0].w * rstd * g0.w);
                o.z = pk2(hv[k][1].x * rstd * g1.x, hv[k][1].y * rstd * g1.y); o.w = pk2(hv[k][1].z * rstd * g1.z, hv[k][1].w * rstd * g1.w);
                *(GAS v4u*)(U + (size_t)row * DM + 8 * ci) = o; }
        }
    }
    __syncthreads();
}


template <int MODE>
__device__ __forceinline__ void resid_phase(Frame& F, const float* x, const float* meta, bf16* H, float* RS, const bf16* T, const float* gpost, float* out, signed char* HQ = nullptr, float* QS = nullptr) {
    asm volatile("" : "+s"(x), "+s"(meta), "+s"(H), "+s"(RS), "+s"(T), "+s"(out));
    LAS float* gp = (LAS float*)(F.lds);
    if (MODE != 0) { for (int i = F.tid; i < 2048; i += NWAVES * 64) gp[i] = gpost[i]; }
    __syncthreads();
    const int gw = F.vcu * NWAVES + F.wave, NGW = F.G * NWAVES;
    const int nrows = (MODE == 2) ? ROW_META : NROWS;
    for (int row = gw; row < nrows; row += NGW) {
        f32x4 hv[4][2];
        if (MODE == 0) {
            const float* hr = row < ROW_META ? x + (size_t)row * DM : meta + (size_t)(row - ROW_META) * DM;
#pragma unroll
            for (int k = 0; k < 4; ++k) { const int ci = F.lane + 64 * k; hv[k][0] = *(const GAS f32x4*)(hr + 8 * ci); hv[k][1] = *(const GAS f32x4*)(hr + 8 * ci + 4); }
        } else {
            v4u tv[4], hb[4];
#pragma unroll
            for (int k = 0; k < 4; ++k) { const int ci = F.lane + 64 * k; tv[k] = *(const GAS v4u*)(T + (size_t)row * DM + 8 * ci); hb[k] = *(const GAS v4u*)(H + (size_t)row * DM + 8 * ci); }
            float ss = 0.f; float tf[4][8];
#pragma unroll
            for (int k = 0; k < 4; ++k) {
                tf[k][0] = pg8::bf_lo(tv[k].x); tf[k][1] = pg8::bf_hi(tv[k].x); tf[k][2] = pg8::bf_lo(tv[k].y); tf[k][3] = pg8::bf_hi(tv[k].y);
                tf[k][4] = pg8::bf_lo(tv[k].z); tf[k][5] = pg8::bf_hi(tv[k].z); tf[k][6] = pg8::bf_lo(tv[k].w); tf[k][7] = pg8::bf_hi(tv[k].w);
#pragma unroll
                for (int e = 0; e < 8; ++e) ss += tf[k][e] * tf[k][e]; }
            const float rstd = 1.0f / sqrtf(wave_sum(ss) * (1.f / DM) + EPS);
#pragma unroll
            for (int k = 0; k < 4; ++k) { const int ci = F.lane + 64 * k; const f32x4 g0 = *(const LAS f32x4*)(gp + 8 * ci), g1 = *(const LAS f32x4*)(gp + 8 * ci + 4);
                hv[k][0].x = pg8::bf_lo(hb[k].x) + tf[k][0] * rstd * g0.x; hv[k][0].y = pg8::bf_hi(hb[k].x) + tf[k][1] * rstd * g0.y; hv[k][0].z = pg8::bf_lo(hb[k].y) + tf[k][2] * rstd * g0.z; hv[k][0].w = pg8::bf_hi(hb[k].y) + tf[k][3] * rstd * g0.w;
                hv[k][1].x = pg8::bf_lo(hb[k].z) + tf[k][4] * rstd * g1.x; hv[k][1].y = pg8::bf_hi(hb[k].z) + tf[k][5] * rstd * g1.y; hv[k][1].z = pg8::bf_lo(hb[k].w) + tf[k][6] * rstd * g1.z; hv[k][1].w = pg8::bf_hi(hb[k].w) + tf[k][7] * rstd * g1.w; }
        }
        if (MODE == 2) {
            float* ho = out + (size_t)row * DM;
#pragma unroll
            for (int k = 0; k < 4; ++k) { const int ci = F.lane + 64 * k; *(GAS f32x4*)(ho + 8 * ci) = hv[k][0]; *(GAS f32x4*)(ho + 8 * ci + 4) = hv[k][1]; }
        } else {
            float ss = 0.f;
#pragma unroll
            for (int k = 0; k < 4; ++k) ss += (hv[k][0].x * hv[k][0].x + hv[k][0].y * hv[k][0].y) + (hv[k][0].z * hv[k][0].z + hv[k][0].w * hv[k][0].w)
                                            + (hv[k][1].x * hv[k][1].x + hv[k][1].y * hv[k][1].y) + (hv[k][1].z * hv[k][1].z + hv[k][1].w * hv[k][1].w);
            const float rstd = 1.0f / sqrtf(wave_sum(ss) * (1.f / DM) + EPS);
            if (F.lane == 0) RS[row] = rstd;
            if (HQ) {
                float am = 0.f;
#pragma unroll
                for (int k = 0; k < 4; ++k) am = fmaxf(fmaxf(fmaxf(am, fmaxf(fabsf(hv[k][0].x), fabsf(hv[k][0].y))), fmaxf(fabsf(hv[k][0].z), fabsf(hv[k][0].w))), fmaxf(fmaxf(fabsf(hv[k][1].x), fabsf(hv[k][1].y)), fmaxf(fabsf(hv[k][1].z), fabsf(hv[k][1].w))));
                am = wave_max(am);
                const float inv = am > 0.f ? 127.f / am : 0.f;
                if (F.lane == 0) QS[row] = rstd * am * (1.f / 127.f);
#pragma unroll
                for (int k = 0; k < 4; ++k) { const int ci = F.lane + 64 * k; typedef unsigned u32x2 __attribute__((ext_vector_type(2))); u32x2 o;
                    o.x = q8pack4(hv[k][0].x * inv, hv[k][0].y * inv, hv[k][0].z * inv, hv[k][0].w * inv); o.y = q8pack4(hv[k][1].x * inv, hv[k][1].y * inv, hv[k][1].z * inv, hv[k][1].w * inv);
                    *(GAS u32x2*)(HQ + (size_t)row * DM + 8 * ci) = o; }
            }
#pragma unroll
            for (int k = 0; k < 4; ++k) { const int ci = F.lane + 64 * k;
                v4u o; o.x = pk2(hv[k][0].x, hv[k][0].y); o.y = pk2(hv[k][0].z, hv[k][0].w); o.z = pk2(hv[k][1].x, hv[k][1].y); o.w = pk2(hv[k][1].z, hv[k][1].w);
                *(GAS v4u*)(H + (size_t)row * DM + 8 * ci) = o; }
        }
    }
    __syncthreads();
}

template <class Epi>
__device__ __forceinline__ void meta_gemm(LAS unsigned char* lds, const bf16* A, int lda, const bf16* Bt, int ldb, int N, int K, int vcu, int G, int tid, const Epi& E) {
    const int lane = tid & 63, w = __builtin_amdgcn_readfirstlane(tid >> 6), fr = lane & 15, fq = lane >> 4;
    const int kw = K >> 3;
    LAS f32x4* part = (LAS f32x4*)lds;
    for (int tile = vcu; tile < (N >> 4); tile += G) {
        const bf16* ap = A + (size_t)fr * lda + w * kw + 8 * fq;
        const bf16* bp = Bt + (size_t)(tile * 16 + fr) * ldb + w * kw + 8 * fq;
        f32x4 acc = (f32x4){0.f, 0.f, 0.f, 0.f};
        for (int k = 0; k < kw; k += 128) {
            bf16x8 a[4], b[4];
#pragma unroll
            for (int j = 0; j < 4; ++j) { a[j] = *(const GAS bf16x8*)(ap + k + 32 * j); b[j] = *(const GAS bf16x8*)(bp + k + 32 * j); }
#pragma unroll
            for (int j = 0; j < 4; ++j) acc = __builtin_amdgcn_mfma_f32_16x16x32_bf16(b[j], a[j], acc, 0, 0, 0);
        }
        part[w * 64 + lane] = acc;
        __syncthreads();
        if (w == 0) { f32x4 s = part[lane];
#pragma unroll
            for (int j = 1; j < 8; ++j) s += part[j * 64 + lane];
            E(fr, tile * 16 + 4 * fq, s); }
        __syncthreads();
    }
}
__device__ __forceinline__ void st4bf(bf16* p, f32x4 v) { typedef unsigned u32x2 __attribute__((ext_vector_type(2))); u32x2 o; o.x = pk2(v.x, v.y); o.y = pk2(v.z, v.w); *(GAS u32x2*)p = o; }
__device__ __forceinline__ f32x4 ld4bf(const bf16* p) { typedef unsigned u32x2 __attribute__((ext_vector_type(2))); const u32x2 u = *(const GAS u32x2*)p; return (f32x4){pg8::bf_lo(u.x), pg8::bf_hi(u.x), pg8::bf_lo(u.y), pg8::bf_hi(u.y)}; }
struct MEpiZ { bf16* Z; const float* rs; __device__ __forceinline__ void operator()(int r, int c, f32x4 v) const {
    v = v * rs[ROW_META + r];
    if (c < 1024 || (c >= 3072 && c < 4096)) v = v * QSCALE;
    else if (c >= C_GA) { v.x = pg8::sigmoidf_fast(v.x); v.y = pg8::sigmoidf_fast(v.y); v.z = pg8::sigmoidf_fast(v.z); v.w = pg8::sigmoidf_fast(v.w); }
    st4bf(Z + (size_t)(ROW_META + r) * INW + c, v); } };
template <int ACT> struct MEpiPlain { bf16* O; int ldc; const float* rs; __device__ __forceinline__ void operator()(int r, int c, f32x4 v) const {
    if (ACT == 1) { v = v * rs[ROW_META + r]; v.x = fmaxf(v.x, 0.f); v.y = fmaxf(v.y, 0.f); v.z = fmaxf(v.z, 0.f); v.w = fmaxf(v.w, 0.f); v = v * v; }
    st4bf(O + (size_t)(ROW_META + r) * ldc + c, v); } };
template <bool ADD_PREV> struct MEpiGate { bf16* O; const bf16* Gt; const bf16* Pv; __device__ __forceinline__ void operator()(int r, int c, f32x4 v) const {
    const size_t row = (size_t)(ROW_META + r); v = v * ld4bf(Gt + row * INW + c);
    if (ADD_PREV) v = v + ld4bf(Pv + row * DM + c);
    st4bf(O + row * DM + c, v); } };

__device__ __forceinline__ int t5_bucket(int dist) {
    const int n = dist < 0 ? 0 : dist;
    if (n < 16) return n;
    int large = 16 + (int)(logf((float)n * (1.f / 16.f)) / 2.0794415416798357f * 16.f);
    return large > 31 ? 31 : large;
}

constexpr int LUTN_G = 448, N_LUT_TABLES = 40;
__device__ __forceinline__ void build_lut_tables(Frame& F, const float* __restrict__ relb, float* __restrict__ lutg) {
    for (int i = F.vcu * NWAVES * 64 + F.tid; i < N_LUT_TABLES * LUTN_G; i += F.G * NWAVES * 64) {
        const int tb = i / LUTN_G, d = 255 - (i % LUTN_G); float v;
        if (tb < 8) { if (d < 0) v = NEGBIG; else if (d < 128) v = (relb[t5_bucket(d) * NBIAS + tb] - relb[31 * NBIAS + tb]) * LOG2E; else v = 0.f; }
        else { const int col = 8 + ((tb - 8) >> 1), kind = (tb - 8) & 1;
            if (d < 0) v = NEGBIG; else if (d < 128) v = relb[t5_bucket(d) * NBIAS + col] * LOG2E; else v = kind ? relb[31 * NBIAS + col] * LOG2E : NEGBIG; }
        lutg[i] = v;
    }
}

#if ATTN_NAIVE
template <bool DIFF>
__global__ void __launch_bounds__(512) naive_attn(const bf16* __restrict__ Z, bf16* __restrict__ YAB, const float* __restrict__ relb, const float* lq1, const float* lk1, const float* lq2, const float* lk2,
                                                   const float* __restrict__ dnorm, const float* __restrict__ sinks, int layer) {
    constexpr int KT = 16, DVT = DIFF ? 64 : 32, KW = DIFF ? 128 : 64, VW = DIFF ? 128 : 64;
    extern __shared__ __attribute__((aligned(16))) unsigned char smem[];
    float* Ksh = (float*)smem;
    float* Vsh = Ksh + 32 * 128;
    float* biasL = Vsh + 32 * 128;
    int* kposs = (int*)(biasL + 2 * 132);
    float* red = (float*)(kposs + 64);
    float* Osh = red + 8;
    const int tid = threadIdx.x, row = tid & 127, cj = (tid >> 7) & 1, dvh = tid >> 8;
    const int unit = blockIdx.x, hh = unit / 129, qb = unit % 129;
    const bool metablk = (qb == 128);
    const int qrow = metablk ? ROW_META + row : 128 * qb + row;
    const int qpos = metablk ? 112 + row : 128 + 128 * qb + row;
    float lam = 0.f, lam_init = 0.f;
    if (DIFF) {
        lam_init = 0.8f - 0.6f * expf(-0.3f * (float)layer);
        if (tid < 64) { float a = lq1[layer * 64 + tid] * lk1[layer * 64 + tid], b = lq2[layer * 64 + tid] * lk2[layer * 64 + tid];
#pragma unroll
            for (int o = 1; o < 64; o <<= 1) { a += __shfl_xor(a, o); b += __shfl_xor(b, o); }
            if (tid == 0) { red[0] = a; red[1] = b; } }
    }
    for (int i = tid; i < 2 * 129; i += 512) { const int j = i / 129, d = i % 129; const int col = DIFF ? hh : 8 + 2 * hh + j; biasL[j * 132 + d] = relb[t5_bucket(d) * NBIAS + col] * LOG2E; }
    __syncthreads();
    if (DIFF) lam = expf(red[0]) - expf(red[1]) + lam_init;
    const int qcol = DIFF ? C_QA + hh * 128 + cj * 64 : C_QB + (2 * hh + cj) * 64;
    const int kcol = DIFF ? C_KA + hh * 128 : C_KB + (hh >> 2) * 64;
    const int vcol = DIFF ? C_VA + hh * 128 : C_VB + (hh >> 2) * 64;
    float q[64];
    { const bf16* qp = Z + (size_t)qrow * INW + qcol;
#pragma unroll
      for (int i = 0; i < 64; ++i) q[i] = pg8::bf_lo((unsigned)qp[i]); }
    float o[DVT];
#pragma unroll
    for (int i = 0; i < DVT; ++i) o[i] = 0.f;
    float m = NEGBIG, l = 0.f;
    if (!DIFF) { m = sinks[layer * 16 + 2 * hh + cj] * LOG2E; l = 1.f; }
    const int t_s = DIFF ? 0 : (qb >= 1 && !metablk ? 128 * (qb - 1) : 0);
    const int nreal = metablk ? 0 : 128 * qb + 128 - t_s;
    const int ns = 16 + nreal;
    const float* bl = biasL + (DIFF ? 0 : cj) * 132;
    for (int s0 = 0; s0 < ns; s0 += KT) {
        __syncthreads();
        for (int i = tid; i < KT * KW; i += 512) { const int kk = i / KW, c = i % KW, s = s0 + kk; float v = 0.f;
            if (s < ns) { const int krow = s < 16 ? ROW_META + s : t_s + s - 16; v = pg8::bf_lo((unsigned)Z[(size_t)krow * INW + kcol + c]); } Ksh[kk * 128 + c] = v; }
        for (int i = tid; i < KT * VW; i += 512) { const int kk = i / VW, c = i % VW, s = s0 + kk; float v = 0.f;
            if (s < ns) { const int krow = s < 16 ? ROW_META + s : t_s + s - 16; v = pg8::bf_lo((unsigned)Z[(size_t)krow * INW + vcol + c]); } Vsh[kk * 128 + c] = v; }
        if (tid < KT) { const int s = s0 + tid; kposs[tid] = s >= ns ? (1 << 30) : (s < 16 ? 112 + s : 128 + t_s + s - 16); kposs[32 + tid] = (s < 16) ? 1 : 0; }
        __syncthreads();
        float sc[KT]; float tmax = NEGBIG;
#pragma unroll
        for (int kk = 0; kk < KT; ++kk) {
            const float* kr = Ksh + kk * 128 + (DIFF ? cj * 64 : 0); float a = 0.f;
#pragma unroll
            for (int i = 0; i < 64; ++i) a += q[i] * kr[i];
            const int dist = qpos - kposs[kk]; const bool ismeta = kposs[32 + kk] != 0;
            bool ok = dist >= 0; if (!DIFF && !ismeta) ok = ok && dist < 128;
            const int di = dist < 0 ? 0 : (dist > 128 ? 128 : dist);
            a = ok ? a + bl[di] : NEGBIG;
            sc[kk] = a; tmax = fmaxf(tmax, a);
        }
        const float mn = fmaxf(m, tmax), alpha = exp2f(m - mn);
        l *= alpha;
#pragma unroll
        for (int i = 0; i < DVT; ++i) o[i] *= alpha;
        m = mn;
#pragma unroll
        for (int kk = 0; kk < KT; ++kk) {
            const float p = sc[kk] > -1e29f ? exp2f(sc[kk] - m) : 0.f;
            l += p; const float* vr = Vsh + kk * 128 + dvh * DVT;
#pragma unroll
            for (int i = 0; i < DVT; ++i) o[i] += p * vr[i];
        }
    }
    const float rl = 1.f / l;
    if (DIFF) {
        __syncthreads();
        if (cj == 1) {
#pragma unroll
            for (int i = 0; i < DVT; ++i) Osh[row * 129 + dvh * 64 + i] = lam * o[i] * rl; }
        __syncthreads();
        if (cj == 0) {
#pragma unroll
            for (int i = 0; i < DVT; ++i) Osh[row * 129 + dvh * 64 + i] = o[i] * rl - Osh[row * 129 + dvh * 64 + i]; }
        __syncthreads();
        if (tid < 128 && (!metablk || tid < 16)) {
            float ss = 0.f;
            for (int d = 0; d < 128; ++d) { const float v = Osh[tid * 129 + d]; ss += v * v; }
            const float rstd = 1.0f / sqrtf(ss * (1.f / 128.f) + EPS) * (1.f - lam_init);
            const int orow = metablk ? ROW_META + tid : 128 * qb + tid;
            for (int d = 0; d < 128; ++d) YAB[(size_t)orow * DM + hh * 128 + d] = (bf16)f2bf(Osh[tid * 129 + d] * rstd * dnorm[layer * 128 + d]);
        }
    } else {
        if (!metablk || row < 16) {
#pragma unroll
            for (int i = 0; i < DVT; ++i) YAB[(size_t)qrow * DM + 1024 + (2 * hh + cj) * 64 + dvh * 32 + i] = (bf16)f2bf(o[i] * rl); }
    }
}
constexpr int NAIVE_LDS = (32 * 128 * 2 + 2 * 132 + 64 + 8 + 128 * 129) * 4;
#endif

namespace att {
typedef float f32x16 __attribute__((ext_vector_type(16)));
typedef short s16x4 __attribute__((ext_vector_type(4)));
typedef short v4i16_t __attribute__((ext_vector_type(4)));
constexpr int LUTN = 448;
constexpr int SLOT = 16384, CK = 8704, KSLOT = 2 * CK, L_K = 0, L_V = 3 * KSLOT, L_LUT = L_V + 3 * SLOT, L_WSF = L_LUT + 4 * LUTN * 4, L_SUBG = L_WSF + 8 * 256, L_END = L_SUBG + 512;
static_assert(L_END <= RING_BYTES, "attention LDS");
constexpr int XD_STRIDE = 132, XS_STRIDE = 68;
constexpr float THR = 30.0f;
__device__ __forceinline__ int crow(int r, int hi) { return (r & 3) + 8 * (r >> 2) + 4 * hi; }
__device__ __forceinline__ void glds16(const void* gsrc, unsigned lds_dst) { unsigned keep;
    asm volatile("s_mov_b32 %0, m0\n\ts_mov_b32 m0, %2\n\ts_nop 0\n\tglobal_load_lds_dwordx4 %1, off\n\ts_mov_b32 m0, %0" : "=&s"(keep) : "v"(gsrc), "s"(lds_dst) : "memory"); }
template <int IMM> __device__ __forceinline__ void glds16s(const void* sbase, unsigned voff, unsigned lds_dst_) { const unsigned lds_dst = lds_dst_ - (unsigned)IMM;
    asm volatile("s_mov_b32 m0, %2\n\ts_nop 0\n\tglobal_load_lds_dwordx4 %0, %1 offset:%c3" :: "v"(voff), "s"(sbase), "s"(lds_dst), "i"(IMM) : "memory", "m0"); }
__device__ __forceinline__ unsigned cvtpk(float lo, float hi) { typedef float f2 __attribute__((ext_vector_type(2))); typedef __bf16 b2 __attribute__((ext_vector_type(2))); f2 v = {lo, hi}; b2 b = __builtin_convertvector(v, b2); return __builtin_bit_cast(unsigned, b); }
__device__ __forceinline__ s16x4 vtr(const LAS unsigned char* p) { return __builtin_bit_cast(s16x4, __builtin_amdgcn_ds_read_tr16_b64_v4i16((LAS v4i16_t*)p)); }
__device__ __forceinline__ float swap_add(float v) { auto rr = __builtin_amdgcn_permlane32_swap(__float_as_uint(v), __float_as_uint(v), false, false); return __uint_as_float(rr[0]) + __uint_as_float(rr[1]); }
__device__ __forceinline__ float swap_max(float v) { auto rr = __builtin_amdgcn_permlane32_swap(__float_as_uint(v), __float_as_uint(v), false, false); return fmaxf(__uint_as_float(rr[0]), __uint_as_float(rr[1])); }
#define ATT_MFMA(a, b, c) __builtin_amdgcn_mfma_f32_32x32x16_bf16(a, b, c, 0, 0, 0)

template <bool DIFF>
__device__ __forceinline__ void attn_epilogue(LAS unsigned char* lds, bf16* __restrict__ YAB, f32x16 (&o)[DIFF ? 4 : 2], float lsum, int tid, int hh, int qb, float lam, float lam_scale);
template <bool DIFF, bool FAST>
__device__ __forceinline__ bool attn_body(LAS unsigned char* lds, const bf16* __restrict__ Z, bf16* __restrict__ YAB, const float* __restrict__ lutg,
                                          int hh, int qb, float lam, float lam_scale, float sink2, int tid_in, unsigned useq) {
    constexpr int NDB = DIFF ? 4 : 2;
    constexpr bool fast = FAST;
    int tid = tid_in; asm volatile("" : "+v"(tid));
    const int lane = tid & 63, w = __builtin_amdgcn_readfirstlane(tid >> 6), cj = w >> 2, wq = w & 3, l31 = lane & 31, hi = lane >> 5;
    const bool metablk = (qb == 128);
    const int qrow = (metablk ? ROW_META : 128 * qb) + 32 * wq + l31;
    const int qpos = (metablk ? 112 : 128 + 128 * qb) + 32 * wq + l31;
    const int qcol = DIFF ? C_QA + hh * 128 + cj * 64 : C_QB + (2 * hh + cj) * 64;
    const int kcol = DIFF ? C_KA + hh * 128 : C_KB + (hh >> 2) * 64;
    const int vcol = DIFF ? C_VA + hh * 128 : C_VB + (hh >> 2) * 64;
    const int rt0 = DIFF ? 0 : (2 * qb - 2 > 0 ? 2 * qb - 2 : 0);
    const int nreal = metablk ? 0 : 2 * qb + 2 - rt0;
    const int NT = 1 + nreal;
    const int rt_special = 2 * qb - 2;
    LAS float* LUT = (LAS float*)(lds + L_LUT);
    if (DIFF) { if (tid < LUTN) LUT[tid] = lutg[hh * LUTN + tid]; }
    else { for (int i = tid; i < 4 * LUTN; i += NWAVES * 64) { const int k = i / LUTN, e = i % LUTN; LUT[i] = lutg[(8 + 2 * (2 * hh + (k & 1)) + (k >> 1)) * LUTN + e]; } }
    const unsigned lds0 = (unsigned)(uintptr_t)lds;
    auto tile_row0 = [&](int t) { return t == 0 ? ROW_META : 64 * (rt0 + t - 1); };
    const unsigned koff = (unsigned)(((8 * w + (lane >> 3)) * INW + kcol + ((lane & 7) ^ (lane >> 3)) * 8) * 2);
    const unsigned voff = (unsigned)(((8 * w + ((lane >> 2) & 7)) * INW + vcol + (lane >> 5) * 32 + (lane & 3) * 8) * 2);
    const unsigned kgb = (unsigned)(w * 1024 + 128 * ((w >> 1) & 1) + 256 * (w >> 2));
    auto dma_k = [&](int t, int sl) {
        const char* zb = (const char*)Z + (size_t)tile_row0(t) * (INW * 2);
        const unsigned dst = (unsigned)__builtin_amdgcn_readfirstlane(lds0 + L_K + sl + (sl >> 4) + kgb);
        glds16s<0>(zb, koff, dst);
        if (DIFF) glds16s<128>(zb, koff, dst + CK);
    };
    auto dma_v = [&](int t, int sl) {
        const char* zb = (const char*)Z + (size_t)tile_row0(t) * (INW * 2);
        const unsigned dst = (unsigned)__builtin_amdgcn_readfirstlane(lds0 + L_V + sl + w * 2048);
        glds16s<0>(zb, voff, dst);
        if (DIFF) glds16s<128>(zb, voff, dst + 1024);
    };
    bf16x8 qr[4];
#pragma unroll
    for (int d0 = 0; d0 < 4; ++d0) qr[d0] = *(const bf16x8*)(Z + (size_t)qrow * INW + qcol + d0 * 16 + hi * 8);
    dma_k(0, 0); dma_v(0, 0); if (NT > 1) dma_k(1, SLOT); if (NT > 2) dma_k(2, 2 * SLOT);
    bool mz = fast || DIFF || (fabsf(sink2) <= THR);
    float m = mz ? 0.f : sink2, lsum = (!DIFF && hi == 0) ? (mz ? __builtin_amdgcn_exp2f(sink2) : 1.f) : 0.f;
    f32x16 o[NDB];
#pragma unroll
    for (int db = 0; db < NDB; ++db) o[db] = f32x16{};
    float nm = -m;
    LAS float* wsf = (LAS float*)(lds + L_WSF) + w * 64;
    const int kr_ = l31 & 7, kg_ = l31 >> 3, kt_ = kr_ ^ hi;
    const LAS unsigned char* kp0 = lds + L_K + (DIFF ? cj * CK : 0) + kg_ * 1024 + 128 * ((kg_ >> 1) & 1) + 128 * kr_;
    const int kx0 = 16 * (0 ^ kt_), kx1 = 16 * (2 ^ kt_), kx2 = 16 * (4 ^ kt_), kx3 = 16 * (6 ^ kt_);
    const LAS unsigned char* vp0 = lds + L_V + ((lane >> 4) & 1) * 32 + (lane & 3) * 8 + (4 * hi + ((lane & 15) >> 2)) * 64;
    bf16x8 kf[8];
    f32x16 pA0, pA1, pB0, pB1;
    v4u pw0, pw1, pw2, pw3;
    bool resc = false;
    int sl_prev = 0, sl_cur = 0, sl_next = SLOT;
#define ATT_SBAR() __builtin_amdgcn_sched_barrier(0)
#define ATT_PIN(x) asm volatile("" : "+v"(x))
#define ATT_ROT() do { sl_prev = sl_cur; sl_cur = sl_next; sl_next = (sl_next == 2 * SLOT) ? 0 : sl_next + SLOT; } while (0)
#define ATT_WAITBAR(N) asm volatile("s_waitcnt vmcnt(" #N ") lgkmcnt(0)\n\ts_barrier" ::: "memory")
#define ATT_KLD2(kp, j) do { kf[2 * (j)] = *(const LAS bf16x8*)((kp) + kx##j); kf[2 * (j) + 1] = *(const LAS bf16x8*)((kp) + kx##j + 4352); } while (0)
#define ATT_SPECIAL(C0, C1, t) do { const int rt_ = rt0 + (t) - 1; \
        if ((t) == 0) { const LAS float* lut_ = DIFF ? LUT : LUT + (2 + cj) * LUTN; const int base_ = 255 - (qpos - 112 - 4 * hi); \
            _Pragma("unroll") for (int r = 0; r < 16; ++r) { \
                if (r < 8) { int idx_ = base_ + ((r & 3) + 8 * (r >> 2)); idx_ = idx_ < 0 ? 0 : (idx_ > LUTN - 1 ? LUTN - 1 : idx_); C0[r] += lut_[idx_]; } else C0[r] = nb_; \
                C1[r] = nb_; } } \
        else if (!DIFF || rt_ >= rt_special) { int base_ = 255 - (qpos - (128 + 64 * rt_) - 4 * hi); base_ = base_ < 0 ? 0 : (base_ > LUTN - 96 ? LUTN - 96 : base_); \
            const LAS float* lut_ = (DIFF ? LUT : LUT + cj * LUTN) + base_; \
            _Pragma("unroll") for (int r = 0; r < 16; ++r) { C0[r] += lut_[(r & 3) + 8 * (r >> 2)]; C1[r] += lut_[(r & 3) + 8 * (r >> 2) + 32]; } } } while (0)
#define ATT_ROWMAX(C0, C1, rm) do { float a_ = fmaxf(fmaxf(C0[0], C0[1]), C1[0]), b_ = fmaxf(fmaxf(C0[2], C0[3]), C1[1]); a_ = fmaxf(fmaxf(a_, C1[2]), C1[3]); \
        _Pragma("unroll") for (int r = 4; r < 16; r += 4) { a_ = fmaxf(fmaxf(a_, C0[r]), C0[r + 1]); b_ = fmaxf(fmaxf(b_, C0[r + 2]), C0[r + 3]); a_ = fmaxf(fmaxf(a_, C1[r]), C1[r + 1]); b_ = fmaxf(fmaxf(b_, C1[r + 2]), C1[r + 3]); } \
        rm = swap_max(fmaxf(a_, b_)); } while (0)
#define ATT_RESC() do { if (resc) { asm volatile("s_waitcnt lgkmcnt(0)" ::: "memory"); \
        _Pragma("unroll") for (int g = 0; g < 4; ++g) { const f32x4 fv_ = *(const LAS f32x4*)(wsf + 8 * g + 4 * hi); \
            _Pragma("unroll") for (int db = 0; db < NDB; ++db) { o[db][4 * g + 0] *= fv_.x; o[db][4 * g + 1] *= fv_.y; o[db][4 * g + 2] *= fv_.z; o[db][4 * g + 3] *= fv_.w; } } } } while (0)
#define ATT_PK(P, B) cvtpk(P[B], P[(B) + 1])
#define ATT_PAF(k) __builtin_bit_cast(bf16x8, pw##k)
    float nb_ = NEGBIG; asm volatile("" : "+v"(nb_));
    asm volatile("s_waitcnt vmcnt(0)" ::: "memory");
    asm volatile("s_waitcnt lgkmcnt(0)\n\ts_barrier" ::: "memory");
    {
        const LAS unsigned char* kp = kp0;
        ATT_KLD2(kp, 0); ATT_KLD2(kp, 1); ATT_KLD2(kp, 2); ATT_KLD2(kp, 3);
        if (mz) { pA0 = ATT_MFMA(kf[0], qr[0], f32x16{}); pA1 = ATT_MFMA(kf[1], qr[0], f32x16{}); }
        else {
#pragma unroll
            for (int r = 0; r < 16; ++r) { pA0[r] = nm; pA1[r] = nm; }
            pA0 = ATT_MFMA(kf[0], qr[0], pA0); pA1 = ATT_MFMA(kf[1], qr[0], pA1); }
#pragma unroll
        for (int d0 = 1; d0 < 4; ++d0) { pA0 = ATT_MFMA(kf[2 * d0], qr[d0], pA0); pA1 = ATT_MFMA(kf[2 * d0 + 1], qr[d0], pA1); }
        asm volatile("s_waitcnt lgkmcnt(0)\n\ts_barrier" ::: "memory");
        if (3 < NT) dma_k(3, 0);
        if (1 < NT) dma_v(1, SLOT);
        ATT_SPECIAL(pA0, pA1, 0);
        float rm = 0.f; if (!fast) ATT_ROWMAX(pA0, pA1, rm);
        if (!fast && __any(rm > THR || (DIFF && rm < -THR))) {
            const float dl = DIFF ? rm : fmaxf(rm, 0.f);
            m += dl; mz = false;
#pragma unroll
            for (int r = 0; r < 16; ++r) { pA0[r] -= dl; pA1[r] -= dl; }
            nm = -m;
            if (!DIFF) lsum *= __builtin_amdgcn_exp2f(-dl);
        }
#pragma unroll
        for (int r = 0; r < 16; ++r) { pA0[r] = __builtin_amdgcn_exp2f(pA0[r]); pA1[r] = __builtin_amdgcn_exp2f(pA1[r]); }
        if (1 < NT) { const LAS unsigned char* kn = kp0 + KSLOT; ATT_KLD2(kn, 0); ATT_KLD2(kn, 1); ATT_KLD2(kn, 2); ATT_KLD2(kn, 3); }
        if (3 < NT) { if (DIFF) ATT_WAITBAR(4); else ATT_WAITBAR(2); } else if (1 < NT) { if (DIFF) ATT_WAITBAR(2); else ATT_WAITBAR(1); } else ATT_WAITBAR(0);
        ATT_ROT();
    }
#define ATT_GAPA(MF, A0, A1, A2, A3, W0, W1, PW) do { MF; sacc += A0; sacc += A1; sacc += A2; sacc += A3; ATT_PIN(sacc); W0; W1; ATT_PIN(PW); ATT_SBAR(); } while (0)
#define ATT_VRD(i, off) do { vlo##i = vtr(vp_ + (off)); vhi##i = vtr(vp_ + (off) + 2048); } while (0)
#define ATT_VFR(i) (bf16x8){vlo##i[0], vlo##i[1], vlo##i[2], vlo##i[3], vhi##i[0], vhi##i[1], vhi##i[2], vhi##i[3]}
#define ATT_EX2(X, B) do { X[B] = __builtin_amdgcn_exp2f(X[B]); X[(B) + 1] = __builtin_amdgcn_exp2f(X[(B) + 1]); } while (0)
#define ATT_EXF(C0, C1, f) do { if ((f) < 16) C0[(f) & 15] = __builtin_amdgcn_exp2f(C0[(f) & 15]); else C1[(f) & 15] = __builtin_amdgcn_exp2f(C1[(f) & 15]); } while (0)
#define ATT_EX4(X, B) do { ATT_EX2(X, B); ATT_EX2(X, (B) + 2); } while (0)
#define ATT_VOFF(j) (DIFF ? ((4 * ((j) >> 2) + (((j) & 3) >> 1)) * 1024 + ((j) & 1) * 512) : (4 * ((j) >> 1) * 1024 + ((j) & 1) * 512))
#define ATT_PVD(j, R, RN, PWK, X, B) do { if ((j) + 3 < 16) ATT_VRD(RN, ATT_VOFF((j) + 3)); ATT_SBAR(); o[(j) & 3] = ATT_MFMA(ATT_PAF(PWK), ATT_VFR(R), o[(j) & 3]); ATT_EX2(X, B); ATT_PIN(X); ATT_SBAR(); } while (0)
#define ATT_PVS(j, R, RN, PWK, X, B) do { if ((j) + 3 < 8) ATT_VRD(RN, ATT_VOFF((j) + 3)); ATT_SBAR(); o[(j) & 1] = ATT_MFMA(ATT_PAF(PWK), ATT_VFR(R), o[(j) & 1]); ATT_EX4(X, B); ATT_PIN(X); ATT_SBAR(); } while (0)
#define ATT_KRD(G, j) do { if (G) { ATT_KLD2(kn_, j); ATT_SBAR(); } } while (0)
#define ATT_STEP(C0, C1, P0, P1, t, GK, GV) do { ATT_SBAR(); \
        const bool gk_ = (GK), gv_ = (GV); \
        float sacc = P0[0] + P0[1]; \
        if (mz) { C0 = ATT_MFMA(kf[0], qr[0], f32x16{}); C1 = ATT_MFMA(kf[1], qr[0], f32x16{}); } \
        else { _Pragma("unroll") for (int r = 0; r < 16; ++r) { C0[r] = nm; C1[r] = nm; } C0 = ATT_MFMA(kf[0], qr[0], C0); C1 = ATT_MFMA(kf[1], qr[0], C1); } \
        ATT_SBAR(); \
        ATT_GAPA((void)0, P0[2], P0[3], P0[4], P0[5],     pw0[0] = ATT_PK(P0, 0),  pw0[1] = ATT_PK(P0, 2),  pw0); \
        ATT_GAPA((void)0, P0[6], P0[7], P0[8], P0[9],     pw0[2] = ATT_PK(P0, 4),  pw0[3] = ATT_PK(P0, 6),  pw0); \
        ATT_GAPA(C0 = ATT_MFMA(kf[2], qr[1], C0),   P0[10], P0[11], P0[12], P0[13], pw1[0] = ATT_PK(P0, 8),  pw1[1] = ATT_PK(P0, 10), pw1); \
        ATT_GAPA(C1 = ATT_MFMA(kf[3], qr[1], C1),   P0[14], P0[15], P1[0], P1[1],   pw1[2] = ATT_PK(P0, 12), pw1[3] = ATT_PK(P0, 14), pw1); \
        ATT_GAPA(C0 = ATT_MFMA(kf[4], qr[2], C0),   P1[2], P1[3], P1[4], P1[5],     pw2[0] = ATT_PK(P1, 0),  pw2[1] = ATT_PK(P1, 2),  pw2); \
        ATT_GAPA(C1 = ATT_MFMA(kf[5], qr[2], C1),   P1[6], P1[7], P1[8], P1[9],     pw2[2] = ATT_PK(P1, 4),  pw2[3] = ATT_PK(P1, 6),  pw2); \
        ATT_GAPA(C0 = ATT_MFMA(kf[6], qr[3], C0),   P1[10], P1[11], P1[12], P1[13], pw3[0] = ATT_PK(P1, 8),  pw3[1] = ATT_PK(P1, 10), pw3); \
        ATT_GAPA(C1 = ATT_MFMA(kf[7], qr[3], C1),   P1[14], P1[15], 0.f, 0.f,       pw3[2] = ATT_PK(P1, 12), pw3[3] = ATT_PK(P1, 14), pw3); \
        lsum += sacc; \
        ATT_SBAR(); \
          \
        { const LAS unsigned char* vp_ = vp0 + sl_prev; const LAS unsigned char* kn_ = kp0 + sl_next + (sl_next >> 4); s16x4 vlo0, vhi0, vlo1, vhi1, vlo2, vhi2, vlo3, vhi3; float rm_ = 0.f; \
          ATT_VRD(0, ATT_VOFF(0)); ATT_VRD(1, ATT_VOFF(1)); ATT_VRD(2, ATT_VOFF(2)); \
          if (DIFF) { \
            ATT_VRD(3, ATT_VOFF(3)); ATT_SBAR(); o[0] = ATT_MFMA(ATT_PAF(0), ATT_VFR(0), o[0]); ATT_SBAR(); \
            if (gk_) dma_k((t) + 3, sl_cur); if (gv_) dma_v((t) + 1, sl_next); \
            ATT_VRD(0, ATT_VOFF(4)); ATT_SBAR(); o[1] = ATT_MFMA(ATT_PAF(0), ATT_VFR(1), o[1]); ATT_SBAR(); \
            ATT_SPECIAL(C0, C1, t); \
            ATT_VRD(1, ATT_VOFF(5)); ATT_SBAR(); o[2] = ATT_MFMA(ATT_PAF(0), ATT_VFR(2), o[2]); ATT_SBAR(); \
            if (!fast) ATT_ROWMAX(C0, C1, rm_); \
            ATT_VRD(2, ATT_VOFF(6)); ATT_SBAR(); o[3] = ATT_MFMA(ATT_PAF(0), ATT_VFR(3), o[3]); ATT_SBAR(); \
            { resc = false; \
              if (!fast && __builtin_expect(__any(rm_ > THR), 0)) { const float dl_ = fmaxf(rm_, 0.f); m += dl_; mz = false; \
                  _Pragma("unroll") for (int r = 0; r < 16; ++r) { C0[r] -= dl_; C1[r] -= dl_; } \
                  nm = -m; \
                  const float f_ = __builtin_amdgcn_exp2f(-dl_); lsum *= f_; if (hi == 0) wsf[l31] = f_; resc = true; } } \
            ATT_SBAR(); \
            ATT_KRD(gv_, 0); ATT_VRD(3, ATT_VOFF(7)); ATT_SBAR(); o[0] = ATT_MFMA(ATT_PAF(1), ATT_VFR(0), o[0]); ATT_SBAR(); ATT_EXF(C0, C1, 0); ATT_EXF(C0, C1, 1); ATT_EXF(C0, C1, 2); ATT_PIN(C0); ATT_PIN(C1); ATT_SBAR(); \
            ATT_KRD(gv_, 1); ATT_VRD(0, ATT_VOFF(8)); ATT_SBAR(); o[1] = ATT_MFMA(ATT_PAF(1), ATT_VFR(1), o[1]); ATT_SBAR(); ATT_EXF(C0, C1, 3); ATT_EXF(C0, C1, 4); ATT_EXF(C0, C1, 5); ATT_PIN(C0); ATT_PIN(C1); ATT_SBAR(); \
            ATT_KRD(gv_, 2); ATT_VRD(1, ATT_VOFF(9)); ATT_SBAR(); o[2] = ATT_MFMA(ATT_PAF(1), ATT_VFR(2), o[2]); ATT_SBAR(); ATT_EXF(C0, C1, 6); ATT_EXF(C0, C1, 7); ATT_EXF(C0, C1, 8); ATT_PIN(C0); ATT_PIN(C1); ATT_SBAR(); \
            ATT_KRD(gv_, 3); ATT_VRD(2, ATT_VOFF(10)); ATT_SBAR(); o[3] = ATT_MFMA(ATT_PAF(1), ATT_VFR(3), o[3]); ATT_SBAR(); ATT_EXF(C0, C1, 9); ATT_EXF(C0, C1, 10); ATT_EXF(C0, C1, 11); ATT_PIN(C0); ATT_PIN(C1); ATT_SBAR(); \
            ATT_VRD(3, ATT_VOFF(11)); ATT_SBAR(); o[0] = ATT_MFMA(ATT_PAF(2), ATT_VFR(0), o[0]); ATT_SBAR(); ATT_EXF(C0, C1, 12); ATT_EXF(C0, C1, 13); ATT_EXF(C0, C1, 14); ATT_PIN(C0); ATT_PIN(C1); ATT_SBAR(); \
            ATT_VRD(0, ATT_VOFF(12)); ATT_SBAR(); o[1] = ATT_MFMA(ATT_PAF(2), ATT_VFR(1), o[1]); ATT_SBAR(); ATT_EXF(C0, C1, 15); ATT_EXF(C0, C1, 16); ATT_EXF(C0, C1, 17); ATT_PIN(C0); ATT_PIN(C1); ATT_SBAR(); \
            ATT_VRD(1, ATT_VOFF(13)); ATT_SBAR(); o[2] = ATT_MFMA(ATT_PAF(2), ATT_VFR(2), o[2]); ATT_SBAR(); ATT_EXF(C0, C1, 18); ATT_EXF(C0, C1, 19); ATT_EXF(C0, C1, 20); ATT_PIN(C0); ATT_PIN(C1); ATT_SBAR(); \
            ATT_VRD(2, ATT_VOFF(14)); ATT_SBAR(); o[3] = ATT_MFMA(ATT_PAF(2), ATT_VFR(3), o[3]); ATT_SBAR(); ATT_EXF(C0, C1, 21); ATT_EXF(C0, C1, 22); ATT_EXF(C0, C1, 23); ATT_PIN(C0); ATT_PIN(C1); ATT_SBAR(); \
            ATT_VRD(3, ATT_VOFF(15)); ATT_SBAR(); o[0] = ATT_MFMA(ATT_PAF(3), ATT_VFR(0), o[0]); ATT_SBAR(); ATT_EXF(C0, C1, 24); ATT_EXF(C0, C1, 25); ATT_PIN(C0); ATT_PIN(C1); ATT_SBAR(); \
            ATT_SBAR(); o[1] = ATT_MFMA(ATT_PAF(3), ATT_VFR(1), o[1]); ATT_SBAR(); ATT_EXF(C0, C1, 26); ATT_EXF(C0, C1, 27); ATT_PIN(C0); ATT_PIN(C1); ATT_SBAR(); \
            ATT_SBAR(); o[2] = ATT_MFMA(ATT_PAF(3), ATT_VFR(2), o[2]); ATT_SBAR(); ATT_EXF(C0, C1, 28); ATT_EXF(C0, C1, 29); ATT_PIN(C0); ATT_PIN(C1); ATT_SBAR(); \
            ATT_SBAR(); o[3] = ATT_MFMA(ATT_PAF(3), ATT_VFR(3), o[3]); ATT_SBAR(); ATT_EXF(C0, C1, 30); ATT_EXF(C0, C1, 31); ATT_PIN(C0); ATT_PIN(C1); ATT_SBAR(); \
          } else { \
            ATT_VRD(3, ATT_VOFF(3)); ATT_SBAR(); o[0] = ATT_MFMA(ATT_PAF(0), ATT_VFR(0), o[0]); ATT_SBAR(); \
            if (gk_) dma_k((t) + 3, sl_cur); if (gv_) dma_v((t) + 1, sl_next); \
            ATT_SPECIAL(C0, C1, t); \
            ATT_VRD(0, ATT_VOFF(4)); ATT_SBAR(); o[1] = ATT_MFMA(ATT_PAF(0), ATT_VFR(1), o[1]); ATT_SBAR(); \
            if (!fast) ATT_ROWMAX(C0, C1, rm_); \
            { resc = false; \
              if (!fast && __builtin_expect(__any(rm_ > THR), 0)) { const float dl_ = fmaxf(rm_, 0.f); m += dl_; mz = false; \
                  _Pragma("unroll") for (int r = 0; r < 16; ++r) { C0[r] -= dl_; C1[r] -= dl_; } \
                  nm = -m; \
                  const float f_ = __builtin_amdgcn_exp2f(-dl_); lsum *= f_; if (hi == 0) wsf[l31] = f_; resc = true; } } \
            ATT_SBAR(); \
            ATT_KRD(gv_, 0); ATT_VRD(1, ATT_VOFF(5)); ATT_SBAR(); o[0] = ATT_MFMA(ATT_PAF(1), ATT_VFR(2), o[0]); ATT_SBAR(); ATT_EXF(C0, C1, 0); ATT_EXF(C0, C1, 1); ATT_EXF(C0, C1, 2); ATT_EXF(C0, C1, 3); ATT_EXF(C0, C1, 4); ATT_EXF(C0, C1, 5); ATT_PIN(C0); ATT_PIN(C1); ATT_SBAR(); \
            ATT_KRD(gv_, 1); ATT_VRD(2, ATT_VOFF(6)); ATT_SBAR(); o[1] = ATT_MFMA(ATT_PAF(1), ATT_VFR(3), o[1]); ATT_SBAR(); ATT_EXF(C0, C1, 6); ATT_EXF(C0, C1, 7); ATT_EXF(C0, C1, 8); ATT_EXF(C0, C1, 9); ATT_EXF(C0, C1, 10); ATT_EXF(C0, C1, 11); ATT_PIN(C0); ATT_PIN(C1); ATT_SBAR(); \
            ATT_KRD(gv_, 2); ATT_VRD(3, ATT_VOFF(7)); ATT_SBAR(); o[0] = ATT_MFMA(ATT_PAF(2), ATT_VFR(0), o[0]); ATT_SBAR(); ATT_EXF(C0, C1, 12); ATT_EXF(C0, C1, 13); ATT_EXF(C0, C1, 14); ATT_EXF(C0, C1, 15); ATT_EXF(C0, C1, 16); ATT_PIN(C0); ATT_PIN(C1); ATT_SBAR(); \
            ATT_KRD(gv_, 3); ATT_SBAR(); o[1] = ATT_MFMA(ATT_PAF(2), ATT_VFR(1), o[1]); ATT_SBAR(); ATT_EXF(C0, C1, 17); ATT_EXF(C0, C1, 18); ATT_EXF(C0, C1, 19); ATT_EXF(C0, C1, 20); ATT_EXF(C0, C1, 21); ATT_PIN(C0); ATT_PIN(C1); ATT_SBAR(); \
            ATT_SBAR(); o[0] = ATT_MFMA(ATT_PAF(3), ATT_VFR(2), o[0]); ATT_SBAR(); ATT_EXF(C0, C1, 22); ATT_EXF(C0, C1, 23); ATT_EXF(C0, C1, 24); ATT_EXF(C0, C1, 25); ATT_EXF(C0, C1, 26); ATT_PIN(C0); ATT_PIN(C1); ATT_SBAR(); \
            ATT_SBAR(); o[1] = ATT_MFMA(ATT_PAF(3), ATT_VFR(3), o[1]); ATT_SBAR(); ATT_EXF(C0, C1, 27); ATT_EXF(C0, C1, 28); ATT_EXF(C0, C1, 29); ATT_EXF(C0, C1, 30); ATT_EXF(C0, C1, 31); ATT_PIN(C0); ATT_PIN(C1); ATT_SBAR(); \
          } } \
        if (gk_) { if (DIFF) ATT_WAITBAR(4); else ATT_WAITBAR(2); } else if (gv_) { if (DIFF) ATT_WAITBAR(2); else ATT_WAITBAR(1); } else ATT_WAITBAR(0); \
        ATT_RESC(); ATT_ROT(); } while (0)
    int t = 1;
    if (fast) for (; t + 4 < NT; t += 2) { ATT_STEP(pB0, pB1, pA0, pA1, t, true, true); ATT_STEP(pA0, pA1, pB0, pB1, t + 1, true, true); }
    for (; t + 1 < NT; t += 2) { ATT_STEP(pB0, pB1, pA0, pA1, t, (t) + 3 < NT, (t) + 1 < NT); ATT_STEP(pA0, pA1, pB0, pB1, t + 1, (t) + 4 < NT, (t) + 2 < NT); }
    if (t < NT) {
        ATT_STEP(pB0, pB1, pA0, pA1, t, (t) + 3 < NT, (t) + 1 < NT);
#pragma unroll
        for (int r = 0; r < 16; ++r) { pA0[r] = pB0[r]; pA1[r] = pB1[r]; }
    }
    {
        float sacc = 0.f;
#pragma unroll
        for (int r = 0; r < 16; ++r) sacc += pA0[r] + pA1[r];
        lsum += sacc;
        pw0 = (v4u){ATT_PK(pA0, 0), ATT_PK(pA0, 2), ATT_PK(pA0, 4), ATT_PK(pA0, 6)}; pw1 = (v4u){ATT_PK(pA0, 8), ATT_PK(pA0, 10), ATT_PK(pA0, 12), ATT_PK(pA0, 14)};
        pw2 = (v4u){ATT_PK(pA1, 0), ATT_PK(pA1, 2), ATT_PK(pA1, 4), ATT_PK(pA1, 6)}; pw3 = (v4u){ATT_PK(pA1, 8), ATT_PK(pA1, 10), ATT_PK(pA1, 12), ATT_PK(pA1, 14)};
        const LAS unsigned char* vb = vp0 + sl_prev;
#pragma unroll
        for (int db = 0; db < NDB; ++db) {
#pragma unroll
            for (int ks = 0; ks < 4; ++ks) {
                const s16x4 lo = vtr(vb + (4 * ks + (db >> 1)) * 1024 + (db & 1) * 512), hh4 = vtr(vb + (4 * ks + (db >> 1)) * 1024 + (db & 1) * 512 + 2048);
                const bf16x8 vf = (bf16x8){lo[0], lo[1], lo[2], lo[3], hh4[0], hh4[1], hh4[2], hh4[3]};
                const v4u pk = ks == 0 ? pw0 : ks == 1 ? pw1 : ks == 2 ? pw2 : pw3;
                o[db] = ATT_MFMA(__builtin_bit_cast(bf16x8, pk), vf, o[db]);
            }
        }
    }
#undef ATT_SBAR
#undef ATT_PIN
#undef ATT_ROT
#undef ATT_WAITBAR
#undef ATT_KLD2
#undef ATT_SPECIAL
#undef ATT_ROWMAX
#undef ATT_RESC
#undef ATT_PK
#undef ATT_PAF
#undef ATT_GAPA
#undef ATT_VRD
#undef ATT_VFR
#undef ATT_EX2
#undef ATT_EX4
#undef ATT_EXF
#undef ATT_VOFF
#undef ATT_PVD
#undef ATT_PVS
#undef ATT_KRD
#undef ATT_STEP
    int tid2 = tid; asm volatile("" : "+v"(tid2));
    if (fast) {
        volatile LAS unsigned* retry_ = (volatile LAS unsigned*)(lds + MISC_OFF + 96);
        const int l31b = tid2 & 31, wqb = (tid2 >> 6) & 3;
        const float lt = swap_add(lsum);
        const bool bad = (!metablk || (wqb == 0 && l31b < 16)) && !(lt > 0x1p-100f && lt < 0x1p100f);
        if (__any(bad)) { if ((tid2 & 63) == 0) retry_[0] = useq; }
        asm volatile("s_waitcnt lgkmcnt(0)\n\ts_barrier" ::: "memory");
        if ((unsigned)__builtin_amdgcn_readfirstlane((int)retry_[0]) == useq) return true;
    }
    attn_epilogue<DIFF>(lds, YAB, o, lsum, tid2, hh, qb, lam, lam_scale);
    return false;
}
template <bool DIFF>
__device__ __forceinline__ void attn_unit(LAS unsigned char* lds, const bf16* __restrict__ Z, bf16* __restrict__ YAB, const float* __restrict__ lutg,
                                          int hh, int qb, float lam, float lam_scale, float sink2, int tid_in, unsigned useq) {
    if (attn_body<DIFF, true>(lds, Z, YAB, lutg, hh, qb, lam, lam_scale, sink2, tid_in, useq))
        (void)attn_body<DIFF, false>(lds, Z, YAB, lutg, hh, qb, lam, lam_scale, sink2, tid_in, useq);
}
template <bool DIFF>
__device__ __forceinline__ void attn_epilogue(LAS unsigned char* lds, bf16* __restrict__ YAB, att::f32x16 (&o)[DIFF ? 4 : 2], float lsum, int tid, int hh, int qb, float lam, float lam_scale) {
    constexpr int NDB = DIFF ? 4 : 2;
    const int lane = tid & 63, w = __builtin_amdgcn_readfirstlane(tid >> 6), cj = w >> 2, wq = w & 3, l31 = lane & 31, hi = lane >> 5;
    const bool metablk = (qb == 128);
    const int qrow = (metablk ? ROW_META : 128 * qb) + 32 * wq + l31;
    LAS float* wsf = (LAS float*)(lds + L_WSF) + w * 64;
    const float ltot = swap_add(lsum);
    float sc = 1.0f / ltot; if (DIFF && cj == 1) sc *= lam;
    if (hi == 0) wsf[l31] = sc;
    asm volatile("s_waitcnt lgkmcnt(0)" ::: "memory");
#pragma unroll
    for (int g = 0; g < 4; ++g) { const f32x4 fv = *(const LAS f32x4*)(wsf + 8 * g + 4 * hi);
#pragma unroll
        for (int db = 0; db < NDB; ++db) { o[db][4 * g + 0] *= fv.x; o[db][4 * g + 1] *= fv.y; o[db][4 * g + 2] *= fv.z; o[db][4 * g + 3] *= fv.w; } }
    asm volatile("s_waitcnt lgkmcnt(0)\n\ts_barrier" ::: "memory");
    const bool store_ok = !metablk || (wq == 0 && l31 < 16);
    if (DIFF) {
        LAS float* X = (LAS float*)lds + wq * 32 * XD_STRIDE;
        if (cj == 1) {
#pragma unroll
            for (int db = 0; db < NDB; ++db)
#pragma unroll
                for (int r = 0; r < 16; ++r) X[crow(r, hi) * XD_STRIDE + 32 * db + l31] = o[db][r];
        }
        asm volatile("s_waitcnt lgkmcnt(0)\n\ts_barrier" ::: "memory");
        if (cj == 0) {
#pragma unroll
            for (int db = 0; db < NDB; ++db)
#pragma unroll
                for (int r = 0; r < 16; ++r) { LAS float* xp = X + crow(r, hi) * XD_STRIDE + 32 * db + l31; *xp = o[db][r] - *xp; }
            asm volatile("s_waitcnt lgkmcnt(0)" ::: "memory");
            const LAS float* xr = X + l31 * XD_STRIDE + 64 * hi; const LAS float* sg = (const LAS float*)(lds + L_SUBG) + 64 * hi;
            f32x4 xv[16]; float ss = 0.f;
#pragma unroll
            for (int i = 0; i < 16; ++i) { xv[i] = *(const LAS f32x4*)(xr + 4 * i); ss += (xv[i].x * xv[i].x + xv[i].y * xv[i].y) + (xv[i].z * xv[i].z + xv[i].w * xv[i].w); }
            ss = swap_add(ss);
            const float rstd = lam_scale / sqrtf(ss * (1.f / 128.f) + EPS);
            if (store_ok) {
                bf16* op = YAB + (size_t)qrow * DM + hh * 128 + 64 * hi;
#pragma unroll
                for (int k = 0; k < 8; ++k) { const f32x4 g0 = *(const LAS f32x4*)(sg + 8 * k), g1 = *(const LAS f32x4*)(sg + 8 * k + 4); const f32x4 a = xv[2 * k], b = xv[2 * k + 1];
                    v4u ov; ov.x = cvtpk(a.x * rstd * g0.x, a.y * rstd * g0.y); ov.y = cvtpk(a.z * rstd * g0.z, a.w * rstd * g0.w); ov.z = cvtpk(b.x * rstd * g1.x, b.y * rstd * g1.y); ov.w = cvtpk(b.z * rstd * g1.z, b.w * rstd * g1.w);
                    *(GAS v4u*)(op + 8 * k) = ov; }
            }
        }
    } else {
        LAS float* X = (LAS float*)lds + w * 32 * XS_STRIDE;
#pragma unroll
        for (int db = 0; db < NDB; ++db)
#pragma unroll
            for (int r = 0; r < 16; ++r) X[crow(r, hi) * XS_STRIDE + 32 * db + l31] = o[db][r];
        asm volatile("s_waitcnt lgkmcnt(0)" ::: "memory");
        const LAS float* xr = X + l31 * XS_STRIDE + 32 * hi;
        if (store_ok) {
            bf16* op = YAB + (size_t)qrow * DM + 1024 + (2 * hh + cj) * 64 + 32 * hi;
#pragma unroll
            for (int k = 0; k < 4; ++k) { const f32x4 a = *(const LAS f32x4*)(xr + 8 * k), b = *(const LAS f32x4*)(xr + 8 * k + 4);
                v4u ov; ov.x = cvtpk(a.x, a.y); ov.y = cvtpk(a.z, a.w); ov.z = cvtpk(b.x, b.y); ov.w = cvtpk(b.z, b.w);
                *(GAS v4u*)(op + 8 * k) = ov; }
        }
    }
    asm volatile("s_waitcnt lgkmcnt(0)\n\ts_barrier" ::: "memory");
}

__device__ __forceinline__ void attn_phase(Frame& F, const bf16* Z, bf16* YAB, CPtrs PP, int layer, int bx) {
    const int tid = F.tid;
    asm volatile("" : "+s"(Z), "+s"(YAB));
    const int lane = tid & 63;
    auto uni = [](float v) { return __builtin_bit_cast(float, __builtin_amdgcn_readfirstlane(__builtin_bit_cast(int, v))); };
    const float lam_init = uni(0.8f - 0.6f * expf(-0.3f * (float)layer));
    asm volatile("" : "+s"(PP));
    const float lam = uni(expf(wave_sum(PP->lq1[layer * 64 + lane] * PP->lk1[layer * 64 + lane])) - expf(wave_sum(PP->lq2[layer * 64 + lane] * PP->lk2[layer * 64 + lane])) + lam_init);
    if (tid < 128) ((LAS float*)(F.lds + L_SUBG))[tid] = PP->dnorm[layer * 128 + tid];
    const float* relb = (const float*)(PP->ws + WS_LUTG); const float* sinks = PP->sinks;
    __syncthreads();
    const int w = __builtin_amdgcn_readfirstlane(tid >> 6);
    const bool deal256 = (F.G == 256);
    unsigned useq = (unsigned)layer * 4096u;
    for (int it = F.vcu; it < 512; it += F.G) {
        for (int sub = 0; sub < 2; ++sub) { const int s = it & 63; attn_unit<true>(F.lds, Z, YAB, relb, it >> 6, sub ? s : 127 - s, lam, 1.f - lam_init, 0.f, tid, ++useq); }
    }
    const int e0 = deal256 ? (bx < 64 ? bx : 128 + (bx - 64)) : F.vcu, estep = deal256 ? (bx < 64 ? 64 : 192) : F.G, elim = (deal256 && bx < 64) ? 128 : 1040;
    const bool last_layer = (layer == DEPTH - 1);
    for (int e = e0; e < elim; e += estep) {
        if (last_layer && (e >= 1032 || (e % 129) == 128)) continue;
        if (e < 1032) attn_unit<false>(F.lds, Z, YAB, relb, e / 129, e % 129, 0.f, 0.f, uni(sinks[layer * 16 + 2 * (e / 129) + (w >> 2)] * LOG2E), tid, ++useq);
        else attn_unit<true>(F.lds, Z, YAB, relb, e - 1032, 128, lam, 1.f - lam_init, 0.f, tid, ++useq);
    }
}
#undef ATT_MFMA
}

#ifndef FFN_SPLIT_N
#define FFN_SPLIT_N 2
#endif
constexpr int FFN_SPLIT = ONE_LAUNCH ? FFN_SPLIT_N : 1;
constexpr int NT_IN_A = 20;
constexpr int PH_PER_LAYER = 9, N_PHASES = 1 + DEPTH * PH_PER_LAYER;
struct Args { Ptrs p; int ph_lo, ph_hi; };

__global__ void __launch_bounds__(NWAVES * 64, 2) fwd_kernel(Args args) {
    extern __shared__ __attribute__((aligned(16))) unsigned char lds[];
    Frame F;
    F.lds = (LAS unsigned char*)lds;
    F.MISC = (volatile LAS unsigned*)(F.lds + MISC_OFF);
    F.tid = threadIdx.x; F.lane = F.tid & 63; F.wave = __builtin_amdgcn_readfirstlane(F.tid >> 6);
    F.G = gridDim.x; { const int bx = blockIdx.x; F.vcu = (F.G % 8 == 0) ? (bx % 8) * (F.G / 8) + bx / 8 : bx; }
    CPtrs PP = (CPtrs)__builtin_amdgcn_kernarg_segment_ptr();
#define LDP(field) ({ CPtrs q_ = PP; asm volatile("" : "+s"(q_)); q_->field; })
#define WSP(off) ({ unsigned char* w_ = LDP(ws); (bf16*)(w_ + (off)); })
    F.ctl = (gu32*)(LDP(ws) + WS_CTL);
    for (int u = F.tid; u < (LDS_BYTES - LDSCTL_OFF) / 4; u += NWAVES * 64) ((LAS unsigned*)(F.lds + LDSCTL_OFF))[u] = 0u;
    __syncthreads();
    const int lo = args.ph_lo, hi = args.ph_hi;
    const bool multi = (hi - lo) > 1;
    XcdBarrier bar; bar.bar = (unsigned*)(F.ctl + CW_BAR); bar.x = 0; bar.st = nullptr;
    if (multi) bar = xcd_barrier_post((unsigned*)(F.ctl + CW_BAR), F.MISC + 8);
#define IN(k) (lo <= (k) && (k) < hi)
#define SEAM(k) do { if (IN(k) && IN((k) + 1)) { xcd_barrier(bar); if (NREP(10) == 2) xcd_barrier(bar); } } while (0)

#define RSP ((float*)(LDP(ws) + WS_HMETA))

    if (IN(0)) {
        gate_colmax_pass(F, LDP(w_in), LDP(n_attn_pre), (unsigned*)(F.ctl + CW_CMAX));
        if (multi) xcd_barrier(bar);
        p0_transposes(F, PP);
        gate_quant_pass(F, LDP(w_in), LDP(n_attn_pre), (signed char*)(LDP(ws) + WS_WQ), (const unsigned*)(F.ctl + CW_CMAX), (float*)(LDP(ws) + WS_CS));
        build_lut_tables(F, LDP(relb), (float*)(LDP(ws) + WS_LUTG));
        __syncthreads();
        resid_phase<0>(F, LDP(x), LDP(meta), WSP(WS_U), RSP, nullptr, nullptr, nullptr, (signed char*)(LDP(ws) + WS_HQ), (float*)(LDP(ws) + WS_QS));
        SEAM(0);
    }
    for (int l = 0; l < DEPTH; ++l) {
        const int pb = 1 + PH_PER_LAYER * l;
        if (pb + PH_PER_LAYER <= lo || pb >= hi) continue;
#define FRESH(Fs) Frame Fs = F; asm volatile("" : "+s"(Fs.vcu), "+s"(Fs.G), "+s"(Fs.wave), "+v"(Fs.tid)); Fs.lane = Fs.tid & 63; int bx_ = blockIdx.x; asm volatile("" : "+s"(bx_))
#define OPQ(p) asm volatile("" : "+s"(p))
        if (IN(pb + 0)) {
            for (int rep = 0; rep < NREP(0); ++rep) {
            const bf16* A_ = WSP(WS_U); const bf16* B_ = WSP(WS_WIN) + (size_t)l * INW * DM; bf16* O_ = WSP(WS_Z); OPQ(A_); OPQ(B_); OPQ(O_);
            FRESH(Fs); for (int mrep = 0; mrep < NREP(11); ++mrep) meta_gemm(Fs.lds, A_ + (size_t)ROW_META * DM, DM, B_, DM, INW, DM, Fs.vcu, Fs.G, Fs.tid, MEpiZ{O_, RSP});
            pg8::Gemm g{A_, B_, SEQ, 17 * 256, DM, DM, DM}; pg8::StaticOrder S; S.init(SEQ, 17 * 256, Fs.G, bx_);
            pg8::EpiZ E{O_, INW, RSP, 0};
            pg8::gemm_phase<pg8::EpiZ, pg8::StaticOrder, true>(F.lds + RING_OFF, g, S, E);
            if (Fs.G != 256 || bx_ >= 64) {
                const bf16* AQ_ = WSP(WS_HQ); const bf16* BQ_ = (const bf16*)(LDP(ws) + WS_WQ + (size_t)l * 4096 * DM); const float* QS_ = (const float*)(LDP(ws) + WS_QS); const float* CS_ = (const float*)(LDP(ws) + WS_CS) + l * 4096; OPQ(AQ_); OPQ(BQ_); OPQ(QS_); OPQ(CS_);
                pg8::Gemm gq{AQ_, BQ_, SEQ, (NT_IN_A - 17) * 256, 1024, 1024, 1024}; pg8::StaticOrder Sq; if (Fs.G == 256) Sq.init(SEQ, (NT_IN_A - 17) * 256, 192, bx_ - 64); else Sq.init(SEQ, (NT_IN_A - 17) * 256, Fs.G, bx_);
                pg8::EpiZ Eq{O_, INW, QS_, 17, CS_};
                pg8::gemm_phase<pg8::EpiZ, pg8::StaticOrder, true, true>(F.lds + RING_OFF, gq, Sq, Eq);
            }
            }
            SEAM(pb + 0);
        }
        if (IN(pb + 1)) {
#if !ATTN_NAIVE
            for (int rep = 0; rep < NREP(1); ++rep) { FRESH(Fs);
                att::attn_phase(Fs, WSP(WS_Z), WSP(WS_YAB), PP, l, bx_);
                {
                    constexpr int GC0 = (NT_IN_A - 17) * 256;
                    const bf16* AQ_ = WSP(WS_HQ); const bf16* BQ_ = (const bf16*)(LDP(ws) + WS_WQ + ((size_t)l * 4096 + GC0) * DM); bf16* O_ = WSP(WS_Z); const float* QS_ = (const float*)(LDP(ws) + WS_QS); const float* CS_ = (const float*)(LDP(ws) + WS_CS) + l * 4096 + GC0; OPQ(AQ_); OPQ(BQ_); OPQ(O_); OPQ(QS_); OPQ(CS_);
                    pg8::Gemm gq{AQ_, BQ_, SEQ, (33 - NT_IN_A) * 256, 1024, 1024, 1024}; pg8::StaticOrder Sq; Sq.init(SEQ, (33 - NT_IN_A) * 256, Fs.G, bx_);
                    pg8::EpiZ Eq{O_, INW, QS_, NT_IN_A, CS_};
                    pg8::gemm_phase<pg8::EpiZ, pg8::StaticOrder, true, true>(F.lds + RING_OFF, gq, Sq, Eq);
                } }
#endif
            SEAM(pb + 1);
        }
        if (IN(pb + 2)) {
            for (int rep = 0; rep < NREP(2); ++rep) {
            const bf16* A_ = WSP(WS_YAB); const bf16* B_ = WSP(WS_WA) + (size_t)l * DM * 1024; bf16* O_ = WSP(WS_T); const bf16* G_ = WSP(WS_Z) + C_GA; OPQ(A_); OPQ(B_); OPQ(O_); OPQ(G_);
            FRESH(Fs); if (l + 1 < DEPTH) for (int mrep = 0; mrep < NREP(11); ++mrep) meta_gemm(Fs.lds, A_ + (size_t)ROW_META * DM, DM, B_, 1024, DM, 1024, Fs.vcu, Fs.G, Fs.tid, MEpiGate<false>{O_, G_, O_});
            pg8::Gemm g{A_, B_, SEQ, DM, 1024, DM, 1024}; pg8::StaticOrder S; S.init(SEQ, DM, Fs.G, bx_);
            pg8::EpiGate<false> E{O_, DM, G_, INW, O_};
            pg8::gemm_phase<pg8::EpiGate<false>, pg8::StaticOrder, true>(F.lds + RING_OFF, g, S, E);
            }
            SEAM(pb + 2);
        }
        if (IN(pb + 3)) {
            for (int rep = 0; rep < NREP(3); ++rep) {
            const bf16* A_ = WSP(WS_YAB) + 1024; const bf16* B_ = WSP(WS_WB) + (size_t)l * DM * 1024; bf16* O_ = WSP(WS_MIX); const bf16* G_ = WSP(WS_Z) + C_GB; const bf16* P_ = WSP(WS_T); OPQ(A_); OPQ(B_); OPQ(O_); OPQ(G_); OPQ(P_);
            FRESH(Fs); if (l + 1 < DEPTH) for (int mrep = 0; mrep < NREP(11); ++mrep) meta_gemm(Fs.lds, A_ + (size_t)ROW_META * DM, DM, B_, 1024, DM, 1024, Fs.vcu, Fs.G, Fs.tid, MEpiGate<true>{O_, G_, P_});
            pg8::Gemm g{A_, B_, SEQ, DM, 1024, DM, 1024}; pg8::StaticOrder S; S.init(SEQ, DM, Fs.G, bx_);
            pg8::EpiGate<true> E{O_, DM, G_, INW, P_};
            pg8::gemm_phase<pg8::EpiGate<true>, pg8::StaticOrder, true>(F.lds + RING_OFF, g, S, E);
            }
            SEAM(pb + 3);
        }
        if (IN(pb + 4)) {
            for (int rep = 0; rep < NREP(4); ++rep) {
            const bf16* A_ = WSP(WS_MIX); const bf16* B_ = WSP(WS_WOUT) + (size_t)l * DM * DM; bf16* O_ = WSP(WS_T); OPQ(A_); OPQ(B_); OPQ(O_);
            FRESH(Fs); if (l + 1 < DEPTH) for (int mrep = 0; mrep < NREP(11); ++mrep) meta_gemm(Fs.lds, A_ + (size_t)ROW_META * DM, DM, B_, DM, DM, DM, Fs.vcu, Fs.G, Fs.tid, MEpiPlain<0>{O_, DM, nullptr});
            pg8::Gemm g{A_, B_, SEQ, DM, DM, DM, DM}; pg8::StaticOrder S; S.init(SEQ, DM, Fs.G, bx_);
            pg8::EpiBf16<0> E{O_, DM, nullptr};
            pg8::gemm_phase<pg8::EpiBf16<0>, pg8::StaticOrder, true>(F.lds + RING_OFF, g, S, E);
            }
            SEAM(pb + 4);
        }
        if (IN(pb + 5)) {
            for (int rep = 0; rep < ((l == 0) ? NREP(5) : 1); ++rep) {
            FRESH(Fs); resid_phase<1>(Fs, nullptr, nullptr, WSP(WS_U), RSP, WSP(WS_T), LDP(n_attn_post) + l * DM, nullptr);
            }
            SEAM(pb + 5);
        }
        if (IN(pb + 6) || IN(pb + 7)) {
            constexpr int PROWS = SEQ / FFN_SPLIT;
            for (int part = 0; part < FFN_SPLIT; ++part) {
                if (IN(pb + 6)) {
                    for (int rep = 0; rep < NREP(6); ++rep) {
                    const bf16* A_ = WSP(WS_U); const bf16* B_ = WSP(WS_W1) + (size_t)l * DFF * DM; bf16* O_ = WSP(WS_Z); const float* R_ = RSP; OPQ(A_); OPQ(B_); OPQ(O_); OPQ(R_);
                    FRESH(Fs); if (l + 1 < DEPTH && part == 0) for (int mrep = 0; mrep < NREP(11); ++mrep) meta_gemm(Fs.lds, A_ + (size_t)ROW_META * DM, DM, B_, DM, DFF, DM, Fs.vcu, Fs.G, Fs.tid, MEpiPlain<1>{O_, DFF, R_});
                    pg8::Gemm g{A_ + (size_t)part * PROWS * DM, B_, PROWS, DFF, DM, DM, DM}; pg8::StaticOrder S; S.init(PROWS, DFF, Fs.G, bx_);
                    pg8::EpiBf16<1> E{O_ + (size_t)part * PROWS * DFF, DFF, R_ + part * PROWS};
                    pg8::gemm_phase<pg8::EpiBf16<1>, pg8::StaticOrder, true>(F.lds + RING_OFF, g, S, E);
                    }
                    if (IN(pb + 7) && multi) xcd_barrier(bar);
                }
                if (IN(pb + 7)) {
                    for (int rep = 0; rep < NREP(7); ++rep) {
                    const bf16* A_ = WSP(WS_Z); const bf16* B_ = WSP(WS_W2) + (size_t)l * DM * DFF; bf16* O_ = WSP(WS_T); OPQ(A_); OPQ(B_); OPQ(O_);
                    FRESH(Fs); if (l + 1 < DEPTH && part == 0) for (int mrep = 0; mrep < NREP(11); ++mrep) meta_gemm(Fs.lds, A_ + (size_t)ROW_META * DFF, DFF, B_, DFF, DM, DFF, Fs.vcu, Fs.G, Fs.tid, MEpiPlain<0>{O_, DM, nullptr});
                    pg8::Gemm g{A_ + (size_t)part * PROWS * DFF, B_, PROWS, DM, DFF, DFF, DFF}; pg8::StaticOrder S; S.init(PROWS, DM, Fs.G, bx_);
                    pg8::EpiBf16<0> E{O_ + (size_t)part * PROWS * DM, DM, nullptr};
                    pg8::gemm_phase<pg8::EpiBf16<0>, pg8::StaticOrder, true>(F.lds + RING_OFF, g, S, E);
                    }
                    if (part + 1 < FFN_SPLIT && IN(pb + 6) && multi) xcd_barrier(bar);
                }
            }
            SEAM(pb + 7);
        }
        if (IN(pb + 8)) {
            FRESH(Fs);
            if (l + 1 < DEPTH) resid_phase<1>(Fs, nullptr, nullptr, WSP(WS_U), RSP, WSP(WS_T), LDP(n_ff_post) + l * DM, nullptr, (signed char*)(LDP(ws) + WS_HQ), (float*)(LDP(ws) + WS_QS));
            else resid_phase<2>(Fs, nullptr, nullptr, WSP(WS_U), RSP, WSP(WS_T), LDP(n_ff_post) + l * DM, LDP(out));
            SEAM(pb + 8);
        }
    }
#undef OPQ
#undef FRESH
#undef LDP
#undef WSP
#undef RSP
#undef IN
#undef SEAM
}

extern "C" void kernel_launch(void* const* d_in, const int* in_sizes, int n_in, void* d_out, int out_size, void* d_ws, size_t ws_size, hipStream_t stream) {
    static int grid = 0;
    if (grid == 0) {
        if (n_in != 19 || in_sizes[0] != SEQ * DM || out_size != SEQ * DM || ws_size < WS_END) { fprintf(stderr, "kernel_launch: unexpected shapes (n_in %d, ws %zu)\n", n_in, ws_size); grid = -1; return; }
        int dev = 0, cus = 0;
        if (hipGetDevice(&dev) != hipSuccess || hipDeviceGetAttribute(&cus, hipDeviceAttributeMultiprocessorCount, dev) != hipSuccess) { grid = -1; return; }
        if (hipFuncSetAttribute((const void*)fwd_kernel, hipFuncAttributeMaxDynamicSharedMemorySize, LDS_BYTES) != hipSuccess) { grid = -1; return; }
#if ATTN_NAIVE
        (void)hipFuncSetAttribute((const void*)naive_attn<true>, hipFuncAttributeMaxDynamicSharedMemorySize, NAIVE_LDS);
        (void)hipFuncSetAttribute((const void*)naive_attn<false>, hipFuncAttributeMaxDynamicSharedMemorySize, NAIVE_LDS);
#endif
        int per_cu = 0;
        (void)hipOccupancyMaxActiveBlocksPerMultiprocessor(&per_cu, (const void*)fwd_kernel, NWAVES * 64, LDS_BYTES);
        (void)hipGetLastError();
        grid = cus;
    }
    if (grid < 0) return;
    if (hipMemsetAsync((char*)d_ws + WS_CTL, 0, CTL_ZERO_BYTES, stream) != hipSuccess) return;
    Args a{};
    a.p.x = (const float*)d_in[0]; a.p.meta = (const float*)d_in[1]; a.p.relb = (const float*)d_in[2]; a.p.w_in = (const float*)d_in[3]; a.p.w_a = (const float*)d_in[4];
    a.p.w_b = (const float*)d_in[5]; a.p.w_out = (const float*)d_in[6]; a.p.lq1 = (const float*)d_in[7]; a.p.lk1 = (const float*)d_in[8]; a.p.lq2 = (const float*)d_in[9];
    a.p.lk2 = (const float*)d_in[10]; a.p.dnorm = (const float*)d_in[11]; a.p.sinks = (const float*)d_in[12]; a.p.n_attn_pre = (const float*)d_in[13]; a.p.n_attn_post = (const float*)d_in[14];
    a.p.w_ff1 = (const float*)d_in[15]; a.p.w_ff2 = (const float*)d_in[16]; a.p.n_ff_pre = (const float*)d_in[17]; a.p.n_ff_post = (const float*)d_in[18];
    a.p.out = (float*)d_out; a.p.ws = (unsigned char*)d_ws;
#if ONE_LAUNCH
    a.ph_lo = 0; a.ph_hi = N_PHASES;
    hipLaunchKernelGGL(fwd_kernel, dim3(grid), dim3(NWAVES * 64), LDS_BYTES, stream, a);
#else
    for (int ph = 0; ph < N_PHASES; ++ph) {
        const int l = (ph - 1) / PH_PER_LAYER, i = (ph - 1) % PH_PER_LAYER;
#if ATTN_NAIVE
        if (ph >= 1 && i == 1) {
            const bf16* Z = (const bf16*)((unsigned char*)d_ws + WS_Z); bf16* YAB = (bf16*)((unsigned char*)d_ws + WS_YAB);
            hipLaunchKernelGGL(naive_attn<true>, dim3(8 * 129), dim3(512), NAIVE_LDS, stream, Z, YAB, a.p.relb, a.p.lq1, a.p.lk1, a.p.lq2, a.p.lk2, a.p.dnorm, a.p.sinks, l);
            hipLaunchKernelGGL(naive_attn<false>, dim3(8 * 129), dim3(512), NAIVE_LDS, stream, Z, YAB, a.p.relb, a.p.lq1, a.p.lk1, a.p.lq2, a.p.lk2, a.p.dnorm, a.p.sinks, l);
            continue;
        }
#endif
        a.ph_lo = ph; a.ph_hi = ph + 1;
        hipLaunchKernelGGL(fwd_kernel, dim3(grid), dim3(NWAVES * 64), LDS_BYTES, stream, a);
    }
#endif
    (void)hipPeekAtLastError();
}
```

```cpp
#include <hip/hip_runtime.h>
#include <cstdio>
#include <cstdint>

#ifndef ATTN_NAIVE
#define ATTN_NAIVE 0
#endif
#ifndef PROBE_MASK
#define PROBE_MASK 0
#endif
#define NREP(i) (((PROBE_MASK >> (i)) & 1) ? 2 : 1)
#ifndef ONE_LAUNCH
#define ONE_LAUNCH 1
#endif

constexpr int DM = 2048, SEQ = 16384, DEPTH = 4, NMETA = 16;
constexpr int MA = 16640;
constexpr int ROW_META = 16384, NROWS = 16400;
constexpr int INW = 8448, DFF = 8192;
constexpr int C_QA = 0, C_KA = 1024, C_VA = 2048, C_QB = 3072, C_KB = 4096, C_VB = 4224, C_GA = 4352, C_GB = 6400;
constexpr int NBUCK = 32, NBIAS = 24;
constexpr float EPS = 1e-6f, LOG2E = 1.4426950408889634f, QSCALE = 0.125f * 1.4426950408889634f, NEGBIG = -1e30f;

constexpr size_t MiB = 1u << 20;
constexpr size_t WS_CTL = 0, CTL_ZERO_BYTES = 1 * MiB;
constexpr size_t WS_HMETA = 2 * MiB;
constexpr size_t WS_LUTG = 2 * MiB + 256 * 1024;
constexpr size_t WS_WIN = 4 * MiB;
constexpr size_t WS_WA = 136 * MiB, WS_WB = 152 * MiB;
constexpr size_t WS_WOUT = 168 * MiB;
constexpr size_t WS_W1 = 200 * MiB;
constexpr size_t WS_W2 = 328 * MiB;
constexpr size_t WS_U = 456 * MiB;
constexpr size_t WS_YAB = 521 * MiB;
constexpr size_t WS_MIX = 586 * MiB;
constexpr size_t WS_T = 651 * MiB;
constexpr size_t WS_Z = 716 * MiB;
constexpr size_t WS_HQ = WS_MIX;
constexpr int NQ = 5120;
constexpr size_t WS_WQ = 985 * MiB;
constexpr size_t WS_QS = 3 * MiB;
constexpr size_t WS_CS = 3 * MiB + 128 * 1024;
constexpr size_t WS_END = 1026 * MiB;
static_assert(WS_Z + (size_t)MA * INW * 2 <= WS_WQ && WS_WQ + (size_t)4 * 5120 * 2048 <= WS_END && (size_t)MA * 2048 <= 65 * MiB, "ws map");
constexpr int CW_TMO = 0, CW_BAR = 4096, CW_CMAX = 32768;

namespace pg8 {
#define PG8_LAS __attribute__((address_space(3)))
typedef unsigned short bf16_t;
typedef short bf16x8 __attribute__((ext_vector_type(8)));
typedef float f32x4 __attribute__((ext_vector_type(4)));
typedef unsigned u32x4 __attribute__((ext_vector_type(4)));
typedef int i32x4 __attribute__((ext_vector_type(4)));
constexpr int BM = 256, BK = 64, HALF = 128, HTB = HALF * BK * 2  , STAGE_BYTES = 8 * HTB, NXCD = 8, WGM = 8;

__host__ __device__ __forceinline__ int lds_byte(int r, int c) { const int r7 = r & 7; return (r >> 3) * 1024 + r7 * 128 + (((c >> 3) ^ r7) << 4) + (c & 7) * 2; }
__host__ __device__ __forceinline__ void stage_rc(int b, int& R, int& C) { const int blk = b / 1024, sb = b % 1024, r7 = sb / 128, chs = (sb % 128) / 16; R = blk * 8 + r7; C = (chs ^ r7) * 8; }
__host__ __device__ __forceinline__ int perm32(int rho) { const int n = rho >> 4, i = rho & 15; return 8 * (i >> 2) + 4 * n + (i & 3); }

struct Unit { int pm, pn; };
struct Gemm { const bf16_t* A; const bf16_t* Bt; int M, N, K, lda, ldb; };

struct StaticOrder {
    int nM, nN, nwg, G, c;
    __host__ __device__ void init(int M, int N, int G_, int c_) { nM = M / BM; nN = N / BM; nwg = nM * nN; G = G_; c = c_; }
    __host__ __device__ bool next(int i, Unit& u) const {
        const long L = (long)i * G + c; if (L >= nwg) return false;
        int wgid = (int)L; { const int q = nwg / NXCD, r = nwg % NXCD, xcd = wgid % NXCD, off = wgid / NXCD; wgid = (xcd < r ? xcd * (q + 1) : r * (q + 1) + (xcd - r) * q) + off; }
        const int nig = WGM * nN, gid = wgid / nig, fm = gid * WGM, gsz = (nM - fm) < WGM ? (nM - fm) : WGM;
        u.pm = fm + ((wgid % nig) % gsz); u.pn = (wgid % nig) / gsz; return true;
    }
    __device__ __forceinline__ void a_ready(const Unit&) const {}
    __device__ __forceinline__ void done(const Unit&) const {}
};

__device__ __forceinline__ unsigned cvt_pk_bf16(float lo, float hi) { unsigned r; asm volatile("v_cvt_pk_bf16_f32 %0, %1, %2" : "=v"(r) : "v"(lo), "v"(hi)); return r; }
__device__ __forceinline__ float bf_lo(unsigned u) { return __builtin_bit_cast(float, u << 16); }
__device__ __forceinline__ float bf_hi(unsigned u) { return __builtin_bit_cast(float, u & 0xffff0000u); }
__device__ __forceinline__ float sigmoidf_fast(float x) { return __builtin_amdgcn_rcpf(1.0f + __builtin_amdgcn_exp2f(-x * 1.4426950408889634f)); }

#define PG8_GAS __attribute__((address_space(1)))
__device__ __forceinline__ void st_remap(PG8_LAS unsigned char* stg, int fr, int fq, int lane, u32x4 w, PG8_GAS bf16_t* blk, int ldc) {
    *(PG8_LAS u32x4*)(stg + fr * 64 + ((fq ^ ((fr >> 1) & 3)) * 16)) = w;
    const int r = lane >> 2, c = lane & 3;
    const u32x4 v = *(const PG8_LAS u32x4*)(stg + r * 64 + ((c ^ ((r >> 1) & 3)) * 16));
    *(PG8_GAS u32x4*)(blk + (size_t)r * ldc + c * 8) = v;
}
struct EpiZ {
    static constexpr bool PERM = true, AFTER_DRAIN = false;
    bf16_t* O; int ldc; const float* rs; int pn_off; const float* cs = nullptr; int pn_split = 1 << 30, pn_jump = 0;
    __device__ __forceinline__ void operator()(const f32x4 (&acc)[2][2][4][2], const Unit& u, int wr, int wc, int fr, int fq, PG8_LAS unsigned char* stg, int lane) const {
        const int tpn = u.pn + pn_off + (u.pn >= pn_split ? pn_jump : 0);
        const int rowb = u.pm * BM + wr * 64, colb = tpn * BM + wc * 32;
        const int mode = (tpn < 4 || (tpn >= 12 && tpn < 16)) ? 1 : (tpn >= 17 ? 2 : 0);
        f32x4 c4[2][2];
        if (cs) {
#pragma unroll
            for (int bj = 0; bj < 2; ++bj) { c4[bj][0] = *(const PG8_GAS f32x4*)(cs + u.pn * BM + wc * 32 + bj * HALF + 8 * fq); c4[bj][1] = *(const PG8_GAS f32x4*)(cs + u.pn * BM + wc * 32 + bj * HALF + 8 * fq + 4); } }
        float r8[2][4];
#pragma unroll
        for (int ai = 0; ai < 2; ++ai)
#pragma unroll
            for (int m = 0; m < 4; ++m) r8[ai][m] = ((const PG8_GAS float*)rs)[rowb + fr + ai * HALF + m * 16];
#pragma unroll
        for (int ai = 0; ai < 2; ++ai)
#pragma unroll
            for (int m = 0; m < 4; ++m) { PG8_GAS bf16_t* blk = (PG8_GAS bf16_t*)O + (size_t)(rowb + ai * HALF + m * 16) * ldc + colb; const float r_ = r8[ai][m];
#pragma unroll
                for (int bj = 0; bj < 2; ++bj) { f32x4 v0, v1;
                    if (cs) { const i32x4 a0 = __builtin_bit_cast(i32x4, acc[ai][bj][m][0]), a1 = __builtin_bit_cast(i32x4, acc[ai][bj][m][1]);
#pragma unroll
                        for (int e = 0; e < 4; ++e) { v0[e] = (float)a0[e] * r_ * c4[bj][0][e]; v1[e] = (float)a1[e] * r_ * c4[bj][1][e]; } }
                    else { v0 = acc[ai][bj][m][0] * r_; v1 = acc[ai][bj][m][1] * r_; }
                    if (mode == 1) { v0 = v0 * QSCALE; v1 = v1 * QSCALE; }
                    else if (mode == 2) {
#pragma unroll
                        for (int e = 0; e < 4; ++e) { v0[e] = sigmoidf_fast(v0[e]); v1[e] = sigmoidf_fast(v1[e]); } }
                    u32x4 w; w.x = cvt_pk_bf16(v0[0], v0[1]); w.y = cvt_pk_bf16(v0[2], v0[3]); w.z = cvt_pk_bf16(v1[0], v1[1]); w.w = cvt_pk_bf16(v1[2], v1[3]);
                    st_remap(stg, fr, fq, lane, w, blk + bj * HALF, ldc); } }
    }
};
struct EpiZq {
    static constexpr bool PERM = true, AFTER_DRAIN = false;
    bf16_t* O; int ldc; const float* qs; const float* cs; int col_off;
    __device__ __forceinline__ void operator()(const f32x4 (&acc)[2][2][4][2], const Unit& u, int wr, int wc, int fr, int fq, PG8_LAS unsigned char* stg, int lane) const {
        const int rowb = u.pm * BM + wr * 64, colg = u.pn * BM + wc * 32;
        float r8[2][4]; f32x4 c4[2][2];
#pragma unroll
        for (int ai = 0; ai < 2; ++ai)
#pragma unroll
            for (int m = 0; m < 4; ++m) r8[ai][m] = ((const PG8_GAS float*)qs)[rowb + fr + ai * HALF + m * 16];
#pragma unroll
        for (int bj = 0; bj < 2; ++bj) { c4[bj][0] = *(const PG8_GAS f32x4*)(cs + colg + bj * HALF + 8 * fq); c4[bj][1] = *(const PG8_GAS f32x4*)(cs + colg + bj * HALF + 8 * fq + 4); }
#pragma unroll
        for (int ai = 0; ai < 2; ++ai)
#pragma unroll
            for (int m = 0; m < 4; ++m) { PG8_GAS bf16_t* blk = (PG8_GAS bf16_t*)O + (size_t)(rowb + ai * HALF + m * 16) * ldc + col_off + colg; const float r_ = r8[ai][m];
#pragma unroll
                for (int bj = 0; bj < 2; ++bj) { const i32x4 a0 = __builtin_bit_cast(i32x4, acc[ai][bj][m][0]), a1 = __builtin_bit_cast(i32x4, acc[ai][bj][m][1]); f32x4 v0, v1;
#pragma unroll
                    for (int e = 0; e < 4; ++e) { v0[e] = sigmoidf_fast((float)a0[e] * r_ * c4[bj][0][e]); v1[e] = sigmoidf_fast((float)a1[e] * r_ * c4[bj][1][e]); }
                    u32x4 w; w.x = cvt_pk_bf16(v0[0], v0[1]); w.y = cvt_pk_bf16(v0[2], v0[3]); w.z = cvt_pk_bf16(v1[0], v1[1]); w.w = cvt_pk_bf16(v1[2], v1[3]);
                    st_remap(stg, fr, fq, lane, w, blk + bj * HALF, ldc); } }
    }
};
template <int ACT  > struct EpiBf16 {
    static constexpr bool PERM = true, AFTER_DRAIN = false;
    bf16_t* O; int ldc; const float* rs;
    __device__ __forceinline__ void operator()(const f32x4 (&acc)[2][2][4][2], const Unit& u, int wr, int wc, int fr, int fq, PG8_LAS unsigned char* stg, int lane) const {
        const int rowb = u.pm * BM + wr * 64, colb = u.pn * BM + wc * 32;
        float r8[2][4];
        if (ACT == 1) {
#pragma unroll
            for (int ai = 0; ai < 2; ++ai)
#pragma unroll
                for (int m = 0; m < 4; ++m) r8[ai][m] = ((const PG8_GAS float*)rs)[rowb + fr + ai * HALF + m * 16]; }
#pragma unroll
        for (int ai = 0; ai < 2; ++ai)
#pragma unroll
            for (int m = 0; m < 4; ++m) { PG8_GAS bf16_t* blk = (PG8_GAS bf16_t*)O + (size_t)(rowb + ai * HALF + m * 16) * ldc + colb;
#pragma unroll
                for (int bj = 0; bj < 2; ++bj) { f32x4 v0 = acc[ai][bj][m][0], v1 = acc[ai][bj][m][1];
                    if (ACT == 1) { const float r_ = r8[ai][m];
#pragma unroll
                        for (int e = 0; e < 4; ++e) { const float a = fmaxf(v0[e] * r_, 0.f), b = fmaxf(v1[e] * r_, 0.f); v0[e] = a * a; v1[e] = b * b; } }
                    u32x4 w; w.x = cvt_pk_bf16(v0[0], v0[1]); w.y = cvt_pk_bf16(v0[2], v0[3]); w.z = cvt_pk_bf16(v1[0], v1[1]); w.w = cvt_pk_bf16(v1[2], v1[3]);
                    st_remap(stg, fr, fq, lane, w, blk + bj * HALF, ldc); } }
    }
};
template <bool ADD_PREV> struct EpiGate {
    static constexpr bool PERM = true, AFTER_DRAIN = false;
    bf16_t* O; int ldc; const bf16_t* G; int ldg; const bf16_t* P;
    __device__ __forceinline__ void operator()(const f32x4 (&acc)[2][2][4][2], const Unit& u, int wr, int wc, int fr, int fq, PG8_LAS unsigned char* stg, int lane) const {
        const int rowb = u.pm * BM + wr * 64, colb = u.pn * BM + wc * 32;
        const int row0 = rowb + fr, col0 = colb + 8 * fq;
        u32x4 gv[2][4], pv[2][4];
#define PG8_EG_LOAD(g, b) do { _Pragma("unroll") for (int mm = 0; mm < 2; ++mm) _Pragma("unroll") for (int bj = 0; bj < 2; ++bj) { \
            const size_t r_ = (size_t)(row0 + ((g) >> 1) * HALF + (((g) & 1) * 2 + mm) * 16); \
            gv[b][mm * 2 + bj] = *(const PG8_GAS u32x4*)((const PG8_GAS bf16_t*)G + r_ * ldg + col0 + bj * HALF); \
            if (ADD_PREV) pv[b][mm * 2 + bj] = *(const PG8_GAS u32x4*)((const PG8_GAS bf16_t*)P + r_ * ldc + col0 + bj * HALF); } } while (0)
#define PG8_EG_PROC(g, b) do { _Pragma("unroll") for (int mm = 0; mm < 2; ++mm) _Pragma("unroll") for (int bj = 0; bj < 2; ++bj) { \
            const int ai_ = (g) >> 1, m_ = ((g) & 1) * 2 + mm; \
            f32x4 v0 = acc[ai_][bj][m_][0], v1 = acc[ai_][bj][m_][1]; const u32x4 g_ = gv[b][mm * 2 + bj]; \
            v0[0] *= bf_lo(g_.x); v0[1] *= bf_hi(g_.x); v0[2] *= bf_lo(g_.y); v0[3] *= bf_hi(g_.y); v1[0] *= bf_lo(g_.z); v1[1] *= bf_hi(g_.z); v1[2] *= bf_lo(g_.w); v1[3] *= bf_hi(g_.w); \
            if (ADD_PREV) { const u32x4 p_ = pv[b][mm * 2 + bj]; \
                v0[0] += bf_lo(p_.x); v0[1] += bf_hi(p_.x); v0[2] += bf_lo(p_.y); v0[3] += bf_hi(p_.y); v1[0] += bf_lo(p_.z); v1[1] += bf_hi(p_.z); v1[2] += bf_lo(p_.w); v1[3] += bf_hi(p_.w); } \
            u32x4 w_; w_.x = cvt_pk_bf16(v0[0], v0[1]); w_.y = cvt_pk_bf16(v0[2], v0[3]); w_.z = cvt_pk_bf16(v1[0], v1[1]); w_.w = cvt_pk_bf16(v1[2], v1[3]); \
            st_remap(stg, fr, fq, lane, w_, (PG8_GAS bf16_t*)O + (size_t)(rowb + ai_ * HALF + m_ * 16) * ldc + colb + bj * HALF, ldc); } } while (0)
        PG8_EG_LOAD(0, 0); PG8_EG_LOAD(1, 1);
        PG8_EG_PROC(0, 0); PG8_EG_LOAD(2, 0);
        PG8_EG_PROC(1, 1); PG8_EG_LOAD(3, 1);
        PG8_EG_PROC(2, 0); PG8_EG_PROC(3, 1);
#undef PG8_EG_LOAD
#undef PG8_EG_PROC
    }
};

template <class Epi, class Sched, bool ALIGN_EPI, bool I8 = false>
__device__ __forceinline__ void gemm_phase(PG8_LAS unsigned char* lds, const Gemm g, const Sched& S, const Epi& E) {
    int tid_ = threadIdx.x; asm volatile("" : "+v"(tid_));
    const int tid = tid_, wid = __builtin_amdgcn_readfirstlane(tid >> 6), lane = tid & 63, wr = wid >> 2, wc = wid & 3, fr = lane & 15, fq = lane >> 4;
    const int K = g.K, nt = K / BK;
    unsigned voffA[2], voffB[2];
#pragma unroll
    for (int i = 0; i < 2; ++i) { int R, C; stage_rc(tid * 16 + i * 8192, R, C); const int Rb = Epi::PERM ? ((R & ~31) + perm32(R & 31)) : R;
        voffA[i] = (unsigned)(R * g.lda + C) * 2u; voffB[i] = (unsigned)(Rb * g.ldb + C) * 2u; }
    const size_t kstep = (size_t)(BK * 2);
    const size_t hstepA = (size_t)HALF * g.lda * 2, hstepB = (size_t)HALF * g.ldb * 2;
    const size_t tstepA = 2 * hstepA, tstepB = 2 * hstepB;
    const unsigned ldsw = (unsigned)wid * 1024u;
    const int aoff0 = lds_byte(wr * 64 + fr, fq * 8), aoff1 = lds_byte(wr * 64 + fr, 32 + fq * 8), boff0 = lds_byte(wc * 32 + fr, fq * 8), boff1 = lds_byte(wc * 32 + fr, 32 + fq * 8);
#define PG8_SA(b, h) (((b) * 2 + (h)) * HTB)
#define PG8_SB(b, h) ((4 + (b) * 2 + (h)) * HTB)
#define PG8_STAGE(bufoff, gbase, voff) do { _Pragma("unroll") for (int _i = 0; _i < 2; ++_i) \
        __builtin_amdgcn_global_load_lds((const unsigned*)((const char*)(gbase) + (voff)[_i]), (PG8_LAS unsigned*)(lds + (bufoff) + ldsw + _i * 8192), 16, 0, 0); } while (0)
#define PG8_LDA(dst, b, h) do { _Pragma("unroll") for (int m = 0; m < 4; ++m) _Pragma("unroll") for (int k = 0; k < 2; ++k) dst[m][k] = *(const PG8_LAS bf16x8*)(lds + PG8_SA(b, h) + (k ? aoff1 : aoff0) + m * 2048); } while (0)
#define PG8_LDB(dst, b, h) do { _Pragma("unroll") for (int n = 0; n < 2; ++n) _Pragma("unroll") for (int k = 0; k < 2; ++k) dst[n][k] = *(const PG8_LAS bf16x8*)(lds + PG8_SB(b, h) + (k ? boff1 : boff0) + n * 2048); } while (0)
#define PG8_MMA(ai, bj, At, Bt) do { __builtin_amdgcn_s_setprio(1); _Pragma("unroll") for (int m = 0; m < 4; ++m) _Pragma("unroll") for (int n = 0; n < 2; ++n) _Pragma("unroll") for (int k = 0; k < 2; ++k) \
        { if (I8) acc[ai][bj][m][n] = __builtin_bit_cast(f32x4, __builtin_amdgcn_mfma_i32_16x16x64_i8(__builtin_bit_cast(i32x4, Bt[n][k]), __builtin_bit_cast(i32x4, At[m][k]), __builtin_bit_cast(i32x4, acc[ai][bj][m][n]), 0, 0, 0)); \
          else acc[ai][bj][m][n] = __builtin_amdgcn_mfma_f32_16x16x32_bf16(Bt[n][k], At[m][k], acc[ai][bj][m][n], 0, 0, 0); } __builtin_amdgcn_s_setprio(0); } while (0)
#define PG8_WAIT_V(n) asm volatile("s_waitcnt vmcnt(" #n ")" ::: "memory")
#define PG8_WAIT_L(n) asm volatile("s_waitcnt lgkmcnt(" #n ")" ::: "memory")
#define PG8_BAR __builtin_amdgcn_s_barrier()
#define PG8_SCHED __builtin_amdgcn_sched_barrier(0)
    Unit cur, nxt; int ui = 0;
    if (!S.next(0, cur)) return;
    f32x4 acc[2][2][4][2];
#pragma unroll
    for (int a = 0; a < 2; ++a)
#pragma unroll
        for (int b = 0; b < 2; ++b)
#pragma unroll
            for (int m = 0; m < 4; ++m)
#pragma unroll
                for (int n = 0; n < 2; ++n) acc[a][b][m][n] = (f32x4){0.f, 0.f, 0.f, 0.f};
    bf16x8 At[4][2], B0[2][2], B1[2][2];
    const char* cA = (const char*)g.A + (size_t)cur.pm * tstepA; const char* cB = (const char*)g.Bt + (size_t)cur.pn * tstepB;
    S.a_ready(cur);
    PG8_STAGE(PG8_SB(0, 0), cB, voffB); PG8_STAGE(PG8_SB(0, 1), cB + hstepB, voffB); PG8_STAGE(PG8_SA(0, 0), cA, voffA); PG8_STAGE(PG8_SA(0, 1), cA + hstepA, voffA);
    if (wr == 1) PG8_BAR;
    PG8_WAIT_V(2); PG8_BAR;
    PG8_STAGE(PG8_SB(1, 0), cB + kstep, voffB); PG8_STAGE(PG8_SA(1, 0), cA + kstep, voffA); PG8_STAGE(PG8_SB(1, 1), cB + hstepB + kstep, voffB);
    PG8_WAIT_V(6); PG8_BAR;
    for (;;) {
        const bool has_next = S.next(ui + 1, nxt);
        const char* nA = has_next ? (const char*)g.A + (size_t)nxt.pm * tstepA : cA; const char* nB = has_next ? (const char*)g.Bt + (size_t)nxt.pn * tstepB : cB;
        for (int t = 0; t < nt; t += 2) {
            const bool last = (t == nt - 2);
            const char* a1 = cA + (size_t)(t + 1) * kstep;
            const char* a2 = last ? nA : cA + (size_t)(t + 2) * kstep; const char* b2 = last ? nB : cB + (size_t)(t + 2) * kstep;
            const char* a3 = a2 + kstep; const char* b3 = b2 + kstep;
            if (last && has_next) S.a_ready(nxt);
            PG8_LDB(B0, 0, 0); PG8_LDB(B1, 0, 1); PG8_SCHED; PG8_LDA(At, 0, 0); PG8_STAGE(PG8_SA(1, 1), a1 + hstepA, voffA);
            PG8_WAIT_V(8); PG8_WAIT_L(0); PG8_BAR; PG8_MMA(0, 0, At, B0); PG8_MMA(0, 1, At, B1); PG8_BAR; PG8_SCHED;
            PG8_LDA(At, 0, 1); PG8_STAGE(PG8_SB(0, 0), b2, voffB); PG8_STAGE(PG8_SB(0, 1), b2 + hstepB, voffB); PG8_STAGE(PG8_SA(0, 0), a2, voffA);
            PG8_WAIT_V(8); PG8_WAIT_L(0); PG8_BAR; PG8_MMA(1, 0, At, B0); PG8_MMA(1, 1, At, B1); PG8_BAR; PG8_SCHED;
            PG8_LDB(B0, 1, 0); PG8_LDB(B1, 1, 1); PG8_SCHED; PG8_LDA(At, 1, 0); PG8_STAGE(PG8_SA(0, 1), a2 + hstepA, voffA);
            PG8_WAIT_V(8); PG8_WAIT_L(0); PG8_BAR; PG8_MMA(0, 0, At, B0); PG8_MMA(0, 1, At, B1); PG8_BAR; PG8_SCHED;
            PG8_LDA(At, 1, 1); PG8_STAGE(PG8_SB(1, 0), b3, voffB); PG8_STAGE(PG8_SB(1, 1), b3 + hstepB, voffB); PG8_STAGE(PG8_SA(1, 0), a3, voffA);
            PG8_WAIT_V(8); PG8_WAIT_L(0); PG8_BAR; PG8_MMA(1, 0, At, B0); PG8_MMA(1, 1, At, B1); PG8_BAR; PG8_SCHED;
        }
        if constexpr (ALIGN_EPI) { if (wr == 0) PG8_BAR; }
        E(acc, cur, wr, wc, fr, fq, lds + STAGE_BYTES + wid * 1024, lane); S.done(cur);
        if (!has_next) break;
#pragma unroll
        for (int a = 0; a < 2; ++a)
#pragma unroll
            for (int b = 0; b < 2; ++b)
#pragma unroll
                for (int m = 0; m < 4; ++m)
#pragma unroll
                    for (int n = 0; n < 2; ++n) acc[a][b][m][n] = (f32x4){0.f, 0.f, 0.f, 0.f};
        cur = nxt; cA = nA; cB = nB; ++ui;
        if constexpr (ALIGN_EPI) { if (wr == 1) PG8_BAR; }
    }
    PG8_WAIT_V(0);
    if constexpr (!ALIGN_EPI) { if (wr == 0) PG8_BAR; }
    PG8_BAR;
#undef PG8_SA
#undef PG8_SB
#undef PG8_STAGE
#undef PG8_LDA
#undef PG8_LDB
#undef PG8_MMA
#undef PG8_WAIT_V
#undef PG8_WAIT_L
#undef PG8_BAR
#undef PG8_SCHED
}
}
#define GAS __attribute__((address_space(1)))
#define LAS __attribute__((address_space(3)))
typedef unsigned short bf16;
typedef unsigned v4u __attribute__((ext_vector_type(4)));
typedef float f32x4 __attribute__((ext_vector_type(4)));
typedef short bf16x8 __attribute__((ext_vector_type(8)));
typedef GAS unsigned gu32;
typedef GAS unsigned long long gu64;
#define RLX_AGENT __ATOMIC_RELAXED, __HIP_MEMORY_SCOPE_AGENT
#define LDS_WAIT() asm volatile("s_waitcnt lgkmcnt(0)" ::: "memory")
#define VM_WAIT() asm volatile("s_waitcnt vmcnt(0)" ::: "memory")
__device__ __forceinline__ unsigned long long rt() { return __builtin_amdgcn_s_memrealtime(); }
__device__ __forceinline__ unsigned f2bf(float f) { unsigned u = __builtin_bit_cast(unsigned, f); return (u + 0x7fffu + ((u >> 16) & 1u)) >> 16; }
__device__ __forceinline__ unsigned pk2(float lo, float hi) { return f2bf(lo) | (f2bf(hi) << 16); }

#define XB_TMO      128
#define XB_XCNT(j)  (256  + 64 * (j))
#define XB_XSUB(j)  (1280 + 64 * (j))
#define XB_XGEN(j)  (2304 + 64 * (j))
#define XB_TOP      3328
#define XB_TOPGEN   3392
#define XCD_BAR_WORDS 3456
#define XB_SPIN_CAP (1u << 18)

__device__ __forceinline__ unsigned xb_ld(unsigned* p)              { return __hip_atomic_load(p, __ATOMIC_RELAXED, __HIP_MEMORY_SCOPE_AGENT); }
__device__ __forceinline__ unsigned xb_add(unsigned* p, unsigned v) { return __hip_atomic_fetch_add(p, v, __ATOMIC_RELAXED, __HIP_MEMORY_SCOPE_AGENT); }
__device__ __forceinline__ unsigned xb_xcc_id() { return (unsigned)__builtin_amdgcn_s_getreg((3 << 11) | 20) & 0xFu; }
#define XB_SPIN(cond, bar) do { unsigned _sp = 0; while (cond) { __builtin_amdgcn_s_sleep(1); \
    if ((++_sp & 255u) == 0u) { if (xb_ld(&(bar)[XB_TMO])) break; if (_sp > XB_SPIN_CAP) { atomicAdd(&(bar)[XB_TMO], 1u); break; } } } } while (0)

struct XcdBarrier {
    unsigned* bar; unsigned x;
    volatile LAS unsigned* st;
};

__device__ __forceinline__ XcdBarrier xcd_barrier_post(unsigned* bar, volatile LAS unsigned* st) {
    XcdBarrier b; b.bar = bar; b.x = xb_xcc_id(); b.st = st;
    if (threadIdx.x == 0) (void)xb_add(&bar[XB_XCNT(b.x)], 1u);
    return b;
}
__device__ __forceinline__ void xcd_barrier_complete(unsigned* bar, unsigned x, unsigned& nloc, unsigned& nx) {
    const unsigned G = gridDim.x * gridDim.y * gridDim.z;
    unsigned sum, cnt, mine, sp = 0u;
    for (;;) {
        sum = 0u; cnt = 0u; mine = 0u;
#pragma unroll
        for (unsigned j = 0; j < 16; ++j) { const unsigned c = xb_ld(&bar[XB_XCNT(j)]); sum += c; cnt += (c > 0u) ? 1u : 0u; mine = (j == x) ? c : mine; }
        if (sum == G) break;
        __builtin_amdgcn_s_sleep(1);
        if ((++sp & 255u) == 0u) { if (xb_ld(&bar[XB_TMO])) break; if (sp > XB_SPIN_CAP) { atomicAdd(&bar[XB_TMO], 1u); break; } }
    }
    nloc = mine > 0u ? mine : 1u; nx = cnt > 0u ? cnt : 1u;
}

__device__ __forceinline__ void xcd_barrier(const XcdBarrier& b) {
    asm volatile("s_waitcnt vmcnt(0)" ::: "memory");
    __syncthreads();
    if (threadIdx.x == 0) {
        unsigned* bar = b.bar;
        __builtin_amdgcn_s_waitcnt(0);
        unsigned nloc = b.st[0], nx = b.st[1];
        if (nloc == 0u) { xcd_barrier_complete(bar, b.x, nloc, nx); b.st[0] = nloc; b.st[1] = nx; }
        const unsigned old = xb_add(&bar[XB_XSUB(b.x)], 1u);
        const unsigned gen = old / nloc;
        if (old + 1u == (gen + 1u) * nloc) {
            __builtin_amdgcn_fence(__ATOMIC_RELEASE, "agent");
            asm volatile("s_waitcnt vmcnt(0)" ::: "memory");
            const unsigned og = xb_add(&bar[XB_TOP], 1u);
            const unsigned tg = og / nx;
            if (og + 1u == (tg + 1u) * nx) xb_add(&bar[XB_TOPGEN], 1u);
            else XB_SPIN(xb_ld(&bar[XB_TOPGEN]) == tg, bar);
            __builtin_amdgcn_fence(__ATOMIC_ACQUIRE, "agent");
            xb_add(&bar[XB_XGEN(b.x)], 1u);
            asm volatile("s_waitcnt vmcnt(0)" ::: "memory");
        } else {
            XB_SPIN(xb_ld(&bar[XB_XGEN(b.x)]) == gen, bar);
            __builtin_amdgcn_fence(__ATOMIC_ACQUIRE, "agent");
            asm volatile("s_waitcnt vmcnt(0)" ::: "memory");
        }
    }
    __syncthreads();
}

constexpr int NWAVES = 8;
constexpr int RING_OFF = 0, RING_BYTES = 131072;
constexpr int LDSCTL_OFF = 143360, MISC_OFF = LDSCTL_OFF + 320;
constexpr int LDS_BYTES = 147456;
static_assert(MISC_OFF + 128 <= LDS_BYTES, "LDS map");

struct Frame {
    LAS unsigned char* lds;
    volatile LAS unsigned* MISC;
    gu32* ctl;
    int tid, lane, wave;
    int vcu, G;
};
__device__ __forceinline__ float wave_sum(float v) {
#pragma unroll
    for (int o = 1; o < 64; o <<= 1) v += __shfl_xor(v, o);
    return v;
}

__device__ __forceinline__ float wave_max(float v) {
#pragma unroll
    for (int o = 1; o < 64; o <<= 1) v = fmaxf(v, __shfl_xor(v, o));
    return v;
}
__device__ __forceinline__ unsigned q8pack4(float a, float b, float c, float d) {
    const int ia = (int)__builtin_rintf(a), ib = (int)__builtin_rintf(b), ic = (int)__builtin_rintf(c), id = (int)__builtin_rintf(d);
    return (unsigned)(ia & 255) | ((unsigned)(ib & 255) << 8) | ((unsigned)(ic & 255) << 16) | ((unsigned)(id & 255) << 24);
}
__device__ __forceinline__ void transpose_item(const float* __restrict__ W, int K, int N, bf16* __restrict__ WT, LAS float* scr, int kb, int nb, int lane, const float* __restrict__ gain) {
    const int k0 = 64 * kb, n0 = 64 * nb;
    f32x4 v[16];
#pragma unroll
    for (int i = 0; i < 16; ++i) { const int kk = 4 * i + (lane >> 4); v[i] = *(const f32x4*)(W + (size_t)(k0 + kk) * N + n0 + 4 * (lane & 15)); }
    if (gain) {
#pragma unroll
        for (int i = 0; i < 16; ++i) v[i] = v[i] * gain[k0 + 4 * i + (lane >> 4)]; }
#pragma unroll
    for (int i = 0; i < 16; ++i) { const int kk = 4 * i + (lane >> 4); LAS float* d = scr + kk * 65 + 4 * (lane & 15); d[0] = v[i].x; d[1] = v[i].y; d[2] = v[i].z; d[3] = v[i].w; }
    LDS_WAIT(); asm volatile("" ::: "memory");
    const int c = lane & 7;
#pragma unroll
    for (int j = 0; j < 8; ++j) { const int n = (lane >> 3) + 8 * j; const LAS float* s = scr + (8 * c) * 65 + n;
        v4u o; o.x = pk2(s[0 * 65], s[1 * 65]); o.y = pk2(s[2 * 65], s[3 * 65]); o.z = pk2(s[4 * 65], s[5 * 65]); o.w = pk2(s[6 * 65], s[7 * 65]);
        *(GAS v4u*)(WT + (size_t)(n0 + n) * K + k0 + 8 * c) = o; }
    LDS_WAIT(); asm volatile("" ::: "memory");
}

struct Ptrs {
    const float* x; const float* meta; const float* relb; const float* w_in; const float* w_a; const float* w_b; const float* w_out;
    const float* lq1; const float* lk1; const float* lq2; const float* lk2; const float* dnorm; const float* sinks;
    const float* n_attn_pre; const float* n_attn_post; const float* w_ff1; const float* w_ff2; const float* n_ff_pre; const float* n_ff_post;
    float* out; unsigned char* ws;
};

typedef const __attribute__((address_space(4))) Ptrs* CPtrs;
__device__ __forceinline__ int qcol0(int nb) { return nb < 16 ? C_VA + 64 * nb : C_GA + 64 * (nb - 16); }
__device__ __forceinline__ void gate_colmax_pass(Frame& F, const float* __restrict__ w_in, const float* __restrict__ g_in, unsigned* __restrict__ cmax) {
    const int lane = F.lane, w = F.wave;
    LAS f32x4* part = (LAS f32x4*)F.lds;
    for (int it = F.vcu; it < DEPTH * 80; it += F.G) {
        const int l = it / 80, nb = it % 80;
        const float* W = w_in + (size_t)l * DM * INW + qcol0(nb) + 4 * (lane & 15); const float* g = g_in + l * DM;
        f32x4 m = (f32x4){0.f, 0.f, 0.f, 0.f};
        for (int kb = 4 * w; kb < 4 * w + 4; ++kb) {
#pragma unroll
            for (int i = 0; i < 16; ++i) { const int kk = 64 * kb + 4 * i + (lane >> 4); const f32x4 v = *(const f32x4*)(W + (size_t)kk * INW) * g[kk];
                m.x = fmaxf(m.x, fabsf(v.x)); m.y = fmaxf(m.y, fabsf(v.y)); m.z = fmaxf(m.z, fabsf(v.z)); m.w = fmaxf(m.w, fabsf(v.w)); } }
#pragma unroll
        for (int o = 16; o < 64; o <<= 1) { m.x = fmaxf(m.x, __shfl_xor(m.x, o)); m.y = fmaxf(m.y, __shfl_xor(m.y, o)); m.z = fmaxf(m.z, __shfl_xor(m.z, o)); m.w = fmaxf(m.w, __shfl_xor(m.w, o)); }
        if (lane < 16) part[w * 16 + lane] = m;
        __syncthreads();
        if (w == 0 && lane < 16) { f32x4 t = part[lane];
#pragma unroll
            for (int j = 1; j < 8; ++j) { const f32x4 q = part[j * 16 + lane]; t.x = fmaxf(t.x, q.x); t.y = fmaxf(t.y, q.y); t.z = fmaxf(t.z, q.z); t.w = fmaxf(t.w, q.w); }
            unsigned* c = cmax + l * NQ + 64 * nb + 4 * lane; c[0] = __float_as_uint(t.x); c[1] = __float_as_uint(t.y); c[2] = __float_as_uint(t.z); c[3] = __float_as_uint(t.w); }
        __syncthreads();
    }
}
__device__ __forceinline__ void gate_quant_item(const float* __restrict__ W, signed char* __restrict__ WQ, const unsigned* __restrict__ cmax, float* __restrict__ cs, LAS float* scr, int kb, int nb, int lane, const float* __restrict__ gain) {
    const int k0 = 64 * kb, n0 = 64 * nb;
    f32x4 v[16];
#pragma unroll
    for (int i = 0; i < 16; ++i) { const int kk = 4 * i + (lane >> 4); v[i] = *(const f32x4*)(W + (size_t)(k0 + kk) * INW + qcol0(nb) + 4 * (lane & 15)) * gain[k0 + kk]; }
#pragma unroll
    for (int i = 0; i < 16; ++i) { const int kk = 4 * i + (lane >> 4); LAS float* d = scr + kk * 65 + 4 * (lane & 15); d[0] = v[i].x; d[1] = v[i].y; d[2] = v[i].z; d[3] = v[i].w; }
    LDS_WAIT(); asm volatile("" ::: "memory");
    const int c = lane & 7;
#pragma unroll
    for (int j = 0; j < 8; ++j) { const int n = (lane >> 3) + 8 * j; const LAS float* s = scr + (8 * c) * 65 + n;
        const float mx = __uint_as_float(cmax[n0 + n]), inv = mx > 0.f ? 127.f / mx : 0.f;
        typedef unsigned u32x2 __attribute__((ext_vector_type(2))); u32x2 o;
        o.x = q8pack4(s[0 * 65] * inv, s[1 * 65] * inv, s[2 * 65] * inv, s[3 * 65] * inv); o.y = q8pack4(s[4 * 65] * inv, s[5 * 65] * inv, s[6 * 65] * inv, s[7 * 65] * inv);
        *(GAS u32x2*)(WQ + (size_t)(n0 + n) * DM + k0 + 8 * c) = o;
        if (kb == 0 && c == 0) cs[n0 + n] = mx * (1.f / 127.f); }
    LDS_WAIT(); asm volatile("" ::: "memory");
}
__device__ __forceinline__ void gate_quant_pass(Frame& F, const float* __restrict__ w_in, const float* __restrict__ g_in, signed char* __restrict__ wq, const unsigned* __restrict__ cmax, float* __restrict__ cs) {
    LAS float* scr = (LAS float*)(F.lds + F.wave * 16640);
    const int gw = F.vcu * NWAVES + F.wave, NGW = F.G * NWAVES;
    for (int it = gw; it < DEPTH * 16 * 80; it += NGW) {
        const int l = it / (16 * 80), kb2 = (it / 80) % 16, nb = it % 80;
        gate_quant_item(w_in + (size_t)l * DM * INW, wq + (size_t)l * NQ * DM, cmax + l * NQ, cs + l * NQ, scr, 2 * kb2, nb, F.lane, g_in + l * DM);
        gate_quant_item(w_in + (size_t)l * DM * INW, wq + (size_t)l * NQ * DM, cmax + l * NQ, cs + l * NQ, scr, 2 * kb2 + 1, nb, F.lane, g_in + l * DM);
    }
}
__device__ __forceinline__ void p0_transposes(Frame& F, CPtrs PPk) {
    struct { const float *w_in, *w_a, *w_b, *w_out, *w_ff1, *w_ff2, *g_in, *g_ff; unsigned char* ws; } P = {PPk->w_in, PPk->w_a, PPk->w_b, PPk->w_out, PPk->w_ff1, PPk->w_ff2, PPk->n_attn_pre, PPk->n_ff_pre, PPk->ws};
    LAS float* scr = (LAS float*)(F.lds + F.wave * 16640);
    const int gw = F.vcu * NWAVES + F.wave, NGW = F.G * NWAVES;
    constexpr int I_IN = 32 * 132, I_A = 16 * 32, I_O = 32 * 32, I_1 = 32 * 128, I_2 = 128 * 32, I_L = I_IN + 2 * I_A + I_O + I_1 + I_2;
    asm volatile("" ::: "memory");
    bf16* ws_in = (bf16*)(P.ws + WS_WIN); bf16* ws_a = (bf16*)(P.ws + WS_WA); bf16* ws_b = (bf16*)(P.ws + WS_WB); bf16* ws_o = (bf16*)(P.ws + WS_WOUT);
    bf16* ws_1 = (bf16*)(P.ws + WS_W1); bf16* ws_2 = (bf16*)(P.ws + WS_W2);
    for (int it = gw; it < DEPTH * I_L; it += NGW) {
        const int l = it / I_L; int r = it % I_L;
        if (r < I_IN) { transpose_item(P.w_in + (size_t)l * DM * INW, DM, INW, ws_in + (size_t)l * INW * DM, scr, r / 132, r % 132, F.lane, P.g_in + l * DM); continue; } r -= I_IN;
        if (r < I_A) { transpose_item(P.w_a + (size_t)l * 1024 * DM, 1024, DM, ws_a + (size_t)l * DM * 1024, scr, r / 32, r % 32, F.lane, nullptr); continue; } r -= I_A;
        if (r < I_A) { transpose_item(P.w_b + (size_t)l * 1024 * DM, 1024, DM, ws_b + (size_t)l * DM * 1024, scr, r / 32, r % 32, F.lane, nullptr); continue; } r -= I_A;
        if (r < I_O) { transpose_item(P.w_out + (size_t)l * DM * DM, DM, DM, ws_o + (size_t)l * DM * DM, scr, r / 32, r % 32, F.lane, nullptr); continue; } r -= I_O;
        if (r < I_1) { transpose_item(P.w_ff1 + (size_t)l * DM * DFF, DM, DFF, ws_1 + (size_t)l * DFF * DM, scr, r / 128, r % 128, F.lane, P.g_ff + l * DM); continue; } r -= I_1;
        transpose_item(P.w_ff2 + (size_t)l * DFF * DM, DFF, DM, ws_2 + (size_t)l * DM * DFF, scr, r / 32, r % 32, F.lane, nullptr);
    }
}

template <bool HAS_T, bool WRITE_U>
__device__ __forceinline__ void norm_phase(Frame& F, const float* hin_real, const float* hin_meta, float* hout_real, float* hout_meta,
                                           const bf16* T, const float* gpost, const float* gpre, bf16* U, int nrows = NROWS) {
    asm volatile("" : "+s"(hin_real), "+s"(hin_meta), "+s"(hout_real), "+s"(hout_meta), "+s"(T), "+s"(U));
    LAS float* gp = (LAS float*)(F.lds); LAS float* gq = gp + 2048;
    for (int i = F.tid; i < 2048; i += NWAVES * 64) { gp[i] = HAS_T ? gpost[i] : 0.f; gq[i] = WRITE_U ? gpre[i] : 0.f; }
    __syncthreads();
    const int gw = F.vcu * NWAVES + F.wave, NGW = F.G * NWAVES;
    for (int row = gw; row < nrows; row += NGW) {
        const bool real = row < ROW_META;
        const float* hr = real ? hin_real + (size_t)row * DM : hin_meta + (size_t)(row - ROW_META) * DM;
        float* ho = real ? (hout_real ? hout_real + (size_t)row * DM : nullptr) : hout_meta + (size_t)(row - ROW_META) * DM;
        f32x4 hv[4][2]; v4u tv[4];
#pragma unroll
        for (int k = 0; k < 4; ++k) { const int ci = F.lane + 64 * k;
            if (HAS_T) tv[k] = *(const GAS v4u*)(T + (size_t)row * DM + 8 * ci);
            hv[k][0] = *(const GAS f32x4*)(hr + 8 * ci); hv[k][1] = *(const GAS f32x4*)(hr + 8 * ci + 4); }
        if (HAS_T) {
            float ss = 0.f; float tf[4][8];
#pragma unroll
            for (int k = 0; k < 4; ++k) {
                tf[k][0] = pg8::bf_lo(tv[k].x); tf[k][1] = pg8::bf_hi(tv[k].x); tf[k][2] = pg8::bf_lo(tv[k].y); tf[k][3] = pg8::bf_hi(tv[k].y);
                tf[k][4] = pg8::bf_lo(tv[k].z); tf[k][5] = pg8::bf_hi(tv[k].z); tf[k][6] = pg8::bf_lo(tv[k].w); tf[k][7] = pg8::bf_hi(tv[k].w);
#pragma unroll
                for (int e = 0; e < 8; ++e) ss += tf[k][e] * tf[k][e]; }
            const float rstd = 1.0f / sqrtf(wave_sum(ss) * (1.f / DM) + EPS);
#pragma unroll
            for (int k = 0; k < 4; ++k) { const int ci = F.lane + 64 * k; const f32x4 g0 = *(const LAS f32x4*)(gp + 8 * ci), g1 = *(const LAS f32x4*)(gp + 8 * ci + 4);
                hv[k][0].x += tf[k][0] * rstd * g0.x; hv[k][0].y += tf[k][1] * rstd * g0.y; hv[k][0].z += tf[k][2] * rstd * g0.z; hv[k][0].w += tf[k][3] * rstd * g0.w;
                hv[k][1].x += tf[k][4] * rstd * g1.x; hv[k][1].y += tf[k][5] * rstd * g1.y; hv[k][1].z += tf[k][6] * rstd * g1.z; hv[k][1].w += tf[k][7] * rstd * g1.w; }
        }
        if (ho) {
#pragma unroll
            for (int k = 0; k < 4; ++k) { const int ci = F.lane + 64 * k; *(GAS f32x4*)(ho + 8 * ci) = hv[k][0]; *(GAS f32x4*)(ho + 8 * ci + 4) = hv[k][1]; }
        }
        if (WRITE_U) {
            float ss = 0.f;
#pragma unroll
            for (int k = 0; k < 4; ++k) ss += (hv[k][0].x * hv[k][0].x + hv[k][0].y * hv[k][0].y) + (hv[k][0].z * hv[k][0].z + hv[k][0].w * hv[k][0].w)
                                            + (hv[k][1].x * hv[k][1].x + hv[k][1].y * hv[k][1].y) + (hv[k][1].z * hv[k][1].z + hv[k][1].w * hv[k][1].w);
            const float rstd = 1.0f / sqrtf(wave_sum(ss) * (1.f / DM) + EPS);
#pragma unroll
            for (int k = 0; k < 4; ++k) { const int ci = F.lane + 64 * k; const f32x4 g0 = *(const LAS f32x4*)(gq + 8 * ci), g1 = *(const LAS f32x4*)(gq + 8 * ci + 4);
                v4u o; o.x = pk2(hv[k][0].x * rstd * g0.x, hv[k][0].y * rstd * g0.y); o.y = pk2(hv[k][0].z * rstd * g0.z, hv[k][0].w * rstd * g0.w);
                o.z = pk2(hv[k][1].x * rstd * g1.x, hv[k][1].y * rstd * g1.y); o.w = pk2(hv[k][1].z * rstd * g1.z, hv[k][1].w * rstd * g1.w);
                *(GAS v4u*)(U + (size_t)row * DM + 8 * ci) = o; }
        }
    }
    __syncthreads();
}


template <int MODE>
__device__ __forceinline__ void resid_phase(Frame& F, const float* x, const float* meta, bf16* H, float* RS, const bf16* T, const float* gpost, float* out, signed char* HQ = nullptr, float* QS = nullptr) {
    asm volatile("" : "+s"(x), "+s"(meta), "+s"(H), "+s"(RS), "+s"(T), "+s"(out));
    LAS float* gp = (LAS float*)(F.lds);
    if (MODE != 0) { for (int i = F.tid; i < 2048; i += NWAVES * 64) gp[i] = gpost[i]; }
    __syncthreads();
    const int gw = F.vcu * NWAVES + F.wave, NGW = F.G * NWAVES;
    const int nrows = (MODE == 2) ? ROW_META : NROWS;
    for (int row = gw; row < nrows; row += NGW) {
        f32x4 hv[4][2];
        if (MODE == 0) {
            const float* hr = row < ROW_META ? x + (size_t)row * DM : meta + (size_t)(row - ROW_META) * DM;
#pragma unroll
            for (int k = 0; k < 4; ++k) { const int ci = F.lane + 64 * k; hv[k][0] = *(const GAS f32x4*)(hr + 8 * ci); hv[k][1] = *(const GAS f32x4*)(hr + 8 * ci + 4); }
        } else {
            v4u tv[4], hb[4];
#pragma unroll
            for (int k = 0; k < 4; ++k) { const int ci = F.lane + 64 * k; tv[k] = *(const GAS v4u*)(T + (size_t)row * DM + 8 * ci); hb[k] = *(const GAS v4u*)(H + (size_t)row * DM + 8 * ci); }
            float ss = 0.f; float tf[4][8];
#pragma unroll
            for (int k = 0; k < 4; ++k) {
                tf[k][0] = pg8::bf_lo(tv[k].x); tf[k][1] = pg8::bf_hi(tv[k].x); tf[k][2] = pg8::bf_lo(tv[k].y); tf[k][3] = pg8::bf_hi(tv[k].y);
                tf[k][4] = pg8::bf_lo(tv[k].z); tf[k][5] = pg8::bf_hi(tv[k].z); tf[k][6] = pg8::bf_lo(tv[k].w); tf[k][7] = pg8::bf_hi(tv[k].w);
#pragma unroll
                for (int e = 0; e < 8; ++e) ss += tf[k][e] * tf[k][e]; }
            const float rstd = 1.0f / sqrtf(wave_sum(ss) * (1.f / DM) + EPS);
#pragma unroll
            for (int k = 0; k < 4; ++k) { const int ci = F.lane + 64 * k; const f32x4 g0 = *(const LAS f32x4*)(gp + 8 * ci), g1 = *(const LAS f32x4*)(gp + 8 * ci + 4);
                hv[k][0].x = pg8::bf_lo(hb[k].x) + tf[k][0] * rstd * g0.x; hv[k][0].y = pg8::bf_hi(hb[k].x) + tf[k][1] * rstd * g0.y; hv[k][0].z = pg8::bf_lo(hb[k].y) + tf[k][2] * rstd * g0.z; hv[k][0].w = pg8::bf_hi(hb[k].y) + tf[k][3] * rstd * g0.w;
                hv[k][1].x = pg8::bf_lo(hb[k].z) + tf[k][4] * rstd * g1.x; hv[k][1].y = pg8::bf_hi(hb[k].z) + tf[k][5] * rstd * g1.y; hv[k][1].z = pg8::bf_lo(hb[k].w) + tf[k][6] * rstd * g1.z; hv[k][1].w = pg8::bf_hi(hb[k].w) + tf[k][7] * rstd * g1.w; }
        }
        if (MODE == 2) {
            float* ho = out + (size_t)row * DM;
#pragma unroll
            for (int k = 0; k < 4; ++k) { const int ci = F.lane + 64 * k; *(GAS f32x4*)(ho + 8 * ci) = hv[k][0]; *(GAS f32x4*)(ho + 8 * ci + 4) = hv[k][1]; }
        } else {
            float ss = 0.f;
#pragma unroll
            for (int k = 0; k < 4; ++k) ss += (hv[k][0].x * hv[k][0].x + hv[k][0].y * hv[k][0].y) + (hv[k][0].z * hv[k][0].z + hv[k][0].w * hv[k][0].w)
                                            + (hv[k][1].x * hv[k][1].x + hv[k][1].y * hv[k][1].y) + (hv[k][1].z * hv[k][1].z + hv[k][1].w * hv[k][1].w);
            const float rstd = 1.0f / sqrtf(wave_sum(ss) * (1.f / DM) + EPS);
            if (F.lane == 0) RS[row] = rstd;
            if (HQ) {
                float am = 0.f;
#pragma unroll
                for (int k = 0; k < 4; ++k) am = fmaxf(fmaxf(fmaxf(am, fmaxf(fabsf(hv[k][0].x), fabsf(hv[k][0].y))), fmaxf(fabsf(hv[k][0].z), fabsf(hv[k][0].w))), fmaxf(fmaxf(fabsf(hv[k][1].x), fabsf(hv[k][1].y)), fmaxf(fabsf(hv[k][1].z), fabsf(hv[k][1].w))));
                am = wave_max(am);
                const float inv = am > 0.f ? 127.f / am : 0.f;
                if (F.lane == 0) QS[row] = rstd * am * (1.f / 127.f);
#pragma unroll
                for (int k = 0; k < 4; ++k) { const int ci = F.lane + 64 * k; typedef unsigned u32x2 __attribute__((ext_vector_type(2))); u32x2 o;
                    o.x = q8pack4(hv[k][0].x * inv, hv[k][0].y * inv, hv[k][0].z * inv, hv[k][0].w * inv); o.y = q8pack4(hv[k][1].x * inv, hv[k][1].y * inv, hv[k][1].z * inv, hv[k][1].w * inv);
                    *(GAS u32x2*)(HQ + (size_t)row * DM + 8 * ci) = o; }
            }
#pragma unroll
            for (int k = 0; k < 4; ++k) { const int ci = F.lane + 64 * k;
                v4u o; o.x = pk2(hv[k][0].x, hv[k][0].y); o.y = pk2(hv[k][0].z, hv[k][0].w); o.z = pk2(hv[k][1].x, hv[k][1].y); o.w = pk2(hv[k][1].z, hv[k][1].w);
                *(GAS v4u*)(H + (size_t)row * DM + 8 * ci) = o; }
        }
    }
    __syncthreads();
}

template <class Epi>
__device__ __forceinline__ void meta_gemm(LAS unsigned char* lds, const bf16* A, int lda, const bf16* Bt, int ldb, int N, int K, int vcu, int G, int tid, const Epi& E) {
    const int lane = tid & 63, w = __builtin_amdgcn_readfirstlane(tid >> 6), fr = lane & 15, fq = lane >> 4;
    const int kw = K >> 3;
    LAS f32x4* part = (LAS f32x4*)lds;
    for (int tile = vcu; tile < (N >> 4); tile += G) {
        const bf16* ap = A + (size_t)fr * lda + w * kw + 8 * fq;
        const bf16* bp = Bt + (size_t)(tile * 16 + fr) * ldb + w * kw + 8 * fq;
        f32x4 acc = (f32x4){0.f, 0.f, 0.f, 0.f};
        for (int k = 0; k < kw; k += 128) {
            bf16x8 a[4], b[4];
#pragma unroll
            for (int j = 0; j < 4; ++j) { a[j] = *(const GAS bf16x8*)(ap + k + 32 * j); b[j] = *(const GAS bf16x8*)(bp + k + 32 * j); }
#pragma unroll
            for (int j = 0; j < 4; ++j) acc = __builtin_amdgcn_mfma_f32_16x16x32_bf16(b[j], a[j], acc, 0, 0, 0);
        }
        part[w * 64 + lane] = acc;
        __syncthreads();
        if (w == 0) { f32x4 s = part[lane];
#pragma unroll
            for (int j = 1; j < 8; ++j) s += part[j * 64 + lane];
            E(fr, tile * 16 + 4 * fq, s); }
        __syncthreads();
    }
}
__device__ __forceinline__ void st4bf(bf16* p, f32x4 v) { typedef unsigned u32x2 __attribute__((ext_vector_type(2))); u32x2 o; o.x = pk2(v.x, v.y); o.y = pk2(v.z, v.w); *(GAS u32x2*)p = o; }
__device__ __forceinline__ f32x4 ld4bf(const bf16* p) { typedef unsigned u32x2 __attribute__((ext_vector_type(2))); const u32x2 u = *(const GAS u32x2*)p; return (f32x4){pg8::bf_lo(u.x), pg8::bf_hi(u.x), pg8::bf_lo(u.y), pg8::bf_hi(u.y)}; }
struct MEpiZ { bf16* Z; const float* rs; __device__ __forceinline__ void operator()(int r, int c, f32x4 v) const {
    v = v * rs[ROW_META + r];
    if (c < 1024 || (c >= 3072 && c < 4096)) v = v * QSCALE;
    else if (c >= C_GA) { v.x = pg8::sigmoidf_fast(v.x); v.y = pg8::sigmoidf_fast(v.y); v.z = pg8::sigmoidf_fast(v.z); v.w = pg8::sigmoidf_fast(v.w); }
    st4bf(Z + (size_t)(ROW_META + r) * INW + c, v); } };
template <int ACT> struct MEpiPlain { bf16* O; int ldc; const float* rs; __device__ __forceinline__ void operator()(int r, int c, f32x4 v) const {
    if (ACT == 1) { v = v * rs[ROW_META + r]; v.x = fmaxf(v.x, 0.f); v.y = fmaxf(v.y, 0.f); v.z = fmaxf(v.z, 0.f); v.w = fmaxf(v.w, 0.f); v = v * v; }
    st4bf(O + (size_t)(ROW_META + r) * ldc + c, v); } };
template <bool ADD_PREV> struct MEpiGate { bf16* O; const bf16* Gt; const bf16* Pv; __device__ __forceinline__ void operator()(int r, int c, f32x4 v) const {
    const size_t row = (size_t)(ROW_META + r); v = v * ld4bf(Gt + row * INW + c);
    if (ADD_PREV) v = v + ld4bf(Pv + row * DM + c);
    st4bf(O + row * DM + c, v); } };

__device__ __forceinline__ int t5_bucket(int dist) {
    const int n = dist < 0 ? 0 : dist;
    if (n < 16) return n;
    int large = 16 + (int)(logf((float)n * (1.f / 16.f)) / 2.0794415416798357f * 16.f);
    return large > 31 ? 31 : large;
}

constexpr int LUTN_G = 448, N_LUT_TABLES = 40;
__device__ __forceinline__ void build_lut_tables(Frame& F, const float* __restrict__ relb, float* __restrict__ lutg) {
    for (int i = F.vcu * NWAVES * 64 + F.tid; i < N_LUT_TABLES * LUTN_G; i += F.G * NWAVES * 64) {
        const int tb = i / LUTN_G, d = 255 - (i % LUTN_G); float v;
        if (tb < 8) { if (d < 0) v = NEGBIG; else if (d < 128) v = (relb[t5_bucket(d) * NBIAS + tb] - relb[31 * NBIAS + tb]) * LOG2E; else v = 0.f; }
        else { const int col = 8 + ((tb - 8) >> 1), kind = (tb - 8) & 1;
            if (d < 0) v = NEGBIG; else if (d < 128) v = relb[t5_bucket(d) * NBIAS + col] * LOG2E; else v = kind ? relb[31 * NBIAS + col] * LOG2E : NEGBIG; }
        lutg[i] = v;
    }
}

#if ATTN_NAIVE
template <bool DIFF>
__global__ void __launch_bounds__(512) naive_attn(const bf16* __restrict__ Z, bf16* __restrict__ YAB, const float* __restrict__ relb, const float* lq1, const float* lk1, const float* lq2, const float* lk2,
                                                   const float* __restrict__ dnorm, const float* __restrict__ sinks, int layer) {
    constexpr int KT = 16, DVT = DIFF ? 64 : 32, KW = DIFF ? 128 : 64, VW = DIFF ? 128 : 64;
    extern __shared__ __attribute__((aligned(16))) unsigned char smem[];
    float* Ksh = (float*)smem;
    float* Vsh = Ksh + 32 * 128;
    float* biasL = Vsh + 32 * 128;
    int* kposs = (int*)(biasL + 2 * 132);
    float* red = (float*)(kposs + 64);
    float* Osh = red + 8;
    const int tid = threadIdx.x, row = tid & 127, cj = (tid >> 7) & 1, dvh = tid >> 8;
    const int unit = blockIdx.x, hh = unit / 129, qb = unit % 129;
    const bool metablk = (qb == 128);
    const int qrow = metablk ? ROW_META + row : 128 * qb + row;
    const int qpos = metablk ? 112 + row : 128 + 128 * qb + row;
    float lam = 0.f, lam_init = 0.f;
    if (DIFF) {
        lam_init = 0.8f - 0.6f * expf(-0.3f * (float)layer);
        if (tid < 64) { float a = lq1[layer * 64 + tid] * lk1[layer * 64 + tid], b = lq2[layer * 64 + tid] * lk2[layer * 64 + tid];
#pragma unroll
            for (int o = 1; o < 64; o <<= 1) { a += __shfl_xor(a, o); b += __shfl_xor(b, o); }
            if (tid == 0) { red[0] = a; red[1] = b; } }
    }
    for (int i = tid; i < 2 * 129; i += 512) { const int j = i / 129, d = i % 129; const int col = DIFF ? hh : 8 + 2 * hh + j; biasL[j * 132 + d] = relb[t5_bucket(d) * NBIAS + col] * LOG2E; }
    __syncthreads();
    if (DIFF) lam = expf(red[0]) - expf(red[1]) + lam_init;
    const int qcol = DIFF ? C_QA + hh * 128 + cj * 64 : C_QB + (2 * hh + cj) * 64;
    const int kcol = DIFF ? C_KA + hh * 128 : C_KB + (hh >> 2) * 64;
    const int vcol = DIFF ? C_VA + hh * 128 : C_VB + (hh >> 2) * 64;
    float q[64];
    { const bf16* qp = Z + (size_t)qrow * INW + qcol;
#pragma unroll
      for (int i = 0; i < 64; ++i) q[i] = pg8::bf_lo((unsigned)qp[i]); }
    float o[DVT];
#pragma unroll
    for (int i = 0; i < DVT; ++i) o[i] = 0.f;
    float m = NEGBIG, l = 0.f;
    if (!DIFF) { m = sinks[layer * 16 + 2 * hh + cj] * LOG2E; l = 1.f; }
    const int t_s = DIFF ? 0 : (qb >= 1 && !metablk ? 128 * (qb - 1) : 0);
    const int nreal = metablk ? 0 : 128 * qb + 128 - t_s;
    const int ns = 16 + nreal;
    const float* bl = biasL + (DIFF ? 0 : cj) * 132;
    for (int s0 = 0; s0 < ns; s0 += KT) {
        __syncthreads();
        for (int i = tid; i < KT * KW; i += 512) { const int kk = i / KW, c = i % KW, s = s0 + kk; float v = 0.f;
            if (s < ns) { const int krow = s < 16 ? ROW_META + s : t_s + s - 16; v = pg8::bf_lo((unsigned)Z[(size_t)krow * INW + kcol + c]); } Ksh[kk * 128 + c] = v; }
        for (int i = tid; i < KT * VW; i += 512) { const int kk = i / VW, c = i % VW, s = s0 + kk; float v = 0.f;
            if (s < ns) { const int krow = s < 16 ? ROW_META + s : t_s + s - 16; v = pg8::bf_lo((unsigned)Z[(size_t)krow * INW + vcol + c]); } Vsh[kk * 128 + c] = v; }
        if (tid < KT) { const int s = s0 + tid; kposs[tid] = s >= ns ? (1 << 30) : (s < 16 ? 112 + s : 128 + t_s + s - 16); kposs[32 + tid] = (s < 16) ? 1 : 0; }
        __syncthreads();
        float sc[KT]; float tmax = NEGBIG;
#pragma unroll
        for (int kk = 0; kk < KT; ++kk) {
            const float* kr = Ksh + kk * 128 + (DIFF ? cj * 64 : 0); float a = 0.f;
#pragma unroll
            for (int i = 0; i < 64; ++i) a += q[i] * kr[i];
            const int dist = qpos - kposs[kk]; const bool ismeta = kposs[32 + kk] != 0;
            bool ok = dist >= 0; if (!DIFF && !ismeta) ok = ok && dist < 128;
            const int di = dist < 0 ? 0 : (dist > 128 ? 128 : dist);
            a = ok ? a + bl[di] : NEGBIG;
            sc[kk] = a; tmax = fmaxf(tmax, a);
        }
        const float mn = fmaxf(m, tmax), alpha = exp2f(m - mn);
        l *= alpha;
#pragma unroll
        for (int i = 0; i < DVT; ++i) o[i] *= alpha;
        m = mn;
#pragma unroll
        for (int kk = 0; kk < KT; ++kk) {
            const float p = sc[kk] > -1e29f ? exp2f(sc[kk] - m) : 0.f;
            l += p; const float* vr = Vsh + kk * 128 + dvh * DVT;
#pragma unroll
            for (int i = 0; i < DVT; ++i) o[i] += p * vr[i];
        }
    }
    const float rl = 1.f / l;
    if (DIFF) {
        __syncthreads();
        if (cj == 1) {
#pragma unroll
            for (int i = 0; i < DVT; ++i) Osh[row * 129 + dvh * 64 + i] = lam * o[i] * rl; }
        __syncthreads();
        if (cj == 0) {
#pragma unroll
            for (int i = 0; i < DVT; ++i) Osh[row * 129 + dvh * 64 + i] = o[i] * rl - Osh[row * 129 + dvh * 64 + i]; }
        __syncthreads();
        if (tid < 128 && (!metablk || tid < 16)) {
            float ss = 0.f;
            for (int d = 0; d < 128; ++d) { const float v = Osh[tid * 129 + d]; ss += v * v; }
            const float rstd = 1.0f / sqrtf(ss * (1.f / 128.f) + EPS) * (1.f - lam_init);
            const int orow = metablk ? ROW_META + tid : 128 * qb + tid;
            for (int d = 0; d < 128; ++d) YAB[(size_t)orow * DM + hh * 128 + d] = (bf16)f2bf(Osh[tid * 129 + d] * rstd * dnorm[layer * 128 + d]);
        }
    } else {
        if (!metablk || row < 16) {
#pragma unroll
            for (int i = 0; i < DVT; ++i) YAB[(size_t)qrow * DM + 1024 + (2 * hh + cj) * 64 + dvh * 32 + i] = (bf16)f2bf(o[i] * rl); }
    }
}
constexpr int NAIVE_LDS = (32 * 128 * 2 + 2 * 132 + 64 + 8 + 128 * 129) * 4;
#endif

namespace att {
typedef float f32x16 __attribute__((ext_vector_type(16)));
typedef short s16x4 __attribute__((ext_vector_type(4)));
typedef short v4i16_t __attribute__((ext_vector_type(4)));
constexpr int LUTN = 448;
constexpr int SLOT = 16384, CK = 8704, KSLOT = 2 * CK, L_K = 0, L_V = 3 * KSLOT, L_LUT = L_V + 3 * SLOT, L_WSF = L_LUT + 4 * LUTN * 4, L_SUBG = L_WSF + 8 * 256, L_END = L_SUBG + 512;
static_assert(L_END <= RING_BYTES, "attention LDS");
constexpr int XD_STRIDE = 132, XS_STRIDE = 68;
constexpr float THR = 30.0f;
__device__ __forceinline__ int crow(int r, int hi) { return (r & 3) + 8 * (r >> 2) + 4 * hi; }
__device__ __forceinline__ void glds16(const void* gsrc, unsigned lds_dst) { unsigned keep;
    asm volatile("s_mov_b32 %0, m0\n\ts_mov_b32 m0, %2\n\ts_nop 0\n\tglobal_load_lds_dwordx4 %1, off\n\ts_mov_b32 m0, %0" : "=&s"(keep) : "v"(gsrc), "s"(lds_dst) : "memory"); }
template <int IMM> __device__ __forceinline__ void glds16s(const void* sbase, unsigned voff, unsigned lds_dst_) { const unsigned lds_dst = lds_dst_ - (unsigned)IMM;
    asm volatile("s_mov_b32 m0, %2\n\ts_nop 0\n\tglobal_load_lds_dwordx4 %0, %1 offset:%c3" :: "v"(voff), "s"(sbase), "s"(lds_dst), "i"(IMM) : "memory", "m0"); }
__device__ __forceinline__ unsigned cvtpk(float lo, float hi) { typedef float f2 __attribute__((ext_vector_type(2))); typedef __bf16 b2 __attribute__((ext_vector_type(2))); f2 v = {lo, hi}; b2 b = __builtin_convertvector(v, b2); return __builtin_bit_cast(unsigned, b); }
__device__ __forceinline__ s16x4 vtr(const LAS unsigned char* p) { return __builtin_bit_cast(s16x4, __builtin_amdgcn_ds_read_tr16_b64_v4i16((LAS v4i16_t*)p)); }
__device__ __forceinline__ float swap_add(float v) { auto rr = __builtin_amdgcn_permlane32_swap(__float_as_uint(v), __float_as_uint(v), false, false); return __uint_as_float(rr[0]) + __uint_as_float(rr[1]); }
__device__ __forceinline__ float swap_max(float v) { auto rr = __builtin_amdgcn_permlane32_swap(__float_as_uint(v), __float_as_uint(v), false, false); return fmaxf(__uint_as_float(rr[0]), __uint_as_float(rr[1])); }
#define ATT_MFMA(a, b, c) __builtin_amdgcn_mfma_f32_32x32x16_bf16(a, b, c, 0, 0, 0)

template <bool DIFF>
__device__ __forceinline__ void attn_epilogue(LAS unsigned char* lds, bf16* __restrict__ YAB, f32x16 (&o)[DIFF ? 4 : 2], float lsum, int tid, int hh, int qb, float lam, float lam_scale);
template <bool DIFF, bool FAST>
__device__ __forceinline__ bool attn_body(LAS unsigned char* lds, const bf16* __restrict__ Z, bf16* __restrict__ YAB, const float* __restrict__ lutg,
                                          int hh, int qb, float lam, float lam_scale, float sink2, int tid_in, unsigned useq) {
    constexpr int NDB = DIFF ? 4 : 2;
    constexpr bool fast = FAST;
    int tid = tid_in; asm volatile("" : "+v"(tid));
    const int lane = tid & 63, w = __builtin_amdgcn_readfirstlane(tid >> 6), cj = w >> 2, wq = w & 3, l31 = lane & 31, hi = lane >> 5;
    const bool metablk = (qb == 128);
    const int qrow = (metablk ? ROW_META : 128 * qb) + 32 * wq + l31;
    const int qpos = (metablk ? 112 : 128 + 128 * qb) + 32 * wq + l31;
    const int qcol = DIFF ? C_QA + hh * 128 + cj * 64 : C_QB + (2 * hh + cj) * 64;
    const int kcol = DIFF ? C_KA + hh * 128 : C_KB + (hh >> 2) * 64;
    const int vcol = DIFF ? C_VA + hh * 128 : C_VB + (hh >> 2) * 64;
    const int rt0 = DIFF ? 0 : (2 * qb - 2 > 0 ? 2 * qb - 2 : 0);
    const int nreal = metablk ? 0 : 2 * qb + 2 - rt0;
    const int NT = 1 + nreal;
    const int rt_special = 2 * qb - 2;
    LAS float* LUT = (LAS float*)(lds + L_LUT);
    if (DIFF) { if (tid < LUTN) LUT[tid] = lutg[hh * LUTN + tid]; }
    else { for (int i = tid; i < 4 * LUTN; i += NWAVES * 64) { const int k = i / LUTN, e = i % LUTN; LUT[i] = lutg[(8 + 2 * (2 * hh + (k & 1)) + (k >> 1)) * LUTN + e]; } }
    const unsigned lds0 = (unsigned)(uintptr_t)lds;
    auto tile_row0 = [&](int t) { return t == 0 ? ROW_META : 64 * (rt0 + t - 1); };
    const unsigned koff = (unsigned)(((8 * w + (lane >> 3)) * INW + kcol + ((lane & 7) ^ (lane >> 3)) * 8) * 2);
    const unsigned voff = (unsigned)(((8 * w + ((lane >> 2) & 7)) * INW + vcol + (lane >> 5) * 32 + (lane & 3) * 8) * 2);
    const unsigned kgb = (unsigned)(w * 1024 + 128 * ((w >> 1) & 1) + 256 * (w >> 2));
    auto dma_k = [&](int t, int sl) {
        const char* zb = (const char*)Z + (size_t)tile_row0(t) * (INW * 2);
        const unsigned dst = (unsigned)__builtin_amdgcn_readfirstlane(lds0 + L_K + sl + (sl >> 4) + kgb);
        glds16s<0>(zb, koff, dst);
        if (DIFF) glds16s<128>(zb, koff, dst + CK);
    };
    auto dma_v = [&](int t, int sl) {
        const char* zb = (const char*)Z + (size_t)tile_row0(t) * (INW * 2);
        const unsigned dst = (unsigned)__builtin_amdgcn_readfirstlane(lds0 + L_V + sl + w * 2048);
        glds16s<0>(zb, voff, dst);
        if (DIFF) glds16s<128>(zb, voff, dst + 1024);
    };
    bf16x8 qr[4];
#pragma unroll
    for (int d0 = 0; d0 < 4; ++d0) qr[d0] = *(const bf16x8*)(Z + (size_t)qrow * INW + qcol + d0 * 16 + hi * 8);
    dma_k(0, 0); dma_v(0, 0); if (NT > 1) dma_k(1, SLOT); if (NT > 2) dma_k(2, 2 * SLOT);
    bool mz = fast || DIFF || (fabsf(sink2) <= THR);
    float m = mz ? 0.f : sink2, lsum = (!DIFF && hi == 0) ? (mz ? __builtin_amdgcn_exp2f(sink2) : 1.f) : 0.f;
    f32x16 o[NDB];
#pragma unroll
    for (int db = 0; db < NDB; ++db) o[db] = f32x16{};
    float nm = -m;
    LAS float* wsf = (LAS float*)(lds + L_WSF) + w * 64;
    const int kr_ = l31 & 7, kg_ = l31 >> 3, kt_ = kr_ ^ hi;
    const LAS unsigned char* kp0 = lds + L_K + (DIFF ? cj * CK : 0) + kg_ * 1024 + 128 * ((kg_ >> 1) & 1) + 128 * kr_;
    const int kx0 = 16 * (0 ^ kt_), kx1 = 16 * (2 ^ kt_), kx2 = 16 * (4 ^ kt_), kx3 = 16 * (6 ^ kt_);
    const LAS unsigned char* vp0 = lds + L_V + ((lane >> 4) & 1) * 32 + (lane & 3) * 8 + (4 * hi + ((lane & 15) >> 2)) * 64;
    bf16x8 kf[8];
    f32x16 pA0, pA1, pB0, pB1;
    v4u pw0, pw1, pw2, pw3;
    bool resc = false;
    int sl_prev = 0, sl_cur = 0, sl_next = SLOT;
#define ATT_SBAR() __builtin_amdgcn_sched_barrier(0)
#define ATT_PIN(x) asm volatile("" : "+v"(x))
#define ATT_ROT() do { sl_prev = sl_cur; sl_cur = sl_next; sl_next = (sl_next == 2 * SLOT) ? 0 : sl_next + SLOT; } while (0)
#define ATT_WAITBAR(N) asm volatile("s_waitcnt vmcnt(" #N ") lgkmcnt(0)\n\ts_barrier" ::: "memory")
#define ATT_KLD2(kp, j) do { kf[2 * (j)] = *(const LAS bf16x8*)((kp) + kx##j); kf[2 * (j) + 1] = *(const LAS bf16x8*)((kp) + kx##j + 4352); } while (0)
#define ATT_SPECIAL(C0, C1, t) do { const int rt_ = rt0 + (t) - 1; \
        if ((t) == 0) { const LAS float* lut_ = DIFF ? LUT : LUT + (2 + cj) * LUTN; const int base_ = 255 - (qpos - 112 - 4 * hi); \
            _Pragma("unroll") for (int r = 0; r < 16; ++r) { \
                if (r < 8) { int idx_ = base_ + ((r & 3) + 8 * (r >> 2)); idx_ = idx_ < 0 ? 0 : (idx_ > LUTN - 1 ? LUTN - 1 : idx_); C0[r] += lut_[idx_]; } else C0[r] = nb_; \
                C1[r] = nb_; } } \
        else if (!DIFF || rt_ >= rt_special) { int base_ = 255 - (qpos - (128 + 64 * rt_) - 4 * hi); base_ = base_ < 0 ? 0 : (base_ > LUTN - 96 ? LUTN - 96 : base_); \
            const LAS float* lut_ = (DIFF ? LUT : LUT + cj * LUTN) + base_; \
            _Pragma("unroll") for (int r = 0; r < 16; ++r) { C0[r] += lut_[(r & 3) + 8 * (r >> 2)]; C1[r] += lut_[(r & 3) + 8 * (r >> 2) + 32]; } } } while (0)
#define ATT_ROWMAX(C0, C1, rm) do { float a_ = fmaxf(fmaxf(C0[0], C0[1]), C1[0]), b_ = fmaxf(fmaxf(C0[2], C0[3]), C1[1]); a_ = fmaxf(fmaxf(a_, C1[2]), C1[3]); \
        _Pragma("unroll") for (int r = 4; r < 16; r += 4) { a_ = fmaxf(fmaxf(a_, C0[r]), C0[r + 1]); b_ = fmaxf(fmaxf(b_, C0[r + 2]), C0[r + 3]); a_ = fmaxf(fmaxf(a_, C1[r]), C1[r + 1]); b_ = fmaxf(fmaxf(b_, C1[r + 2]), C1[r + 3]); } \
        rm = swap_max(fmaxf(a_, b_)); } while (0)
#define ATT_RESC() do { if (resc) { asm volatile("s_waitcnt lgkmcnt(0)" ::: "memory"); \
        _Pragma("unroll") for (int g = 0; g < 4; ++g) { const f32x4 fv_ = *(const LAS f32x4*)(wsf + 8 * g + 4 * hi); \
            _Pragma("unroll") for (int db = 0; db < NDB; ++db) { o[db][4 * g + 0] *= fv_.x; o[db][4 * g + 1] *= fv_.y; o[db][4 * g + 2] *= fv_.z; o[db][4 * g + 3] *= fv_.w; } } } } while (0)
#define ATT_PK(P, B) cvtpk(P[B], P[(B) + 1])
#define ATT_PAF(k) __builtin_bit_cast(bf16x8, pw##k)
    float nb_ = NEGBIG; asm volatile("" : "+v"(nb_));
    asm volatile("s_waitcnt vmcnt(0)" ::: "memory");
    asm volatile("s_waitcnt lgkmcnt(0)\n\ts_barrier" ::: "memory");
    {
        const LAS unsigned char* kp = kp0;
        ATT_KLD2(kp, 0); ATT_KLD2(kp, 1); ATT_KLD2(kp, 2); ATT_KLD2(kp, 3);
        if (mz) { pA0 = ATT_MFMA(kf[0], qr[0], f32x16{}); pA1 = ATT_MFMA(kf[1], qr[0], f32x16{}); }
        else {
#pragma unroll
            for (int r = 0; r < 16; ++r) { pA0[r] = nm; pA1[r] = nm; }
            pA0 = ATT_MFMA(kf[0], qr[0], pA0); pA1 = ATT_MFMA(kf[1], qr[0], pA1); }
#pragma unroll
        for (int d0 = 1; d0 < 4; ++d0) { pA0 = ATT_MFMA(kf[2 * d0], qr[d0], pA0); pA1 = ATT_MFMA(kf[2 * d0 + 1], qr[d0], pA1); }
        asm volatile("s_waitcnt lgkmcnt(0)\n\ts_barrier" ::: "memory");
        if (3 < NT) dma_k(3, 0);
        if (1 < NT) dma_v(1, SLOT);
        ATT_SPECIAL(pA0, pA1, 0);
        float rm = 0.f; if (!fast) ATT_ROWMAX(pA0, pA1, rm);
        if (!fast && __any(rm > THR || (DIFF && rm < -THR))) {
            const float dl = DIFF ? rm : fmaxf(rm, 0.f);
            m += dl; mz = false;
#pragma unroll
            for (int r = 0; r < 16; ++r) { pA0[r] -= dl; pA1[r] -= dl; }
            nm = -m;
            if (!DIFF) lsum *= __builtin_amdgcn_exp2f(-dl);
        }
#pragma unroll
        for (int r = 0; r < 16; ++r) { pA0[r] = __builtin_amdgcn_exp2f(pA0[r]); pA1[r] = __builtin_amdgcn_exp2f(pA1[r]); }
        if (1 < NT) { const LAS unsigned char* kn = kp0 + KSLOT; ATT_KLD2(kn, 0); ATT_KLD2(kn, 1); ATT_KLD2(kn, 2); ATT_KLD2(kn, 3); }
        if (3 < NT) { if (DIFF) ATT_WAITBAR(4); else ATT_WAITBAR(2); } else if (1 < NT) { if (DIFF) ATT_WAITBAR(2); else ATT_WAITBAR(1); } else ATT_WAITBAR(0);
        ATT_ROT();
    }
#define ATT_GAPA(MF, A0, A1, A2, A3, W0, W1, PW) do { MF; sacc += A0; sacc += A1; sacc += A2; sacc += A3; ATT_PIN(sacc); W0; W1; ATT_PIN(PW); ATT_SBAR(); } while (0)
#define ATT_VRD(i, off) do { vlo##i = vtr(vp_ + (off)); vhi##i = vtr(vp_ + (off) + 2048); } while (0)
#define ATT_VFR(i) (bf16x8){vlo##i[0], vlo##i[1], vlo##i[2], vlo##i[3], vhi##i[0], vhi##i[1], vhi##i[2], vhi##i[3]}
#define ATT_EX2(X, B) do { X[B] = __builtin_amdgcn_exp2f(X[B]); X[(B) + 1] = __builtin_amdgcn_exp2f(X[(B) + 1]); } while (0)
#define ATT_EXF(C0, C1, f) do { if ((f) < 16) C0[(f) & 15] = __builtin_amdgcn_exp2f(C0[(f) & 15]); else C1[(f) & 15] = __builtin_amdgcn_exp2f(C1[(f) & 15]); } while (0)
#define ATT_EX4(X, B) do { ATT_EX2(X, B); ATT_EX2(X, (B) + 2); } while (0)
#define ATT_VOFF(j) (DIFF ? ((4 * ((j) >> 2) + (((j) & 3) >> 1)) * 1024 + ((j) & 1) * 512) : (4 * ((j) >> 1) * 1024 + ((j) & 1) * 512))
#define ATT_PVD(j, R, RN, PWK, X, B) do { if ((j) + 3 < 16) ATT_VRD(RN, ATT_VOFF((j) + 3)); ATT_SBAR(); o[(j) & 3] = ATT_MFMA(ATT_PAF(PWK), ATT_VFR(R), o[(j) & 3]); ATT_EX2(X, B); ATT_PIN(X); ATT_SBAR(); } while (0)
#define ATT_PVS(j, R, RN, PWK, X, B) do { if ((j) + 3 < 8) ATT_VRD(RN, ATT_VOFF((j) + 3)); ATT_SBAR(); o[(j) & 1] = ATT_MFMA(ATT_PAF(PWK), ATT_VFR(R), o[(j) & 1]); ATT_EX4(X, B); ATT_PIN(X); ATT_SBAR(); } while (0)
#define ATT_KRD(G, j) do { if (G) { ATT_KLD2(kn_, j); ATT_SBAR(); } } while (0)
#define ATT_STEP(C0, C1, P0, P1, t, GK, GV) do { ATT_SBAR(); \
        const bool gk_ = (GK), gv_ = (GV); \
        float sacc = P0[0] + P0[1]; \
        if (mz) { C0 = ATT_MFMA(kf[0], qr[0], f32x16{}); C1 = ATT_MFMA(kf[1], qr[0], f32x16{}); } \
        else { _Pragma("unroll") for (int r = 0; r < 16; ++r) { C0[r] = nm; C1[r] = nm; } C0 = ATT_MFMA(kf[0], qr[0], C0); C1 = ATT_MFMA(kf[1], qr[0], C1); } \
        ATT_SBAR(); \
        ATT_GAPA((void)0, P0[2], P0[3], P0[4], P0[5],     pw0[0] = ATT_PK(P0, 0),  pw0[1] = ATT_PK(P0, 2),  pw0); \
        ATT_GAPA((void)0, P0[6], P0[7], P0[8], P0[9],     pw0[2] = ATT_PK(P0, 4),  pw0[3] = ATT_PK(P0, 6),  pw0); \
        ATT_GAPA(C0 = ATT_MFMA(kf[2], qr[1], C0),   P0[10], P0[11], P0[12], P0[13], pw1[0] = ATT_PK(P0, 8),  pw1[1] = ATT_PK(P0, 10), pw1); \
        ATT_GAPA(C1 = ATT_MFMA(kf[3], qr[1], C1),   P0[14], P0[15], P1[0], P1[1],   pw1[2] = ATT_PK(P0, 12), pw1[3] = ATT_PK(P0, 14), pw1); \
        ATT_GAPA(C0 = ATT_MFMA(kf[4], qr[2], C0),   P1[2], P1[3], P1[4], P1[5],     pw2[0] = ATT_PK(P1, 0),  pw2[1] = ATT_PK(P1, 2),  pw2); \
        ATT_GAPA(C1 = ATT_MFMA(kf[5], qr[2], C1),   P1[6], P1[7], P1[8], P1[9],     pw2[2] = ATT_PK(P1, 4),  pw2[3] = ATT_PK(P1, 6),  pw2); \
        ATT_GAPA(C0 = ATT_MFMA(kf[6], qr[3], C0),   P1[10], P1[11], P1[12], P1[13], pw3[0] = ATT_PK(P1, 8),  pw3[1] = ATT_PK(P1, 10), pw3); \
        ATT_GAPA(C1 = ATT_MFMA(kf[7], qr[3], C1),   P1[14], P1[15], 0.f, 0.f,       pw3[2] = ATT_PK(P1, 12), pw3[3] = ATT_PK(P1, 14), pw3); \
        lsum += sacc; \
        ATT_SBAR(); \
          \
        { const LAS unsigned char* vp_ = vp0 + sl_prev; const LAS unsigned char* kn_ = kp0 + sl_next + (sl_next >> 4); s16x4 vlo0, vhi0, vlo1, vhi1, vlo2, vhi2, vlo3, vhi3; float rm_ = 0.f; \
          ATT_VRD(0, ATT_VOFF(0)); ATT_VRD(1, ATT_VOFF(1)); ATT_VRD(2, ATT_VOFF(2)); \
          if (DIFF) { \
            ATT_VRD(3, ATT_VOFF(3)); ATT_SBAR(); o[0] = ATT_MFMA(ATT_PAF(0), ATT_VFR(0), o[0]); ATT_SBAR(); \
            if (gk_) dma_k((t) + 3, sl_cur); if (gv_) dma_v((t) + 1, sl_next); \
            ATT_VRD(0, ATT_VOFF(4)); ATT_SBAR(); o[1] = ATT_MFMA(ATT_PAF(0), ATT_VFR(1), o[1]); ATT_SBAR(); \
            ATT_SPECIAL(C0, C1, t); \
            ATT_VRD(1, ATT_VOFF(5)); ATT_SBAR(); o[2] = ATT_MFMA(ATT_PAF(0), ATT_VFR(2), o[2]); ATT_SBAR(); \
            if (!fast) ATT_ROWMAX(C0, C1, rm_); \
            ATT_VRD(2, ATT_VOFF(6)); ATT_SBAR(); o[3] = ATT_MFMA(ATT_PAF(0), ATT_VFR(3), o[3]); ATT_SBAR(); \
            { resc = false; \
              if (!fast && __builtin_expect(__any(rm_ > THR), 0)) { const float dl_ = fmaxf(rm_, 0.f); m += dl_; mz = false; \
                  _Pragma("unroll") for (int r = 0; r < 16; ++r) { C0[r] -= dl_; C1[r] -= dl_; } \
                  nm = -m; \
                  const float f_ = __builtin_amdgcn_exp2f(-dl_); lsum *= f_; if (hi == 0) wsf[l31] = f_; resc = true; } } \
            ATT_SBAR(); \
            ATT_KRD(gv_, 0); ATT_VRD(3, ATT_VOFF(7)); ATT_SBAR(); o[0] = ATT_MFMA(ATT_PAF(1), ATT_VFR(0), o[0]); ATT_SBAR(); ATT_EXF(C0, C1, 0); ATT_EXF(C0, C1, 1); ATT_EXF(C0, C1, 2); ATT_PIN(C0); ATT_PIN(C1); ATT_SBAR(); \
            ATT_KRD(gv_, 1); ATT_VRD(0, ATT_VOFF(8)); ATT_SBAR(); o[1] = ATT_MFMA(ATT_PAF(1), ATT_VFR(1), o[1]); ATT_SBAR(); ATT_EXF(C0, C1, 3); ATT_EXF(C0, C1, 4); ATT_EXF(C0, C1, 5); ATT_PIN(C0); ATT_PIN(C1); ATT_SBAR(); \
            ATT_KRD(gv_, 2); ATT_VRD(1, ATT_VOFF(9)); ATT_SBAR(); o[2] = ATT_MFMA(ATT_PAF(1), ATT_VFR(2), o[2]); ATT_SBAR(); ATT_EXF(C0, C1, 6); ATT_EXF(C0, C1, 7); ATT_EXF(C0, C1, 8); ATT_PIN(C0); ATT_PIN(C1); ATT_SBAR(); \
            ATT_KRD(gv_, 3); ATT_VRD(2, ATT_VOFF(10)); ATT_SBAR(); o[3] = ATT_MFMA(ATT_PAF(1), ATT_VFR(3), o[3]); ATT_SBAR(); ATT_EXF(C0, C1, 9); ATT_EXF(C0, C1, 10); ATT_EXF(C0, C1, 11); ATT_PIN(C0); ATT_PIN(C1); ATT_SBAR(); \
            ATT_VRD(3, ATT_VOFF(11)); ATT_SBAR(); o[0] = ATT_MFMA(ATT_PAF(2), ATT_VFR(0), o[0]); ATT_SBAR(); ATT_EXF(C0, C1, 12); ATT_EXF(C0, C1, 13); ATT_EXF(C0, C1, 14); ATT_PIN(C0); ATT_PIN(C1); ATT_SBAR(); \
            ATT_VRD(0, ATT_VOFF(12)); ATT_SBAR(); o[1] = ATT_MFMA(ATT_PAF(2), ATT_VFR(1), o[1]); ATT_SBAR(); ATT_EXF(C0, C1, 15); ATT_EXF(C0, C1, 16); ATT_EXF(C0, C1, 17); ATT_PIN(C0); ATT_PIN(C1); ATT_SBAR(); \
            ATT_VRD(1, ATT_VOFF(13)); ATT_SBAR(); o[2] = ATT_MFMA(ATT_PAF(2), ATT_VFR(2), o[2]); ATT_SBAR(); ATT_EXF(C0, C1, 18); ATT_EXF(C0, C1, 19); ATT_EXF(C0, C1, 20); ATT_PIN(C0); ATT_PIN(C1); ATT_SBAR(); \
            ATT_VRD(2, ATT_VOFF(14)); ATT_SBAR(); o[3] = ATT_MFMA(ATT_PAF(2), ATT_VFR(3), o[3]); ATT_SBAR(); ATT_EXF(C0, C1, 21); ATT_EXF(C0, C1, 22); ATT_EXF(C0, C1, 23); ATT_PIN(C0); ATT_PIN(C1); ATT_SBAR(); \
            ATT_VRD(3, ATT_VOFF(15)); ATT_SBAR(); o[0] = ATT_MFMA(ATT_PAF(3), ATT_VFR(0), o[0]); ATT_SBAR(); ATT_EXF(C0, C1, 24); ATT_EXF(C0, C1, 25); ATT_PIN(C0); ATT_PIN(C1); ATT_SBAR(); \
            ATT_SBAR(); o[1] = ATT_MFMA(ATT_PAF(3), ATT_VFR(1), o[1]); ATT_SBAR(); ATT_EXF(C0, C1, 26); ATT_EXF(C0, C1, 27); ATT_PIN(C0); ATT_PIN(C1); ATT_SBAR(); \
            ATT_SBAR(); o[2] = ATT_MFMA(ATT_PAF(3), ATT_VFR(2), o[2]); ATT_SBAR(); ATT_EXF(C0, C1, 28); ATT_EXF(C0, C1, 29); ATT_PIN(C0); ATT_PIN(C1); ATT_SBAR(); \
            ATT_SBAR(); o[3] = ATT_MFMA(ATT_PAF(3), ATT_VFR(3), o[3]); ATT_SBAR(); ATT_EXF(C0, C1, 30); ATT_EXF(C0, C1, 31); ATT_PIN(C0); ATT_PIN(C1); ATT_SBAR(); \
          } else { \
            ATT_VRD(3, ATT_VOFF(3)); ATT_SBAR(); o[0] = ATT_MFMA(ATT_PAF(0), ATT_VFR(0), o[0]); ATT_SBAR(); \
            if (gk_) dma_k((t) + 3, sl_cur); if (gv_) dma_v((t) + 1, sl_next); \
            ATT_SPECIAL(C0, C1, t); \
            ATT_VRD(0, ATT_VOFF(4)); ATT_SBAR(); o[1] = ATT_MFMA(ATT_PAF(0), ATT_VFR(1), o[1]); ATT_SBAR(); \
            if (!fast) ATT_ROWMAX(C0, C1, rm_); \
            { resc = false; \
              if (!fast && __builtin_expect(__any(rm_ > THR), 0)) { const float dl_ = fmaxf(rm_, 0.f); m += dl_; mz = false; \
                  _Pragma("unroll") for (int r = 0; r < 16; ++r) { C0[r] -= dl_; C1[r] -= dl_; } \
                  nm = -m; \
                  const float f_ = __builtin_amdgcn_exp2f(-dl_); lsum *= f_; if (hi == 0) wsf[l31] = f_; resc = true; } } \
            ATT_SBAR(); \
            ATT_KRD(gv_, 0); ATT_VRD(1, ATT_VOFF(5)); ATT_SBAR(); o[0] = ATT_MFMA(ATT_PAF(1), ATT_VFR(2), o[0]); ATT_SBAR(); ATT_EXF(C0, C1, 0); ATT_EXF(C0, C1, 1); ATT_EXF(C0, C1, 2); ATT_EXF(C0, C1, 3); ATT_EXF(C0, C1, 4); ATT_EXF(C0, C1, 5); ATT_PIN(C0); ATT_PIN(C1); ATT_SBAR(); \
            ATT_KRD(gv_, 1); ATT_VRD(2, ATT_VOFF(6)); ATT_SBAR(); o[1] = ATT_MFMA(ATT_PAF(1), ATT_VFR(3), o[1]); ATT_SBAR(); ATT_EXF(C0, C1, 6); ATT_EXF(C0, C1, 7); ATT_EXF(C0, C1, 8); ATT_EXF(C0, C1, 9); ATT_EXF(C0, C1, 10); ATT_EXF(C0, C1, 11); ATT_PIN(C0); ATT_PIN(C1); ATT_SBAR(); \
            ATT_KRD(gv_, 2); ATT_VRD(3, ATT_VOFF(7)); ATT_SBAR(); o[0] = ATT_MFMA(ATT_PAF(2), ATT_VFR(0), o[0]); ATT_SBAR(); ATT_EXF(C0, C1, 12); ATT_EXF(C0, C1, 13); ATT_EXF(C0, C1, 14); ATT_EXF(C0, C1, 15); ATT_EXF(C0, C1, 16); ATT_PIN(C0); ATT_PIN(C1); ATT_SBAR(); \
            ATT_KRD(gv_, 3); ATT_SBAR(); o[1] = ATT_MFMA(ATT_PAF(2), ATT_VFR(1), o[1]); ATT_SBAR(); ATT_EXF(C0, C1, 17); ATT_EXF(C0, C1, 18); ATT_EXF(C0, C1, 19); ATT_EXF(C0, C1, 20); ATT_EXF(C0, C1, 21); ATT_PIN(C0); ATT_PIN(C1); ATT_SBAR(); \
            ATT_SBAR(); o[0] = ATT_MFMA(ATT_PAF(3), ATT_VFR(2), o[0]); ATT_SBAR(); ATT_EXF(C0, C1, 22); ATT_EXF(C0, C1, 23); ATT_EXF(C0, C1, 24); ATT_EXF(C0, C1, 25); ATT_EXF(C0, C1, 26); ATT_PIN(C0); ATT_PIN(C1); ATT_SBAR(); \
            ATT_SBAR(); o[1] = ATT_MFMA(ATT_PAF(3), ATT_VFR(3), o[1]); ATT_SBAR(); ATT_EXF(C0, C1, 27); ATT_EXF(C0, C1, 28); ATT_EXF(C0, C1, 29); ATT_EXF(C0, C1, 30); ATT_EXF(C0, C1, 31); ATT_PIN(C0); ATT_PIN(C1); ATT_SBAR(); \
          } } \
        if (gk_) { if (DIFF) ATT_WAITBAR(4); else ATT_WAITBAR(2); } else if (gv_) { if (DIFF) ATT_WAITBAR(2); else ATT_WAITBAR(1); } else ATT_WAITBAR(0); \
        ATT_RESC(); ATT_ROT(); } while (0)
    int t = 1;
    if (fast) for (; t + 4 < NT; t += 2) { ATT_STEP(pB0, pB1, pA0, pA1, t, true, true); ATT_STEP(pA0, pA1, pB0, pB1, t + 1, true, true); }
    for (; t + 1 < NT; t += 2) { ATT_STEP(pB0, pB1, pA0, pA1, t, (t) + 3 < NT, (t) + 1 < NT); ATT_STEP(pA0, pA1, pB0, pB1, t + 1, (t) + 4 < NT, (t) + 2 < NT); }
    if (t < NT) {
        ATT_STEP(pB0, pB1, pA0, pA1, t, (t) + 3 < NT, (t) + 1 < NT);
#pragma unroll
        for (int r = 0; r < 16; ++r) { pA0[r] = pB0[r]; pA1[r] = pB1[r]; }
    }
    {
        float sacc = 0.f;
#pragma unroll
        for (int r = 0; r < 16; ++r) sacc += pA0[r] + pA1[r];
        lsum += sacc;
        pw0 = (v4u){ATT_PK(pA0, 0), ATT_PK(pA0, 2), ATT_PK(pA0, 4), ATT_PK(pA0, 6)}; pw1 = (v4u){ATT_PK(pA0, 8), ATT_PK(pA0, 10), ATT_PK(pA0, 12), ATT_PK(pA0, 14)};
        pw2 = (v4u){ATT_PK(pA1, 0), ATT_PK(pA1, 2), ATT_PK(pA1, 4), ATT_PK(pA1, 6)}; pw3 = (v4u){ATT_PK(pA1, 8), ATT_PK(pA1, 10), ATT_PK(pA1, 12), ATT_PK(pA1, 14)};
        const LAS unsigned char* vb = vp0 + sl_prev;
#pragma unroll
        for (int db = 0; db < NDB; ++db) {
#pragma unroll
            for (int ks = 0; ks < 4; ++ks) {
                const s16x4 lo = vtr(vb + (4 * ks + (db >> 1)) * 1024 + (db & 1) * 512), hh4 = vtr(vb + (4 * ks + (db >> 1)) * 1024 + (db & 1) * 512 + 2048);
                const bf16x8 vf = (bf16x8){lo[0], lo[1], lo[2], lo[3], hh4[0], hh4[1], hh4[2], hh4[3]};
                const v4u pk = ks == 0 ? pw0 : ks == 1 ? pw1 : ks == 2 ? pw2 : pw3;
                o[db] = ATT_MFMA(__builtin_bit_cast(bf16x8, pk), vf, o[db]);
            }
        }
    }
#undef ATT_SBAR
#undef ATT_PIN
#undef ATT_ROT
#undef ATT_WAITBAR
#undef ATT_KLD2
#undef ATT_SPECIAL
#undef ATT_ROWMAX
#undef ATT_RESC
#undef ATT_PK
#undef ATT_PAF
#undef ATT_GAPA
#undef ATT_VRD
#undef ATT_VFR
#undef ATT_EX2
#undef ATT_EX4
#undef ATT_EXF
#undef ATT_VOFF
#undef ATT_PVD
#undef ATT_PVS
#undef ATT_KRD
#undef ATT_STEP
    int tid2 = tid; asm volatile("" : "+v"(tid2));
    if (fast) {
        volatile LAS unsigned* retry_ = (volatile LAS unsigned*)(lds + MISC_OFF + 96);
        const int l31b = tid2 & 31, wqb = (tid2 >> 6) & 3;
        const float lt = swap_add(lsum);
        const bool bad = (!metablk || (wqb == 0 && l31b < 16)) && !(lt > 0x1p-100f && lt < 0x1p100f);
        if (__any(bad)) { if ((tid2 & 63) == 0) retry_[0] = useq; }
        asm volatile("s_waitcnt lgkmcnt(0)\n\ts_barrier" ::: "memory");
        if ((unsigned)__builtin_amdgcn_readfirstlane((int)retry_[0]) == useq) return true;
    }
    attn_epilogue<DIFF>(lds, YAB, o, lsum, tid2, hh, qb, lam, lam_scale);
    return false;
}
template <bool DIFF>
__device__ __forceinline__ void attn_unit(LAS unsigned char* lds, const bf16* __restrict__ Z, bf16* __restrict__ YAB, const float* __restrict__ lutg,
                                          int hh, int qb, float lam, float lam_scale, float sink2, int tid_in, unsigned useq) {
    if (attn_body<DIFF, true>(lds, Z, YAB, lutg, hh, qb, lam, lam_scale, sink2, tid_in, useq))
        (void)attn_body<DIFF, false>(lds, Z, YAB, lutg, hh, qb, lam, lam_scale, sink2, tid_in, useq);
}
template <bool DIFF>
__device__ __forceinline__ void attn_epilogue(LAS unsigned char* lds, bf16* __restrict__ YAB, att::f32x16 (&o)[DIFF ? 4 : 2], float lsum, int tid, int hh, int qb, float lam, float lam_scale) {
    constexpr int NDB = DIFF ? 4 : 2;
    const int lane = tid & 63, w = __builtin_amdgcn_readfirstlane(tid >> 6), cj = w >> 2, wq = w & 3, l31 = lane & 31, hi = lane >> 5;
    const bool metablk = (qb == 128);
    const int qrow = (metablk ? ROW_META : 128 * qb) + 32 * wq + l31;
    LAS float* wsf = (LAS float*)(lds + L_WSF) + w * 64;
    const float ltot = swap_add(lsum);
    float sc = 1.0f / ltot; if (DIFF && cj == 1) sc *= lam;
    if (hi == 0) wsf[l31] = sc;
    asm volatile("s_waitcnt lgkmcnt(0)" ::: "memory");
#pragma unroll
    for (int g = 0; g < 4; ++g) { const f32x4 fv = *(const LAS f32x4*)(wsf + 8 * g + 4 * hi);
#pragma unroll
        for (int db = 0; db < NDB; ++db) { o[db][4 * g + 0] *= fv.x; o[db][4 * g + 1] *= fv.y; o[db][4 * g + 2] *= fv.z; o[db][4 * g + 3] *= fv.w; } }
    asm volatile("s_waitcnt lgkmcnt(0)\n\ts_barrier" ::: "memory");
    const bool store_ok = !metablk || (wq == 0 && l31 < 16);
    if (DIFF) {
        LAS float* X = (LAS float*)lds + wq * 32 * XD_STRIDE;
        if (cj == 1) {
#pragma unroll
            for (int db = 0; db < NDB; ++db)
#pragma unroll
                for (int r = 0; r < 16; ++r) X[crow(r, hi) * XD_STRIDE + 32 * db + l31] = o[db][r];
        }
        asm volatile("s_waitcnt lgkmcnt(0)\n\ts_barrier" ::: "memory");
        if (cj == 0) {
#pragma unroll
            for (int db = 0; db < NDB; ++db)
#pragma unroll
                for (int r = 0; r < 16; ++r) { LAS float* xp = X + crow(r, hi) * XD_STRIDE + 32 * db + l31; *xp = o[db][r] - *xp; }
            asm volatile("s_waitcnt lgkmcnt(0)" ::: "memory");
            const LAS float* xr = X + l31 * XD_STRIDE + 64 * hi; const LAS float* sg = (const LAS float*)(lds + L_SUBG) + 64 * hi;
            f32x4 xv[16]; float ss = 0.f;
#pragma unroll
            for (int i = 0; i < 16; ++i) { xv[i] = *(const LAS f32x4*)(xr + 4 * i); ss += (xv[i].x * xv[i].x + xv[i].y * xv[i].y) + (xv[i].z * xv[i].z + xv[i].w * xv[i].w); }
            ss = swap_add(ss);
            const float rstd = lam_scale / sqrtf(ss * (1.f / 128.f) + EPS);
            if (store_ok) {
                bf16* op = YAB + (size_t)qrow * DM + hh * 128 + 64 * hi;
#pragma unroll
                for (int k = 0; k < 8; ++k) { const f32x4 g0 = *(const LAS f32x4*)(sg + 8 * k), g1 = *(const LAS f32x4*)(sg + 8 * k + 4); const f32x4 a = xv[2 * k], b = xv[2 * k + 1];
                    v4u ov; ov.x = cvtpk(a.x * rstd * g0.x, a.y * rstd * g0.y); ov.y = cvtpk(a.z * rstd * g0.z, a.w * rstd * g0.w); ov.z = cvtpk(b.x * rstd * g1.x, b.y * rstd * g1.y); ov.w = cvtpk(b.z * rstd * g1.z, b.w * rstd * g1.w);
                    *(GAS v4u*)(op + 8 * k) = ov; }
            }
        }
    } else {
        LAS float* X = (LAS float*)lds + w * 32 * XS_STRIDE;
#pragma unroll
        for (int db = 0; db < NDB; ++db)
#pragma unroll
            for (int r = 0; r < 16; ++r) X[crow(r, hi) * XS_STRIDE + 32 * db + l31] = o[db][r];
        asm volatile("s_waitcnt lgkmcnt(0)" ::: "memory");
        const LAS float* xr = X + l31 * XS_STRIDE + 32 * hi;
        if (store_ok) {
            bf16* op = YAB + (size_t)qrow * DM + 1024 + (2 * hh + cj) * 64 + 32 * hi;
#pragma unroll
            for (int k = 0; k < 4; ++k) { const f32x4 a = *(const LAS f32x4*)(xr + 8 * k), b = *(const LAS f32x4*)(xr + 8 * k + 4);
                v4u ov; ov.x = cvtpk(a.x, a.y); ov.y = cvtpk(a.z, a.w); ov.z = cvtpk(b.x, b.y); ov.w = cvtpk(b.z, b.w);
                *(GAS v4u*)(op + 8 * k) = ov; }
        }
    }
    asm volatile("s_waitcnt lgkmcnt(0)\n\ts_barrier" ::: "memory");
}

__device__ __forceinline__ void attn_phase(Frame& F, const bf16* Z, bf16* YAB, CPtrs PP, int layer, int bx) {
    const int tid = F.tid;
    asm volatile("" : "+s"(Z), "+s"(YAB));
    const int lane = tid & 63;
    auto uni = [](float v) { return __builtin_bit_cast(float, __builtin_amdgcn_readfirstlane(__builtin_bit_cast(int, v))); };
    const float lam_init = uni(0.8f - 0.6f * expf(-0.3f * (float)layer));
    asm volatile("" : "+s"(PP));
    const float lam = uni(expf(wave_sum(PP->lq1[layer * 64 + lane] * PP->lk1[layer * 64 + lane])) - expf(wave_sum(PP->lq2[layer * 64 + lane] * PP->lk2[layer * 64 + lane])) + lam_init);
    if (tid < 128) ((LAS float*)(F.lds + L_SUBG))[tid] = PP->dnorm[layer * 128 + tid];
    const float* relb = (const float*)(PP->ws + WS_LUTG); const float* sinks = PP->sinks;
    __syncthreads();
    const int w = __builtin_amdgcn_readfirstlane(tid >> 6);
    const bool deal256 = (F.G == 256);
    unsigned useq = (unsigned)layer * 4096u;
    for (int it = F.vcu; it < 512; it += F.G) {
        for (int sub = 0; sub < 2; ++sub) { const int s = it & 63; attn_unit<true>(F.lds, Z, YAB, relb, it >> 6, sub ? s : 127 - s, lam, 1.f - lam_init, 0.f, tid, ++useq); }
    }
    constexpr int EH = 302;
    const int e0 = deal256 ? (bx < 128 ? bx : EH + (bx - 128)) : F.vcu, estep = deal256 ? 128 : F.G, elim = (deal256 && bx < 128) ? EH : 1040;
    const bool last_layer = (layer == DEPTH - 1);
    for (int e = e0; e < elim; e += estep) {
        if (last_layer && (e >= 1032 || (e % 129) == 128)) continue;
        if (e < 1032) attn_unit<false>(F.lds, Z, YAB, relb, e / 129, e % 129, 0.f, 0.f, uni(sinks[layer * 16 + 2 * (e / 129) + (w >> 2)] * LOG2E), tid, ++useq);
        else attn_unit<true>(F.lds, Z, YAB, relb, e - 1032, 128, lam, 1.f - lam_init, 0.f, tid, ++useq);
    }
}
#undef ATT_MFMA
}

#ifndef FFN_SPLIT_N
#define FFN_SPLIT_N 2
#endif
constexpr int FFN_SPLIT = ONE_LAUNCH ? FFN_SPLIT_N : 1;
constexpr int NT_IN_A = 20;
constexpr int PH_PER_LAYER = 9, N_PHASES = 1 + DEPTH * PH_PER_LAYER;
struct Args { Ptrs p; int ph_lo, ph_hi; };

__global__ void __launch_bounds__(NWAVES * 64, 2) fwd_kernel(Args args) {
    extern __shared__ __attribute__((aligned(16))) unsigned char lds[];
    Frame F;
    F.lds = (LAS unsigned char*)lds;
    F.MISC = (volatile LAS unsigned*)(F.lds + MISC_OFF);
    F.tid = threadIdx.x; F.lane = F.tid & 63; F.wave = __builtin_amdgcn_readfirstlane(F.tid >> 6);
    F.G = gridDim.x; { const int bx = blockIdx.x; F.vcu = (F.G % 8 == 0) ? (bx % 8) * (F.G / 8) + bx / 8 : bx; }
    CPtrs PP = (CPtrs)__builtin_amdgcn_kernarg_segment_ptr();
#define LDP(field) ({ CPtrs q_ = PP; asm volatile("" : "+s"(q_)); q_->field; })
#define WSP(off) ({ unsigned char* w_ = LDP(ws); (bf16*)(w_ + (off)); })
    F.ctl = (gu32*)(LDP(ws) + WS_CTL);
    for (int u = F.tid; u < (LDS_BYTES - LDSCTL_OFF) / 4; u += NWAVES * 64) ((LAS unsigned*)(F.lds + LDSCTL_OFF))[u] = 0u;
    __syncthreads();
    const int lo = args.ph_lo, hi = args.ph_hi;
    const bool multi = (hi - lo) > 1;
    XcdBarrier bar; bar.bar = (unsigned*)(F.ctl + CW_BAR); bar.x = 0; bar.st = nullptr;
    if (multi) bar = xcd_barrier_post((unsigned*)(F.ctl + CW_BAR), F.MISC + 8);
#define IN(k) (lo <= (k) && (k) < hi)
#define SEAM(k) do { if (IN(k) && IN((k) + 1)) { xcd_barrier(bar); if (NREP(10) == 2) xcd_barrier(bar); } } while (0)

#define RSP ((float*)(LDP(ws) + WS_HMETA))

    if (IN(0)) {
        gate_colmax_pass(F, LDP(w_in), LDP(n_attn_pre), (unsigned*)(F.ctl + CW_CMAX));
        if (multi) xcd_barrier(bar);
        p0_transposes(F, PP);
        gate_quant_pass(F, LDP(w_in), LDP(n_attn_pre), (signed char*)(LDP(ws) + WS_WQ), (const unsigned*)(F.ctl + CW_CMAX), (float*)(LDP(ws) + WS_CS));
        build_lut_tables(F, LDP(relb), (float*)(LDP(ws) + WS_LUTG));
        __syncthreads();
        resid_phase<0>(F, LDP(x), LDP(meta), WSP(WS_U), RSP, nullptr, nullptr, nullptr, (signed char*)(LDP(ws) + WS_HQ), (float*)(LDP(ws) + WS_QS));
        SEAM(0);
    }
    for (int l = 0; l < DEPTH; ++l) {
        const int pb = 1 + PH_PER_LAYER * l;
        if (pb + PH_PER_LAYER <= lo || pb >= hi) continue;
#define FRESH(Fs) Frame Fs = F; asm volatile("" : "+s"(Fs.vcu), "+s"(Fs.G), "+s"(Fs.wave), "+v"(Fs.tid)); Fs.lane = Fs.tid & 63; int bx_ = blockIdx.x; asm volatile("" : "+s"(bx_))
#define OPQ(p) asm volatile("" : "+s"(p))
        if (IN(pb + 0)) {
            for (int rep = 0; rep < NREP(0); ++rep) {
            const bf16* A_ = WSP(WS_U); const bf16* B_ = WSP(WS_WIN) + (size_t)l * INW * DM; bf16* O_ = WSP(WS_Z); OPQ(A_); OPQ(B_); OPQ(O_);
            FRESH(Fs); for (int mrep = 0; mrep < NREP(11); ++mrep) meta_gemm(Fs.lds, A_ + (size_t)ROW_META * DM, DM, B_, DM, INW, DM, Fs.vcu, Fs.G, Fs.tid, MEpiZ{O_, RSP});
            {
            pg8::Gemm g{A_, B_, SEQ, 8 * 256, DM, DM, DM}; pg8::StaticOrder S; S.init(SEQ, 8 * 256, Fs.G, bx_);
            pg8::EpiZ E{O_, INW, RSP, 0};
            pg8::gemm_phase<pg8::EpiZ, pg8::StaticOrder, true>(F.lds + RING_OFF, g, S, E); }
            {
            const bf16* B2_ = B_ + (size_t)12 * 256 * DM; OPQ(B2_);
            pg8::Gemm g{A_, B2_, SEQ, 5 * 256, DM, DM, DM}; pg8::StaticOrder S; S.init(SEQ, 5 * 256, Fs.G, bx_);
            pg8::EpiZ E{O_, INW, RSP, 12};
            pg8::gemm_phase<pg8::EpiZ, pg8::StaticOrder, true>(F.lds + RING_OFF, g, S, E); }
            if (Fs.G != 256 || bx_ >= 64) {
                const bf16* AQ_ = WSP(WS_HQ); const bf16* BQ_ = (const bf16*)(LDP(ws) + WS_WQ + (size_t)l * NQ * DM); const float* QS_ = (const float*)(LDP(ws) + WS_QS); const float* CS_ = (const float*)(LDP(ws) + WS_CS) + l * NQ; OPQ(AQ_); OPQ(BQ_); OPQ(QS_); OPQ(CS_);
                pg8::Gemm gq{AQ_, BQ_, SEQ, 6 * 256, 1024, 1024, 1024}; pg8::StaticOrder Sq; if (Fs.G == 256) Sq.init(SEQ, 6 * 256, 192, bx_ - 64); else Sq.init(SEQ, 6 * 256, Fs.G, bx_);
                pg8::EpiZ Eq{O_, INW, QS_, 8, CS_, 4, 5};
                pg8::gemm_phase<pg8::EpiZ, pg8::StaticOrder, true, true>(F.lds + RING_OFF, gq, Sq, Eq);
            }
            }
            SEAM(pb + 0);
        }
        if (IN(pb + 1)) {
#if !ATTN_NAIVE
            for (int rep = 0; rep < NREP(1); ++rep) { FRESH(Fs);
                att::attn_phase(Fs, WSP(WS_Z), WSP(WS_YAB), PP, l, bx_);
                {
                    constexpr int QR0 = 6 * 256;
                    const bf16* AQ_ = WSP(WS_HQ); const bf16* BQ_ = (const bf16*)(LDP(ws) + WS_WQ + ((size_t)l * NQ + QR0) * DM); bf16* O_ = WSP(WS_Z); const float* QS_ = (const float*)(LDP(ws) + WS_QS); const float* CS_ = (const float*)(LDP(ws) + WS_CS) + l * NQ + QR0; OPQ(AQ_); OPQ(BQ_); OPQ(O_); OPQ(QS_); OPQ(CS_);
                    pg8::Gemm gq{AQ_, BQ_, SEQ, 14 * 256, 1024, 1024, 1024}; pg8::StaticOrder Sq; Sq.init(SEQ, 14 * 256, Fs.G, bx_);
                    pg8::EpiZ Eq{O_, INW, QS_, 19, CS_};
                    pg8::gemm_phase<pg8::EpiZ, pg8::StaticOrder, true, true>(F.lds + RING_OFF, gq, Sq, Eq);
                } }
#endif
            SEAM(pb + 1);
        }
        if (IN(pb + 2)) {
            for (int rep = 0; rep < NREP(2); ++rep) {
            const bf16* A_ = WSP(WS_YAB); const bf16* B_ = WSP(WS_WA) + (size_t)l * DM * 1024; bf16* O_ = WSP(WS_T); const bf16* G_ = WSP(WS_Z) + C_GA; OPQ(A_); OPQ(B_); OPQ(O_); OPQ(G_);
            FRESH(Fs); if (l + 1 < DEPTH) for (int mrep = 0; mrep < NREP(11); ++mrep) meta_gemm(Fs.lds, A_ + (size_t)ROW_META * DM, DM, B_, 1024, DM, 1024, Fs.vcu, Fs.G, Fs.tid, MEpiGate<false>{O_, G_, O_});
            pg8::Gemm g{A_, B_, SEQ, DM, 1024, DM, 1024}; pg8::StaticOrder S; S.init(SEQ, DM, Fs.G, bx_);
            pg8::EpiGate<false> E{O_, DM, G_, INW, O_};
            pg8::gemm_phase<pg8::EpiGate<false>, pg8::StaticOrder, true>(F.lds + RING_OFF, g, S, E);
            }
            SEAM(pb + 2);
        }
        if (IN(pb + 3)) {
            for (int rep = 0; rep < NREP(3); ++rep) {
            const bf16* A_ = WSP(WS_YAB) + 1024; const bf16* B_ = WSP(WS_WB) + (size_t)l * DM * 1024; bf16* O_ = WSP(WS_MIX); const bf16* G_ = WSP(WS_Z) + C_GB; const bf16* P_ = WSP(WS_T); OPQ(A_); OPQ(B_); OPQ(O_); OPQ(G_); OPQ(P_);
            FRESH(Fs); if (l + 1 < DEPTH) for (int mrep = 0; mrep < NREP(11); ++mrep) meta_gemm(Fs.lds, A_ + (size_t)ROW_META * DM, DM, B_, 1024, DM, 1024, Fs.vcu, Fs.G, Fs.tid, MEpiGate<true>{O_, G_, P_});
            pg8::Gemm g{A_, B_, SEQ, DM, 1024, DM, 1024}; pg8::StaticOrder S; S.init(SEQ, DM, Fs.G, bx_);
            pg8::EpiGate<true> E{O_, DM, G_, INW, P_};
            pg8::gemm_phase<pg8::EpiGate<true>, pg8::StaticOrder, true>(F.lds + RING_OFF, g, S, E);
            }
            SEAM(pb + 3);
        }
        if (IN(pb + 4)) {
            for (int rep = 0; rep < NREP(4); ++rep) {
            const bf16* A_ = WSP(WS_MIX); const bf16* B_ = WSP(WS_WOUT) + (size_t)l * DM * DM; bf16* O_ = WSP(WS_T); OPQ(A_); OPQ(B_); OPQ(O_);
            FRESH(Fs); if (l + 1 < DEPTH) for (int mrep = 0; mrep < NREP(11); ++mrep) meta_gemm(Fs.lds, A_ + (size_t)ROW_META * DM, DM, B_, DM, DM, DM, Fs.vcu, Fs.G, Fs.tid, MEpiPlain<0>{O_, DM, nullptr});
            pg8::Gemm g{A_, B_, SEQ, DM, DM, DM, DM}; pg8::StaticOrder S; S.init(SEQ, DM, Fs.G, bx_);
            pg8::EpiBf16<0> E{O_, DM, nullptr};
            pg8::gemm_phase<pg8::EpiBf16<0>, pg8::StaticOrder, true>(F.lds + RING_OFF, g, S, E);
            }
            SEAM(pb + 4);
        }
        if (IN(pb + 5)) {
            for (int rep = 0; rep < ((l == 0) ? NREP(5) : 1); ++rep) {
            FRESH(Fs); resid_phase<1>(Fs, nullptr, nullptr, WSP(WS_U), RSP, WSP(WS_T), LDP(n_attn_post) + l * DM, nullptr);
            }
            SEAM(pb + 5);
        }
        if (IN(pb + 6) || IN(pb + 7)) {
            constexpr int PROWS = SEQ / FFN_SPLIT;
            for (int part = 0; part < FFN_SPLIT; ++part) {
                if (IN(pb + 6)) {
                    for (int rep = 0; rep < NREP(6); ++rep) {
                    const bf16* A_ = WSP(WS_U); const bf16* B_ = WSP(WS_W1) + (size_t)l * DFF * DM; bf16* O_ = WSP(WS_Z); const float* R_ = RSP; OPQ(A_); OPQ(B_); OPQ(O_); OPQ(R_);
                    FRESH(Fs); if (l + 1 < DEPTH && part == 0) for (int mrep = 0; mrep < NREP(11); ++mrep) meta_gemm(Fs.lds, A_ + (size_t)ROW_META * DM, DM, B_, DM, DFF, DM, Fs.vcu, Fs.G, Fs.tid, MEpiPlain<1>{O_, DFF, R_});
                    pg8::Gemm g{A_ + (size_t)part * PROWS * DM, B_, PROWS, DFF, DM, DM, DM}; pg8::StaticOrder S; S.init(PROWS, DFF, Fs.G, bx_);
                    pg8::EpiBf16<1> E{O_ + (size_t)part * PROWS * DFF, DFF, R_ + part * PROWS};
                    pg8::gemm_phase<pg8::EpiBf16<1>, pg8::StaticOrder, true>(F.lds + RING_OFF, g, S, E);
                    }
                    if (IN(pb + 7) && multi) xcd_barrier(bar);
                }
                if (IN(pb + 7)) {
                    for (int rep = 0; rep < NREP(7); ++rep) {
                    const bf16* A_ = WSP(WS_Z); const bf16* B_ = WSP(WS_W2) + (size_t)l * DM * DFF; bf16* O_ = WSP(WS_T); OPQ(A_); OPQ(B_); OPQ(O_);
                    FRESH(Fs); if (l + 1 < DEPTH && part == 0) for (int mrep = 0; mrep < NREP(11); ++mrep) meta_gemm(Fs.lds, A_ + (size_t)ROW_META * DFF, DFF, B_, DFF, DM, DFF, Fs.vcu, Fs.G, Fs.tid, MEpiPlain<0>{O_, DM, nullptr});
                    pg8::Gemm g{A_ + (size_t)part * PROWS * DFF, B_, PROWS, DM, DFF, DFF, DFF}; pg8::StaticOrder S; S.init(PROWS, DM, Fs.G, bx_);
                    pg8::EpiBf16<0> E{O_ + (size_t)part * PROWS * DM, DM, nullptr};
                    pg8::gemm_phase<pg8::EpiBf16<0>, pg8::StaticOrder, true>(F.lds + RING_OFF, g, S, E);
                    }
                    if (part + 1 < FFN_SPLIT && IN(pb + 6) && multi) xcd_barrier(bar);
                }
            }
            SEAM(pb + 7);
        }
        if (IN(pb + 8)) {
            FRESH(Fs);
            if (l + 1 < DEPTH) resid_phase<1>(Fs, nullptr, nullptr, WSP(WS_U), RSP, WSP(WS_T), LDP(n_ff_post) + l * DM, nullptr, (signed char*)(LDP(ws) + WS_HQ), (float*)(LDP(ws) + WS_QS));
            else resid_phase<2>(Fs, nullptr, nullptr, WSP(WS_U), RSP, WSP(WS_T), LDP(n_ff_post) + l * DM, LDP(out));
            SEAM(pb + 8);
        }
    }
#undef OPQ
#undef FRESH
#undef LDP
#undef WSP
#undef RSP
#undef IN
#undef SEAM
}

extern "C" void kernel_launch(void* const* d_in, const int* in_sizes, int n_in, void* d_out, int out_size, void* d_ws, size_t ws_size, hipStream_t stream) {
    static int grid = 0;
    if (grid == 0) {
        if (n_in != 19 || in_sizes[0] != SEQ * DM || out_size != SEQ * DM || ws_size < WS_END) { fprintf(stderr, "kernel_launch: unexpected shapes (n_in %d, ws %zu)\n", n_in, ws_size); grid = -1; return; }
        int dev = 0, cus = 0;
        if (hipGetDevice(&dev) != hipSuccess || hipDeviceGetAttribute(&cus, hipDeviceAttributeMultiprocessorCount, dev) != hipSuccess) { grid = -1; return; }
        if (hipFuncSetAttribute((const void*)fwd_kernel, hipFuncAttributeMaxDynamicSharedMemorySize, LDS_BYTES) != hipSuccess) { grid = -1; return; }
#if ATTN_NAIVE
        (void)hipFuncSetAttribute((const void*)naive_attn<true>, hipFuncAttributeMaxDynamicSharedMemorySize, NAIVE_LDS);
        (void)hipFuncSetAttribute((const void*)naive_attn<false>, hipFuncAttributeMaxDynamicSharedMemorySize, NAIVE_LDS);
#endif
        int per_cu = 0;
        (void)hipOccupancyMaxActiveBlocksPerMultiprocessor(&per_cu, (const void*)fwd_kernel, NWAVES * 64, LDS_BYTES);
        (void)hipGetLastError();
        grid = cus;
    }
    if (grid < 0) return;
    if (hipMemsetAsync((char*)d_ws + WS_CTL, 0, CTL_ZERO_BYTES, stream) != hipSuccess) return;
    Args a{};
    a.p.x = (const float*)d_in[0]; a.p.meta = (const float*)d_in[1]; a.p.relb = (const float*)d_in[2]; a.p.w_in = (const float*)d_in[3]; a.p.w_a = (const float*)d_in[4];
    a.p.w_b = (const float*)d_in[5]; a.p.w_out = (const float*)d_in[6]; a.p.lq1 = (const float*)d_in[7]; a.p.lk1 = (const float*)d_in[8]; a.p.lq2 = (const float*)d_in[9];
    a.p.lk2 = (const float*)d_in[10]; a.p.dnorm = (const float*)d_in[11]; a.p.sinks = (const float*)d_in[12]; a.p.n_attn_pre = (const float*)d_in[13]; a.p.n_attn_post = (const float*)d_in[14];
    a.p.w_ff1 = (const float*)d_in[15]; a.p.w_ff2 = (const float*)d_in[16]; a.p.n_ff_pre = (const float*)d_in[17]; a.p.n_ff_post = (const float*)d_in[18];
    a.p.out = (float*)d_out; a.p.ws = (unsigned char*)d_ws;
#if ONE_LAUNCH
    a.ph_lo = 0; a.ph_hi = N_PHASES;
    hipLaunchKernelGGL(fwd_kernel, dim3(grid), dim3(NWAVES * 64), LDS_BYTES, stream, a);
#else
    for (int ph = 0; ph < N_PHASES; ++ph) {
        const int l = (ph - 1) / PH_PER_LAYER, i = (ph - 1) % PH_PER_LAYER;
#if ATTN_NAIVE
        if (ph >= 1 && i == 1) {
            const bf16* Z = (const bf16*)((unsigned char*)d_ws + WS_Z); bf16* YAB = (bf16*)((unsigned char*)d_ws + WS_YAB);
            hipLaunchKernelGGL(naive_attn<true>, dim3(8 * 129), dim3(512), NAIVE_LDS, stream, Z, YAB, a.p.relb, a.p.lq1, a.p.lk1, a.p.lq2, a.p.lk2, a.p.dnorm, a.p.sinks, l);
            hipLaunchKernelGGL(naive_attn<false>, dim3(8 * 129), dim3(512), NAIVE_LDS, stream, Z, YAB, a.p.relb, a.p.lq1, a.p.lk1, a.p.lq2, a.p.lk2, a.p.dnorm, a.p.sinks, l);
            continue;
        }
#endif
        a.ph_lo = ph; a.ph_hi = ph + 1;
        hipLaunchKernelGGL(fwd_kernel, dim3(grid), dim3(NWAVES * 64), LDS_BYTES, stream, a);
    }
#endif
    (void)hipPeekAtLastError();
}
```

```cpp
#include <hip/hip_runtime.h>
#include <cstdio>
#include <cstdint>

#ifndef ATTN_NAIVE
#define ATTN_NAIVE 0
#endif
#ifndef PROBE_MASK
#define PROBE_MASK 0
#endif
#define NREP(i) (((PROBE_MASK >> (i)) & 1) ? 2 : 1)
#ifndef ONE_LAUNCH
#define ONE_LAUNCH 1
#endif

constexpr int DM = 2048, SEQ = 16384, DEPTH = 4, NMETA = 16;
constexpr int MA = 16640;
constexpr int ROW_META = 16384, NROWS = 16400;
constexpr int INW = 8448, DFF = 8192;
constexpr int C_QA = 0, C_KA = 1024, C_VA = 2048, C_QB = 3072, C_KB = 4096, C_VB = 4224, C_GA = 4352, C_GB = 6400;
constexpr int NBUCK = 32, NBIAS = 24;
constexpr float EPS = 1e-6f, LOG2E = 1.4426950408889634f, QSCALE = 0.125f * 1.4426950408889634f, NEGBIG = -1e30f;

constexpr size_t MiB = 1u << 20;
constexpr size_t WS_CTL = 0, CTL_ZERO_BYTES = 1 * MiB;
constexpr size_t WS_HMETA = 2 * MiB;
constexpr size_t WS_LUTG = 2 * MiB + 256 * 1024;
constexpr size_t WS_WIN = 4 * MiB;
constexpr size_t WS_WA = 136 * MiB, WS_WB = 152 * MiB;
constexpr size_t WS_WOUT = 168 * MiB;
constexpr size_t WS_W1 = 200 * MiB;
constexpr size_t WS_W2 = 328 * MiB;
constexpr size_t WS_U = 456 * MiB;
constexpr size_t WS_YAB = 521 * MiB;
constexpr size_t WS_MIX = 586 * MiB;
constexpr size_t WS_T = 651 * MiB;
constexpr size_t WS_Z = 716 * MiB;
constexpr size_t WS_HQ = WS_MIX;
constexpr int NQ = 5120;
constexpr size_t WS_WQ = 985 * MiB;
constexpr size_t WS_QS = 3 * MiB;
constexpr size_t WS_CS = 3 * MiB + 128 * 1024;
constexpr size_t WS_END = 1026 * MiB;
static_assert(WS_Z + (size_t)MA * INW * 2 <= WS_WQ && WS_WQ + (size_t)4 * 5120 * 2048 <= WS_END && (size_t)MA * 2048 <= 65 * MiB, "ws map");
constexpr int CW_TMO = 0, CW_BAR = 4096, CW_CMAX = 32768;

namespace pg8 {
#define PG8_LAS __attribute__((address_space(3)))
typedef unsigned short bf16_t;
typedef short bf16x8 __attribute__((ext_vector_type(8)));
typedef float f32x4 __attribute__((ext_vector_type(4)));
typedef unsigned u32x4 __attribute__((ext_vector_type(4)));
typedef int i32x4 __attribute__((ext_vector_type(4)));
constexpr int BM = 256, BK = 64, HALF = 128, HTB = HALF * BK * 2  , STAGE_BYTES = 8 * HTB, NXCD = 8, WGM = 8;

__host__ __device__ __forceinline__ int lds_byte(int r, int c) { const int r7 = r & 7; return (r >> 3) * 1024 + r7 * 128 + (((c >> 3) ^ r7) << 4) + (c & 7) * 2; }
__host__ __device__ __forceinline__ void stage_rc(int b, int& R, int& C) { const int blk = b / 1024, sb = b % 1024, r7 = sb / 128, chs = (sb % 128) / 16; R = blk * 8 + r7; C = (chs ^ r7) * 8; }
__host__ __device__ __forceinline__ int perm32(int rho) { const int n = rho >> 4, i = rho & 15; return 8 * (i >> 2) + 4 * n + (i & 3); }

struct Unit { int pm, pn; };
struct Gemm { const bf16_t* A; const bf16_t* Bt; int M, N, K, lda, ldb; };

struct StaticOrder {
    int nM, nN, nwg, G, c;
    __host__ __device__ void init(int M, int N, int G_, int c_) { nM = M / BM; nN = N / BM; nwg = nM * nN; G = G_; c = c_; }
    __host__ __device__ bool next(int i, Unit& u) const {
        const long L = (long)i * G + c; if (L >= nwg) return false;
        int wgid = (int)L; { const int q = nwg / NXCD, r = nwg % NXCD, xcd = wgid % NXCD, off = wgid / NXCD; wgid = (xcd < r ? xcd * (q + 1) : r * (q + 1) + (xcd - r) * q) + off; }
        const int nig = WGM * nN, gid = wgid / nig, fm = gid * WGM, gsz = (nM - fm) < WGM ? (nM - fm) : WGM;
        u.pm = fm + ((wgid % nig) % gsz); u.pn = (wgid % nig) / gsz; return true;
    }
    __device__ __forceinline__ void a_ready(const Unit&) const {}
    __device__ __forceinline__ void done(const Unit&) const {}
};

__device__ __forceinline__ unsigned cvt_pk_bf16(float lo, float hi) { unsigned r; asm volatile("v_cvt_pk_bf16_f32 %0, %1, %2" : "=v"(r) : "v"(lo), "v"(hi)); return r; }
__device__ __forceinline__ float bf_lo(unsigned u) { return __builtin_bit_cast(float, u << 16); }
__device__ __forceinline__ float bf_hi(unsigned u) { return __builtin_bit_cast(float, u & 0xffff0000u); }
__device__ __forceinline__ float sigmoidf_fast(float x) { return __builtin_amdgcn_rcpf(1.0f + __builtin_amdgcn_exp2f(-x * 1.4426950408889634f)); }

#define PG8_GAS __attribute__((address_space(1)))
__device__ __forceinline__ void st_remap(PG8_LAS unsigned char* stg, int fr, int fq, int lane, u32x4 w, PG8_GAS bf16_t* blk, int ldc) {
    *(PG8_LAS u32x4*)(stg + fr * 64 + ((fq ^ ((fr >> 1) & 3)) * 16)) = w;
    const int r = lane >> 2, c = lane & 3;
    const u32x4 v = *(const PG8_LAS u32x4*)(stg + r * 64 + ((c ^ ((r >> 1) & 3)) * 16));
    *(PG8_GAS u32x4*)(blk + (size_t)r * ldc + c * 8) = v;
}
struct EpiZ {
    static constexpr bool PERM = true, AFTER_DRAIN = false;
    bf16_t* O; int ldc; const float* rs; int pn_off; const float* cs = nullptr; int pn_split = 1 << 30, pn_jump = 0;
    __device__ __forceinline__ void operator()(const f32x4 (&acc)[2][2][4][2], const Unit& u, int wr, int wc, int fr, int fq, PG8_LAS unsigned char* stg, int lane) const {
        const int tpn = u.pn + pn_off + (u.pn >= pn_split ? pn_jump : 0);
        const int rowb = u.pm * BM + wr * 64, colb = tpn * BM + wc * 32;
        const int mode = (tpn < 4 || (tpn >= 12 && tpn < 16)) ? 1 : (tpn >= 17 ? 2 : 0);
        f32x4 c4[2][2];
        if (cs) {
#pragma unroll
            for (int bj = 0; bj < 2; ++bj) { c4[bj][0] = *(const PG8_GAS f32x4*)(cs + u.pn * BM + wc * 32 + bj * HALF + 8 * fq); c4[bj][1] = *(const PG8_GAS f32x4*)(cs + u.pn * BM + wc * 32 + bj * HALF + 8 * fq + 4); } }
        float r8[2][4];
#pragma unroll
        for (int ai = 0; ai < 2; ++ai)
#pragma unroll
            for (int m = 0; m < 4; ++m) r8[ai][m] = ((const PG8_GAS float*)rs)[rowb + fr + ai * HALF + m * 16];
#pragma unroll
        for (int ai = 0; ai < 2; ++ai)
#pragma unroll
            for (int m = 0; m < 4; ++m) { PG8_GAS bf16_t* blk = (PG8_GAS bf16_t*)O + (size_t)(rowb + ai * HALF + m * 16) * ldc + colb; const float r_ = r8[ai][m];
#pragma unroll
                for (int bj = 0; bj < 2; ++bj) { f32x4 v0, v1;
                    if (cs) { const i32x4 a0 = __builtin_bit_cast(i32x4, acc[ai][bj][m][0]), a1 = __builtin_bit_cast(i32x4, acc[ai][bj][m][1]);
#pragma unroll
                        for (int e = 0; e < 4; ++e) { v0[e] = (float)a0[e] * r_ * c4[bj][0][e]; v1[e] = (float)a1[e] * r_ * c4[bj][1][e]; } }
                    else { v0 = acc[ai][bj][m][0] * r_; v1 = acc[ai][bj][m][1] * r_; }
                    if (mode == 1) { v0 = v0 * QSCALE; v1 = v1 * QSCALE; }
                    else if (mode == 2) {
#pragma unroll
                        for (int e = 0; e < 4; ++e) { v0[e] = sigmoidf_fast(v0[e]); v1[e] = sigmoidf_fast(v1[e]); } }
                    u32x4 w; w.x = cvt_pk_bf16(v0[0], v0[1]); w.y = cvt_pk_bf16(v0[2], v0[3]); w.z = cvt_pk_bf16(v1[0], v1[1]); w.w = cvt_pk_bf16(v1[2], v1[3]);
                    st_remap(stg, fr, fq, lane, w, blk + bj * HALF, ldc); } }
    }
};
struct EpiZq {
    static constexpr bool PERM = true, AFTER_DRAIN = false;
    bf16_t* O; int ldc; const float* qs; const float* cs; int col_off;
    __device__ __forceinline__ void operator()(const f32x4 (&acc)[2][2][4][2], const Unit& u, int wr, int wc, int fr, int fq, PG8_LAS unsigned char* stg, int lane) const {
        const int rowb = u.pm * BM + wr * 64, colg = u.pn * BM + wc * 32;
        float r8[2][4]; f32x4 c4[2][2];
#pragma unroll
        for (int ai = 0; ai < 2; ++ai)
#pragma unroll
            for (int m = 0; m < 4; ++m) r8[ai][m] = ((const PG8_GAS float*)qs)[rowb + fr + ai * HALF + m * 16];
#pragma unroll
        for (int bj = 0; bj < 2; ++bj) { c4[bj][0] = *(const PG8_GAS f32x4*)(cs + colg + bj * HALF + 8 * fq); c4[bj][1] = *(const PG8_GAS f32x4*)(cs + colg + bj * HALF + 8 * fq + 4); }
#pragma unroll
        for (int ai = 0; ai < 2; ++ai)
#pragma unroll
            for (int m = 0; m < 4; ++m) { PG8_GAS bf16_t* blk = (PG8_GAS bf16_t*)O + (size_t)(rowb + ai * HALF + m * 16) * ldc + col_off + colg; const float r_ = r8[ai][m];
#pragma unroll
                for (int bj = 0; bj < 2; ++bj) { const i32x4 a0 = __builtin_bit_cast(i32x4, acc[ai][bj][m][0]), a1 = __builtin_bit_cast(i32x4, acc[ai][bj][m][1]); f32x4 v0, v1;
#pragma unroll
                    for (int e = 0; e < 4; ++e) { v0[e] = sigmoidf_fast((float)a0[e] * r_ * c4[bj][0][e]); v1[e] = sigmoidf_fast((float)a1[e] * r_ * c4[bj][1][e]); }
                    u32x4 w; w.x = cvt_pk_bf16(v0[0], v0[1]); w.y = cvt_pk_bf16(v0[2], v0[3]); w.z = cvt_pk_bf16(v1[0], v1[1]); w.w = cvt_pk_bf16(v1[2], v1[3]);
                    st_remap(stg, fr, fq, lane, w, blk + bj * HALF, ldc); } }
    }
};
template <int ACT  > struct EpiBf16 {
    static constexpr bool PERM = true, AFTER_DRAIN = false;
    bf16_t* O; int ldc; const float* rs;
    __device__ __forceinline__ void operator()(const f32x4 (&acc)[2][2][4][2], const Unit& u, int wr, int wc, int fr, int fq, PG8_LAS unsigned char* stg, int lane) const {
        const int rowb = u.pm * BM + wr * 64, colb = u.pn * BM + wc * 32;
        float r8[2][4];
        if (ACT == 1) {
#pragma unroll
            for (int ai = 0; ai < 2; ++ai)
#pragma unroll
                for (int m = 0; m < 4; ++m) r8[ai][m] = ((const PG8_GAS float*)rs)[rowb + fr + ai * HALF + m * 16]; }
#pragma unroll
        for (int ai = 0; ai < 2; ++ai)
#pragma unroll
            for (int m = 0; m < 4; ++m) { PG8_GAS bf16_t* blk = (PG8_GAS bf16_t*)O + (size_t)(rowb + ai * HALF + m * 16) * ldc + colb;
#pragma unroll
                for (int bj = 0; bj < 2; ++bj) { f32x4 v0 = acc[ai][bj][m][0], v1 = acc[ai][bj][m][1];
                    if (ACT == 1) { const float r_ = r8[ai][m];
#pragma unroll
                        for (int e = 0; e < 4; ++e) { const float a = fmaxf(v0[e] * r_, 0.f), b = fmaxf(v1[e] * r_, 0.f); v0[e] = a * a; v1[e] = b * b; } }
                    u32x4 w; w.x = cvt_pk_bf16(v0[0], v0[1]); w.y = cvt_pk_bf16(v0[2], v0[3]); w.z = cvt_pk_bf16(v1[0], v1[1]); w.w = cvt_pk_bf16(v1[2], v1[3]);
                    st_remap(stg, fr, fq, lane, w, blk + bj * HALF, ldc); } }
    }
};
template <bool ADD_PREV> struct EpiGate {
    static constexpr bool PERM = true, AFTER_DRAIN = false;
    bf16_t* O; int ldc; const bf16_t* G; int ldg; const bf16_t* P;
    __device__ __forceinline__ void operator()(const f32x4 (&acc)[2][2][4][2], const Unit& u, int wr, int wc, int fr, int fq, PG8_LAS unsigned char* stg, int lane) const {
        const int rowb = u.pm * BM + wr * 64, colb = u.pn * BM + wc * 32;
        const int row0 = rowb + fr, col0 = colb + 8 * fq;
        u32x4 gv[2][4], pv[2][4];
#define PG8_EG_LOAD(g, b) do { _Pragma("unroll") for (int mm = 0; mm < 2; ++mm) _Pragma("unroll") for (int bj = 0; bj < 2; ++bj) { \
            const size_t r_ = (size_t)(row0 + ((g) >> 1) * HALF + (((g) & 1) * 2 + mm) * 16); \
            gv[b][mm * 2 + bj] = *(const PG8_GAS u32x4*)((const PG8_GAS bf16_t*)G + r_ * ldg + col0 + bj * HALF); \
            if (ADD_PREV) pv[b][mm * 2 + bj] = *(const PG8_GAS u32x4*)((const PG8_GAS bf16_t*)P + r_ * ldc + col0 + bj * HALF); } } while (0)
#define PG8_EG_PROC(g, b) do { _Pragma("unroll") for (int mm = 0; mm < 2; ++mm) _Pragma("unroll") for (int bj = 0; bj < 2; ++bj) { \
            const int ai_ = (g) >> 1, m_ = ((g) & 1) * 2 + mm; \
            f32x4 v0 = acc[ai_][bj][m_][0], v1 = acc[ai_][bj][m_][1]; const u32x4 g_ = gv[b][mm * 2 + bj]; \
            v0[0] *= bf_lo(g_.x); v0[1] *= bf_hi(g_.x); v0[2] *= bf_lo(g_.y); v0[3] *= bf_hi(g_.y); v1[0] *= bf_lo(g_.z); v1[1] *= bf_hi(g_.z); v1[2] *= bf_lo(g_.w); v1[3] *= bf_hi(g_.w); \
            if (ADD_PREV) { const u32x4 p_ = pv[b][mm * 2 + bj]; \
                v0[0] += bf_lo(p_.x); v0[1] += bf_hi(p_.x); v0[2] += bf_lo(p_.y); v0[3] += bf_hi(p_.y); v1[0] += bf_lo(p_.z); v1[1] += bf_hi(p_.z); v1[2] += bf_lo(p_.w); v1[3] += bf_hi(p_.w); } \
            u32x4 w_; w_.x = cvt_pk_bf16(v0[0], v0[1]); w_.y = cvt_pk_bf16(v0[2], v0[3]); w_.z = cvt_pk_bf16(v1[0], v1[1]); w_.w = cvt_pk_bf16(v1[2], v1[3]); \
            st_remap(stg, fr, fq, lane, w_, (PG8_GAS bf16_t*)O + (size_t)(rowb + ai_ * HALF + m_ * 16) * ldc + colb + bj * HALF, ldc); } } while (0)
        PG8_EG_LOAD(0, 0); PG8_EG_LOAD(1, 1);
        PG8_EG_PROC(0, 0); PG8_EG_LOAD(2, 0);
        PG8_EG_PROC(1, 1); PG8_EG_LOAD(3, 1);
        PG8_EG_PROC(2, 0); PG8_EG_PROC(3, 1);
#undef PG8_EG_LOAD
#undef PG8_EG_PROC
    }
};

template <class Epi, class Sched, bool ALIGN_EPI, bool I8 = false>
__device__ __forceinline__ void gemm_phase(PG8_LAS unsigned char* lds, const Gemm g, const Sched& S, const Epi& E) {
    int tid_ = threadIdx.x; asm volatile("" : "+v"(tid_));
    const int tid = tid_, wid = __builtin_amdgcn_readfirstlane(tid >> 6), lane = tid & 63, wr = wid >> 2, wc = wid & 3, fr = lane & 15, fq = lane >> 4;
    const int K = g.K, nt = K / BK;
    unsigned voffA[2], voffB[2];
#pragma unroll
    for (int i = 0; i < 2; ++i) { int R, C; stage_rc(tid * 16 + i * 8192, R, C); const int Rb = Epi::PERM ? ((R & ~31) + perm32(R & 31)) : R;
        voffA[i] = (unsigned)(R * g.lda + C) * 2u; voffB[i] = (unsigned)(Rb * g.ldb + C) * 2u; }
    const size_t kstep = (size_t)(BK * 2);
    const size_t hstepA = (size_t)HALF * g.lda * 2, hstepB = (size_t)HALF * g.ldb * 2;
    const size_t tstepA = 2 * hstepA, tstepB = 2 * hstepB;
    const unsigned ldsw = (unsigned)wid * 1024u;
    const int aoff0 = lds_byte(wr * 64 + fr, fq * 8), aoff1 = lds_byte(wr * 64 + fr, 32 + fq * 8), boff0 = lds_byte(wc * 32 + fr, fq * 8), boff1 = lds_byte(wc * 32 + fr, 32 + fq * 8);
#define PG8_SA(b, h) (((b) * 2 + (h)) * HTB)
#define PG8_SB(b, h) ((4 + (b) * 2 + (h)) * HTB)
#define PG8_STAGE(bufoff, gbase, voff) do { _Pragma("unroll") for (int _i = 0; _i < 2; ++_i) \
        __builtin_amdgcn_global_load_lds((const unsigned*)((const char*)(gbase) + (voff)[_i]), (PG8_LAS unsigned*)(lds + (bufoff) + ldsw + _i * 8192), 16, 0, 0); } while (0)
#define PG8_LDA(dst, b, h) do { _Pragma("unroll") for (int m = 0; m < 4; ++m) _Pragma("unroll") for (int k = 0; k < 2; ++k) dst[m][k] = *(const PG8_LAS bf16x8*)(lds + PG8_SA(b, h) + (k ? aoff1 : aoff0) + m * 2048); } while (0)
#define PG8_LDB(dst, b, h) do { _Pragma("unroll") for (int n = 0; n < 2; ++n) _Pragma("unroll") for (int k = 0; k < 2; ++k) dst[n][k] = *(const PG8_LAS bf16x8*)(lds + PG8_SB(b, h) + (k ? boff1 : boff0) + n * 2048); } while (0)
#define PG8_MMA(ai, bj, At, Bt) do { __builtin_amdgcn_s_setprio(1); _Pragma("unroll") for (int m = 0; m < 4; ++m) _Pragma("unroll") for (int n = 0; n < 2; ++n) _Pragma("unroll") for (int k = 0; k < 2; ++k) \
        { if (I8) acc[ai][bj][m][n] = __builtin_bit_cast(f32x4, __builtin_amdgcn_mfma_i32_16x16x64_i8(__builtin_bit_cast(i32x4, Bt[n][k]), __builtin_bit_cast(i32x4, At[m][k]), __builtin_bit_cast(i32x4, acc[ai][bj][m][n]), 0, 0, 0)); \
          else acc[ai][bj][m][n] = __builtin_amdgcn_mfma_f32_16x16x32_bf16(Bt[n][k], At[m][k], acc[ai][bj][m][n], 0, 0, 0); } __builtin_amdgcn_s_setprio(0); } while (0)
#define PG8_WAIT_V(n) asm volatile("s_waitcnt vmcnt(" #n ")" ::: "memory")
#define PG8_WAIT_L(n) asm volatile("s_waitcnt lgkmcnt(" #n ")" ::: "memory")
#define PG8_BAR __builtin_amdgcn_s_barrier()
#define PG8_SCHED __builtin_amdgcn_sched_barrier(0)
    Unit cur, nxt; int ui = 0;
    if (!S.next(0, cur)) return;
    f32x4 acc[2][2][4][2];
#pragma unroll
    for (int a = 0; a < 2; ++a)
#pragma unroll
        for (int b = 0; b < 2; ++b)
#pragma unroll
            for (int m = 0; m < 4; ++m)
#pragma unroll
                for (int n = 0; n < 2; ++n) acc[a][b][m][n] = (f32x4){0.f, 0.f, 0.f, 0.f};
    bf16x8 At[4][2], B0[2][2], B1[2][2];
    const char* cA = (const char*)g.A + (size_t)cur.pm * tstepA; const char* cB = (const char*)g.Bt + (size_t)cur.pn * tstepB;
    S.a_ready(cur);
    PG8_STAGE(PG8_SB(0, 0), cB, voffB); PG8_STAGE(PG8_SB(0, 1), cB + hstepB, voffB); PG8_STAGE(PG8_SA(0, 0), cA, voffA); PG8_STAGE(PG8_SA(0, 1), cA + hstepA, voffA);
    if (wr == 1) PG8_BAR;
    PG8_WAIT_V(2); PG8_BAR;
    PG8_STAGE(PG8_SB(1, 0), cB + kstep, voffB); PG8_STAGE(PG8_SA(1, 0), cA + kstep, voffA); PG8_STAGE(PG8_SB(1, 1), cB + hstepB + kstep, voffB);
    PG8_WAIT_V(6); PG8_BAR;
    for (;;) {
        const bool has_next = S.next(ui + 1, nxt);
        const char* nA = has_next ? (const char*)g.A + (size_t)nxt.pm * tstepA : cA; const char* nB = has_next ? (const char*)g.Bt + (size_t)nxt.pn * tstepB : cB;
        for (int t = 0; t < nt; t += 2) {
            const bool last = (t == nt - 2);
            const char* a1 = cA + (size_t)(t + 1) * kstep;
            const char* a2 = last ? nA : cA + (size_t)(t + 2) * kstep; const char* b2 = last ? nB : cB + (size_t)(t + 2) * kstep;
            const char* a3 = a2 + kstep; const char* b3 = b2 + kstep;
            if (last && has_next) S.a_ready(nxt);
            PG8_LDB(B0, 0, 0); PG8_LDB(B1, 0, 1); PG8_SCHED; PG8_LDA(At, 0, 0); PG8_STAGE(PG8_SA(1, 1), a1 + hstepA, voffA);
            PG8_WAIT_V(8); PG8_WAIT_L(0); PG8_BAR; PG8_MMA(0, 0, At, B0); PG8_MMA(0, 1, At, B1); PG8_BAR; PG8_SCHED;
            PG8_LDA(At, 0, 1); PG8_STAGE(PG8_SB(0, 0), b2, voffB); PG8_STAGE(PG8_SB(0, 1), b2 + hstepB, voffB); PG8_STAGE(PG8_SA(0, 0), a2, voffA);
            PG8_WAIT_V(8); PG8_WAIT_L(0); PG8_BAR; PG8_MMA(1, 0, At, B0); PG8_MMA(1, 1, At, B1); PG8_BAR; PG8_SCHED;
            PG8_LDB(B0, 1, 0); PG8_LDB(B1, 1, 1); PG8_SCHED; PG8_LDA(At, 1, 0); PG8_STAGE(PG8_SA(0, 1), a2 + hstepA, voffA);
            PG8_WAIT_V(8); PG8_WAIT_L(0); PG8_BAR; PG8_MMA(0, 0, At, B0); PG8_MMA(0, 1, At, B1); PG8_BAR; PG8_SCHED;
            PG8_LDA(At, 1, 1); PG8_STAGE(PG8_SB(1, 0), b3, voffB); PG8_STAGE(PG8_SB(1, 1), b3 + hstepB, voffB); PG8_STAGE(PG8_SA(1, 0), a3, voffA);
            PG8_WAIT_V(8); PG8_WAIT_L(0); PG8_BAR; PG8_MMA(1, 0, At, B0); PG8_MMA(1, 1, At, B1); PG8_BAR; PG8_SCHED;
        }
        if constexpr (ALIGN_EPI) { if (wr == 0) PG8_BAR; }
        E(acc, cur, wr, wc, fr, fq, lds + STAGE_BYTES + wid * 1024, lane); S.done(cur);
        if (!has_next) break;
#pragma unroll
        for (int a = 0; a < 2; ++a)
#pragma unroll
            for (int b = 0; b < 2; ++b)
#pragma unroll
                for (int m = 0; m < 4; ++m)
#pragma unroll
                    for (int n = 0; n < 2; ++n) acc[a][b][m][n] = (f32x4){0.f, 0.f, 0.f, 0.f};
        cur = nxt; cA = nA; cB = nB; ++ui;
        if constexpr (ALIGN_EPI) { if (wr == 1) PG8_BAR; }
    }
    PG8_WAIT_V(0);
    if constexpr (!ALIGN_EPI) { if (wr == 0) PG8_BAR; }
    PG8_BAR;
#undef PG8_SA
#undef PG8_SB
#undef PG8_STAGE
#undef PG8_LDA
#undef PG8_LDB
#undef PG8_MMA
#undef PG8_WAIT_V
#undef PG8_WAIT_L
#undef PG8_BAR
#undef PG8_SCHED
}
}
#define GAS __attribute__((address_space(1)))
#define LAS __attribute__((address_space(3)))
typedef unsigned short bf16;
typedef unsigned v4u __attribute__((ext_vector_type(4)));
typedef float f32x4 __attribute__((ext_vector_type(4)));
typedef short bf16x8 __attribute__((ext_vector_type(8)));
typedef GAS unsigned gu32;
typedef GAS unsigned long long gu64;
#define RLX_AGENT __ATOMIC_RELAXED, __HIP_MEMORY_SCOPE_AGENT
#define LDS_WAIT() asm volatile("s_waitcnt lgkmcnt(0)" ::: "memory")
#define VM_WAIT() asm volatile("s_waitcnt vmcnt(0)" ::: "memory")
__device__ __forceinline__ unsigned long long rt() { return __builtin_amdgcn_s_memrealtime(); }
__device__ __forceinline__ unsigned f2bf(float f) { unsigned u = __builtin_bit_cast(unsigned, f); return (u + 0x7fffu + ((u >> 16) & 1u)) >> 16; }
__device__ __forceinline__ unsigned pk2(float lo, float hi) { return f2bf(lo) | (f2bf(hi) << 16); }

#define XB_TMO      128
#define XB_XCNT(j)  (256  + 64 * (j))
#define XB_XSUB(j)  (1280 + 64 * (j))
#define XB_XGEN(j)  (2304 + 64 * (j))
#define XB_TOP      3328
#define XB_TOPGEN   3392
#define XCD_BAR_WORDS 3456
#define XB_SPIN_CAP (1u << 18)

__device__ __forceinline__ unsigned xb_ld(unsigned* p)              { return __hip_atomic_load(p, __ATOMIC_RELAXED, __HIP_MEMORY_SCOPE_AGENT); }
__device__ __forceinline__ unsigned xb_add(unsigned* p, unsigned v) { return __hip_atomic_fetch_add(p, v, __ATOMIC_RELAXED, __HIP_MEMORY_SCOPE_AGENT); }
__device__ __forceinline__ unsigned xb_xcc_id() { return (unsigned)__builtin_amdgcn_s_getreg((3 << 11) | 20) & 0xFu; }
#define XB_SPIN(cond, bar) do { unsigned _sp = 0; while (cond) { __builtin_amdgcn_s_sleep(1); \
    if ((++_sp & 255u) == 0u) { if (xb_ld(&(bar)[XB_TMO])) break; if (_sp > XB_SPIN_CAP) { atomicAdd(&(bar)[XB_TMO], 1u); break; } } } } while (0)

struct XcdBarrier {
    unsigned* bar; unsigned x;
    volatile LAS unsigned* st;
};

__device__ __forceinline__ XcdBarrier xcd_barrier_post(unsigned* bar, volatile LAS unsigned* st) {
    XcdBarrier b; b.bar = bar; b.x = xb_xcc_id(); b.st = st;
    if (threadIdx.x == 0) (void)xb_add(&bar[XB_XCNT(b.x)], 1u);
    return b;
}
__device__ __forceinline__ void xcd_barrier_complete(unsigned* bar, unsigned x, unsigned& nloc, unsigned& nx) {
    const unsigned G = gridDim.x * gridDim.y * gridDim.z;
    unsigned sum, cnt, mine, sp = 0u;
    for (;;) {
        sum = 0u; cnt = 0u; mine = 0u;
#pragma unroll
        for (unsigned j = 0; j < 16; ++j) { const unsigned c = xb_ld(&bar[XB_XCNT(j)]); sum += c; cnt += (c > 0u) ? 1u : 0u; mine = (j == x) ? c : mine; }
        if (sum == G) break;
        __builtin_amdgcn_s_sleep(1);
        if ((++sp & 255u) == 0u) { if (xb_ld(&bar[XB_TMO])) break; if (sp > XB_SPIN_CAP) { atomicAdd(&bar[XB_TMO], 1u); break; } }
    }
    nloc = mine > 0u ? mine : 1u; nx = cnt > 0u ? cnt : 1u;
}

__device__ __forceinline__ void xcd_barrier(const XcdBarrier& b) {
    asm volatile("s_waitcnt vmcnt(0)" ::: "memory");
    __syncthreads();
    if (threadIdx.x == 0) {
        unsigned* bar = b.bar;
        __builtin_amdgcn_s_waitcnt(0);
        unsigned nloc = b.st[0], nx = b.st[1];
        if (nloc == 0u) { xcd_barrier_complete(bar, b.x, nloc, nx); b.st[0] = nloc; b.st[1] = nx; }
        const unsigned old = xb_add(&bar[XB_XSUB(b.x)], 1u);
        const unsigned gen = old / nloc;
        if (old + 1u == (gen + 1u) * nloc) {
            __builtin_amdgcn_fence(__ATOMIC_RELEASE, "agent");
            asm volatile("s_waitcnt vmcnt(0)" ::: "memory");
            const unsigned og = xb_add(&bar[XB_TOP], 1u);
            const unsigned tg = og / nx;
            if (og + 1u == (tg + 1u) * nx) xb_add(&bar[XB_TOPGEN], 1u);
            else XB_SPIN(xb_ld(&bar[XB_TOPGEN]) == tg, bar);
            __builtin_amdgcn_fence(__ATOMIC_ACQUIRE, "agent");
            xb_add(&bar[XB_XGEN(b.x)], 1u);
            asm volatile("s_waitcnt vmcnt(0)" ::: "memory");
        } else {
            XB_SPIN(xb_ld(&bar[XB_XGEN(b.x)]) == gen, bar);
            __builtin_amdgcn_fence(__ATOMIC_ACQUIRE, "agent");
            asm volatile("s_waitcnt vmcnt(0)" ::: "memory");
        }
    }
    __syncthreads();
}

constexpr int NWAVES = 8;
constexpr int RING_OFF = 0, RING_BYTES = 131072;
constexpr int LDSCTL_OFF = 143360, MISC_OFF = LDSCTL_OFF + 320;
constexpr int LDS_BYTES = 147456;
static_assert(MISC_OFF + 128 <= LDS_BYTES, "LDS map");

struct Frame {
    LAS unsigned char* lds;
    volatile LAS unsigned* MISC;
    gu32* ctl;
    int tid, lane, wave;
    int vcu, G;
};
__device__ __forceinline__ float wave_sum(float v) {
#pragma unroll
    for (int o = 1; o < 64; o <<= 1) v += __shfl_xor(v, o);
    return v;
}

__device__ __forceinline__ float wave_max(float v) {
#pragma unroll
    for (int o = 1; o < 64; o <<= 1) v = fmaxf(v, __shfl_xor(v, o));
    return v;
}
__device__ __forceinline__ unsigned q8pack4(float a, float b, float c, float d) {
    const int ia = (int)__builtin_rintf(a), ib = (int)__builtin_rintf(b), ic = (int)__builtin_rintf(c), id = (int)__builtin_rintf(d);
    return (unsigned)(ia & 255) | ((unsigned)(ib & 255) << 8) | ((unsigned)(ic & 255) << 16) | ((unsigned)(id & 255) << 24);
}
__device__ __forceinline__ void transpose_item(const float* __restrict__ W, int K, int N, bf16* __restrict__ WT, LAS float* scr, int kb, int nb, int lane, const float* __restrict__ gain) {
    const int k0 = 64 * kb, n0 = 64 * nb;
    f32x4 v[16];
#pragma unroll
    for (int i = 0; i < 16; ++i) { const int kk = 4 * i + (lane >> 4); v[i] = *(const f32x4*)(W + (size_t)(k0 + kk) * N + n0 + 4 * (lane & 15)); }
    if (gain) {
#pragma unroll
        for (int i = 0; i < 16; ++i) v[i] = v[i] * gain[k0 + 4 * i + (lane >> 4)]; }
#pragma unroll
    for (int i = 0; i < 16; ++i) { const int kk = 4 * i + (lane >> 4); LAS float* d = scr + kk * 65 + 4 * (lane & 15); d[0] = v[i].x; d[1] = v[i].y; d[2] = v[i].z; d[3] = v[i].w; }
    LDS_WAIT(); asm volatile("" ::: "memory");
    const int c = lane & 7;
#pragma unroll
    for (int j = 0; j < 8; ++j) { const int n = (lane >> 3) + 8 * j; const LAS float* s = scr + (8 * c) * 65 + n;
        v4u o; o.x = pk2(s[0 * 65], s[1 * 65]); o.y = pk2(s[2 * 65], s[3 * 65]); o.z = pk2(s[4 * 65], s[5 * 65]); o.w = pk2(s[6 * 65], s[7 * 65]);
        *(GAS v4u*)(WT + (size_t)(n0 + n) * K + k0 + 8 * c) = o; }
    LDS_WAIT(); asm volatile("" ::: "memory");
}

struct Ptrs {
    const float* x; const float* meta; const float* relb; const float* w_in; const float* w_a; const float* w_b; const float* w_out;
    const float* lq1; const float* lk1; const float* lq2; const float* lk2; const float* dnorm; const float* sinks;
    const float* n_attn_pre; const float* n_attn_post; const float* w_ff1; const float* w_ff2; const float* n_ff_pre; const float* n_ff_post;
    float* out; unsigned char* ws;
};

typedef const __attribute__((address_space(4))) Ptrs* CPtrs;
__device__ __forceinline__ int qcol0(int nb) { return nb < 16 ? C_VA + 64 * nb : C_GA + 64 * (nb - 16); }
__device__ __forceinline__ void gate_colmax_pass(Frame& F, const float* __restrict__ w_in, const float* __restrict__ g_in, unsigned* __restrict__ cmax) {
    const int lane = F.lane, w = F.wave;
    LAS f32x4* part = (LAS f32x4*)F.lds;
    for (int it = F.vcu; it < DEPTH * 80; it += F.G) {
        const int l = it / 80, nb = it % 80;
        const float* W = w_in + (size_t)l * DM * INW + qcol0(nb) + 4 * (lane & 15); const float* g = g_in + l * DM;
        f32x4 m = (f32x4){0.f, 0.f, 0.f, 0.f};
        for (int kb = 4 * w; kb < 4 * w + 4; ++kb) {
#pragma unroll
            for (int i = 0; i < 16; ++i) { const int kk = 64 * kb + 4 * i + (lane >> 4); const f32x4 v = *(const f32x4*)(W + (size_t)kk * INW) * g[kk];
                m.x = fmaxf(m.x, fabsf(v.x)); m.y = fmaxf(m.y, fabsf(v.y)); m.z = fmaxf(m.z, fabsf(v.z)); m.w = fmaxf(m.w, fabsf(v.w)); } }
#pragma unroll
        for (int o = 16; o < 64; o <<= 1) { m.x = fmaxf(m.x, __shfl_xor(m.x, o)); m.y = fmaxf(m.y, __shfl_xor(m.y, o)); m.z = fmaxf(m.z, __shfl_xor(m.z, o)); m.w = fmaxf(m.w, __shfl_xor(m.w, o)); }
        if (lane < 16) part[w * 16 + lane] = m;
        __syncthreads();
        if (w == 0 && lane < 16) { f32x4 t = part[lane];
#pragma unroll
            for (int j = 1; j < 8; ++j) { const f32x4 q = part[j * 16 + lane]; t.x = fmaxf(t.x, q.x); t.y = fmaxf(t.y, q.y); t.z = fmaxf(t.z, q.z); t.w = fmaxf(t.w, q.w); }
            unsigned* c = cmax + l * NQ + 64 * nb + 4 * lane; c[0] = __float_as_uint(t.x); c[1] = __float_as_uint(t.y); c[2] = __float_as_uint(t.z); c[3] = __float_as_uint(t.w); }
        __syncthreads();
    }
}
__device__ __forceinline__ void gate_quant_item(const float* __restrict__ W, signed char* __restrict__ WQ, const unsigned* __restrict__ cmax, float* __restrict__ cs, LAS float* scr, int kb, int nb, int lane, const float* __restrict__ gain) {
    const int k0 = 64 * kb, n0 = 64 * nb;
    f32x4 v[16];
#pragma unroll
    for (int i = 0; i < 16; ++i) { const int kk = 4 * i + (lane >> 4); v[i] = *(const f32x4*)(W + (size_t)(k0 + kk) * INW + qcol0(nb) + 4 * (lane & 15)) * gain[k0 + kk]; }
#pragma unroll
    for (int i = 0; i < 16; ++i) { const int kk = 4 * i + (lane >> 4); LAS float* d = scr + kk * 65 + 4 * (lane & 15); d[0] = v[i].x; d[1] = v[i].y; d[2] = v[i].z; d[3] = v[i].w; }
    LDS_WAIT(); asm volatile("" ::: "memory");
    const int c = lane & 7;
#pragma unroll
    for (int j = 0; j < 8; ++j) { const int n = (lane >> 3) + 8 * j; const LAS float* s = scr + (8 * c) * 65 + n;
        const float mx = __uint_as_float(cmax[n0 + n]), inv = mx > 0.f ? 127.f / mx : 0.f;
        typedef unsigned u32x2 __attribute__((ext_vector_type(2))); u32x2 o;
        o.x = q8pack4(s[0 * 65] * inv, s[1 * 65] * inv, s[2 * 65] * inv, s[3 * 65] * inv); o.y = q8pack4(s[4 * 65] * inv, s[5 * 65] * inv, s[6 * 65] * inv, s[7 * 65] * inv);
        *(GAS u32x2*)(WQ + (size_t)(n0 + n) * DM + k0 + 8 * c) = o;
        if (kb == 0 && c == 0) cs[n0 + n] = mx * (1.f / 127.f); }
    LDS_WAIT(); asm volatile("" ::: "memory");
}
__device__ __forceinline__ void gate_quant_pass(Frame& F, const float* __restrict__ w_in, const float* __restrict__ g_in, signed char* __restrict__ wq, const unsigned* __restrict__ cmax, float* __restrict__ cs) {
    LAS float* scr = (LAS float*)(F.lds + F.wave * 16640);
    const int gw = F.vcu * NWAVES + F.wave, NGW = F.G * NWAVES;
    for (int it = gw; it < DEPTH * 16 * 80; it += NGW) {
        const int l = it / (16 * 80), kb2 = (it / 80) % 16, nb = it % 80;
        gate_quant_item(w_in + (size_t)l * DM * INW, wq + (size_t)l * NQ * DM, cmax + l * NQ, cs + l * NQ, scr, 2 * kb2, nb, F.lane, g_in + l * DM);
        gate_quant_item(w_in + (size_t)l * DM * INW, wq + (size_t)l * NQ * DM, cmax + l * NQ, cs + l * NQ, scr, 2 * kb2 + 1, nb, F.lane, g_in + l * DM);
    }
}
__device__ __forceinline__ void p0_transposes(Frame& F, CPtrs PPk) {
    struct { const float *w_in, *w_a, *w_b, *w_out, *w_ff1, *w_ff2, *g_in, *g_ff; unsigned char* ws; } P = {PPk->w_in, PPk->w_a, PPk->w_b, PPk->w_out, PPk->w_ff1, PPk->w_ff2, PPk->n_attn_pre, PPk->n_ff_pre, PPk->ws};
    LAS float* scr = (LAS float*)(F.lds + F.wave * 16640);
    const int gw = F.vcu * NWAVES + F.wave, NGW = F.G * NWAVES;
    constexpr int I_IN = 32 * 132, I_A = 16 * 32, I_O = 32 * 32, I_1 = 32 * 128, I_2 = 128 * 32, I_L = I_IN + 2 * I_A + I_O + I_1 + I_2;
    asm volatile("" ::: "memory");
    bf16* ws_in = (bf16*)(P.ws + WS_WIN); bf16* ws_a = (bf16*)(P.ws + WS_WA); bf16* ws_b = (bf16*)(P.ws + WS_WB); bf16* ws_o = (bf16*)(P.ws + WS_WOUT);
    bf16* ws_1 = (bf16*)(P.ws + WS_W1); bf16* ws_2 = (bf16*)(P.ws + WS_W2);
    for (int it = gw; it < DEPTH * I_L; it += NGW) {
        const int l = it / I_L; int r = it % I_L;
        if (r < I_IN) { transpose_item(P.w_in + (size_t)l * DM * INW, DM, INW, ws_in + (size_t)l * INW * DM, scr, r / 132, r % 132, F.lane, P.g_in + l * DM); continue; } r -= I_IN;
        if (r < I_A) { transpose_item(P.w_a + (size_t)l * 1024 * DM, 1024, DM, ws_a + (size_t)l * DM * 1024, scr, r / 32, r % 32, F.lane, nullptr); continue; } r -= I_A;
        if (r < I_A) { transpose_item(P.w_b + (size_t)l * 1024 * DM, 1024, DM, ws_b + (size_t)l * DM * 1024, scr, r / 32, r % 32, F.lane, nullptr); continue; } r -= I_A;
        if (r < I_O) { transpose_item(P.w_out + (size_t)l * DM * DM, DM, DM, ws_o + (size_t)l * DM * DM, scr, r / 32, r % 32, F.lane, nullptr); continue; } r -= I_O;
        if (r < I_1) { transpose_item(P.w_ff1 + (size_t)l * DM * DFF, DM, DFF, ws_1 + (size_t)l * DFF * DM, scr, r / 128, r % 128, F.lane, P.g_ff + l * DM); continue; } r -= I_1;
        transpose_item(P.w_ff2 + (size_t)l * DFF * DM, DFF, DM, ws_2 + (size_t)l * DM * DFF, scr, r / 32, r % 32, F.lane, nullptr);
    }
}

template <bool HAS_T, bool WRITE_U>
__device__ __forceinline__ void norm_phase(Frame& F, const float* hin_real, const float* hin_meta, float* hout_real, float* hout_meta,
                                           const bf16* T, const float* gpost, const float* gpre, bf16* U, int nrows = NROWS) {
    asm volatile("" : "+s"(hin_real), "+s"(hin_meta), "+s"(hout_real), "+s"(hout_meta), "+s"(T), "+s"(U));
    LAS float* gp = (LAS float*)(F.lds); LAS float* gq = gp + 2048;
    for (int i = F.tid; i < 2048; i += NWAVES * 64) { gp[i] = HAS_T ? gpost[i] : 0.f; gq[i] = WRITE_U ? gpre[i] : 0.f; }
    __syncthreads();
    const int gw = F.vcu * NWAVES + F.wave, NGW = F.G * NWAVES;
    for (int row = gw; row < nrows; row += NGW) {
        const bool real = row < ROW_META;
        const float* hr = real ? hin_real + (size_t)row * DM : hin_meta + (size_t)(row - ROW_META) * DM;
        float* ho = real ? (hout_real ? hout_real + (size_t)row * DM : nullptr) : hout_meta + (size_t)(row - ROW_META) * DM;
        f32x4 hv[4][2]; v4u tv[4];
#pragma unroll
        for (int k = 0; k < 4; ++k) { const int ci = F.lane + 64 * k;
            if (HAS_T) tv[k] = *(const GAS v4u*)(T + (size_t)row * DM + 8 * ci);
            hv[k][0] = *(const GAS f32x4*)(hr + 8 * ci); hv[k][1] = *(const GAS f32x4*)(hr + 8 * ci + 4); }
        if (HAS_T) {
            float ss = 0.f; float tf[4][8];
#pragma unroll
            for (int k = 0; k < 4; ++k) {
                tf[k][0] = pg8::bf_lo(tv[k].x); tf[k][1] = pg8::bf_hi(tv[k].x); tf[k][2] = pg8::bf_lo(tv[k].y); tf[k][3] = pg8::bf_hi(tv[k].y);
                tf[k][4] = pg8::bf_lo(tv[k].z); tf[k][5] = pg8::bf_hi(tv[k].z); tf[k][6] = pg8::bf_lo(tv[k].w); tf[k][7] = pg8::bf_hi(tv[k].w);
#pragma unroll
                for (int e = 0; e < 8; ++e) ss += tf[k][e] * tf[k][e]; }
            const float rstd = 1.0f / sqrtf(wave_sum(ss) * (1.f / DM) + EPS);
#pragma unroll
            for (int k = 0; k < 4; ++k) { const int ci = F.lane + 64 * k; const f32x4 g0 = *(const LAS f32x4*)(gp + 8 * ci), g1 = *(const LAS f32x4*)(gp + 8 * ci + 4);
                hv[k][0].x += tf[k][0] * rstd * g0.x; hv[k][0].y += tf[k][1] * rstd * g0.y; hv[k][0].z += tf[k][2] * rstd * g0.z; hv[k][0].w += tf[k][3] * rstd * g0.w;
                hv[k][1].x += tf[k][4] * rstd * g1.x; hv[k][1].y += tf[k][5] * rstd * g1.y; hv[k][1].z += tf[k][6] * rstd * g1.z; hv[k][1].w += tf[k][7] * rstd * g1.w; }
        }
        if (ho) {
#pragma unroll
            for (int k = 0; k < 4; ++k) { const int ci = F.lane + 64 * k; *(GAS f32x4*)(ho + 8 * ci) = hv[k][0]; *(GAS f32x4*)(ho + 8 * ci + 4) = hv[k][1]; }
        }
        if (WRITE_U) {
            float ss = 0.f;
#pragma unroll
            for (int k = 0; k < 4; ++k) ss += (hv[k][0].x * hv[k][0].x + hv[k][0].y * hv[k][0].y) + (hv[k][0].z * hv[k][0].z + hv[k][0].w * hv[k][0].w)
                                            + (hv[k][1].x * hv[k][1].x + hv[k][1].y * hv[k][1].y) + (hv[k][1].z * hv[k][1].z + hv[k][1].w * hv[k][1].w);
            const float rstd = 1.0f / sqrtf(wave_sum(ss) * (1.f / DM) + EPS);
#pragma unroll
            for (int k = 0; k < 4; ++k) { const int ci = F.lane + 64 * k; const f32x4 g0 = *(const LAS f32x4*)(gq + 8 * ci), g1 = *(const LAS f32x4*)(gq + 8 * ci + 4);
                v4u o; o.x = pk2(hv[k][0].x * rstd * g0.x, hv[k][0].y * rstd * g0.y); o.y = pk2(hv[k][0].z * rstd * g0.z, hv[k][0].w * rstd * g0.w);
                o.z = pk2(hv[k][1].x * rstd * g1.x, hv[k][1].y * rstd * g1.y); o.w = pk2(hv[k][1].z * rstd * g1.z, hv[k][1].w * rstd * g1.w);
                *(GAS v4u*)(U + (size_t)row * DM + 8 * ci) = o; }
        }
    }
    __syncthreads();
}


template <int MODE>
__device__ __forceinline__ void resid_phase(Frame& F, const float* x, const float* meta, bf16* H, float* RS, const bf16* T, const float* gpost, float* out, signed char* HQ = nullptr, float* QS = nullptr) {
    asm volatile("" : "+s"(x), "+s"(meta), "+s"(H), "+s"(RS), "+s"(T), "+s"(out));
    LAS float* gp = (LAS float*)(F.lds);
    if (MODE != 0) { for (int i = F.tid; i < 2048; i += NWAVES * 64) gp[i] = gpost[i]; }
    __syncthreads();
    const int gw = F.vcu * NWAVES + F.wave, NGW = F.G * NWAVES;
    const int nrows = (MODE == 2) ? ROW_META : NROWS;
    for (int row = gw; row < nrows; row += NGW) {
        f32x4 hv[4][2];
        if (MODE == 0) {
            const float* hr = row < ROW_META ? x + (size_t)row * DM : meta + (size_t)(row - ROW_META) * DM;
#pragma unroll
            for (int k = 0; k < 4; ++k) { const int ci = F.lane + 64 * k; hv[k][0] = *(const GAS f32x4*)(hr + 8 * ci); hv[k][1] = *(const GAS f32x4*)(hr + 8 * ci + 4); }
        } else {
            v4u tv[4], hb[4];
#pragma unroll
            for (int k = 0; k < 4; ++k) { const int ci = F.lane + 64 * k; tv[k] = *(const GAS v4u*)(T + (size_t)row * DM + 8 * ci); hb[k] = *(const GAS v4u*)(H + (size_t)row * DM + 8 * ci); }
            float ss = 0.f; float tf[4][8];
#pragma unroll
            for (int k = 0; k < 4; ++k) {
                tf[k][0] = pg8::bf_lo(tv[k].x); tf[k][1] = pg8::bf_hi(tv[k].x); tf[k][2] = pg8::bf_lo(tv[k].y); tf[k][3] = pg8::bf_hi(tv[k].y);
                tf[k][4] = pg8::bf_lo(tv[k].z); tf[k][5] = pg8::bf_hi(tv[k].z); tf[k][6] = pg8::bf_lo(tv[k].w); tf[k][7] = pg8::bf_hi(tv[k].w);
#pragma unroll
                for (int e = 0; e < 8; ++e) ss += tf[k][e] * tf[k][e]; }
            const float rstd = 1.0f / sqrtf(wave_sum(ss) * (1.f / DM) + EPS);
#pragma unroll
            for (int k = 0; k < 4; ++k) { const int ci = F.lane + 64 * k; const f32x4 g0 = *(const LAS f32x4*)(gp + 8 * ci), g1 = *(const LAS f32x4*)(gp + 8 * ci + 4);
                hv[k][0].x = pg8::bf_lo(hb[k].x) + tf[k][0] * rstd * g0.x; hv[k][0].y = pg8::bf_hi(hb[k].x) + tf[k][1] * rstd * g0.y; hv[k][0].z = pg8::bf_lo(hb[k].y) + tf[k][2] * rstd * g0.z; hv[k][0].w = pg8::bf_hi(hb[k].y) + tf[k][3] * rstd * g0.w;
                hv[k][1].x = pg8::bf_lo(hb[k].z) + tf[k][4] * rstd * g1.x; hv[k][1].y = pg8::bf_hi(hb[k].z) + tf[k][5] * rstd * g1.y; hv[k][1].z = pg8::bf_lo(hb[k].w) + tf[k][6] * rstd * g1.z; hv[k][1].w = pg8::bf_hi(hb[k].w) + tf[k][7] * rstd * g1.w; }
        }
        if (MODE == 2) {
            float* ho = out + (size_t)row * DM;
#pragma unroll
            for (int k = 0; k < 4; ++k) { const int ci = F.lane + 64 * k; *(GAS f32x4*)(ho + 8 * ci) = hv[k][0]; *(GAS f32x4*)(ho + 8 * ci + 4) = hv[k][1]; }
        } else {
            float ss = 0.f;
#pragma unroll
            for (int k = 0; k < 4; ++k) ss += (hv[k][0].x * hv[k][0].x + hv[k][0].y * hv[k][0].y) + (hv[k][0].z * hv[k][0].z + hv[k][0].w * hv[k][0].w)
                                            + (hv[k][1].x * hv[k][1].x + hv[k][1].y * hv[k][1].y) + (hv[k][1].z * hv[k][1].z + hv[k][1].w * hv[k][1].w);
            const float rstd = 1.0f / sqrtf(wave_sum(ss) * (1.f / DM) + EPS);
            if (F.lane == 0) RS[row] = rstd;
            if (HQ) {
                float am = 0.f;
#pragma unroll
                for (int k = 0; k < 4; ++k) am = fmaxf(fmaxf(fmaxf(am, fmaxf(fabsf(hv[k][0].x), fabsf(hv[k][0].y))), fmaxf(fabsf(hv[k][0].z), fabsf(hv[k][0].w))), fmaxf(fmaxf(fabsf(hv[k][1].x), fabsf(hv[k][1].y)), fmaxf(fabsf(hv[k][1].z), fabsf(hv[k][1].w))));
                am = wave_max(am);
                const float inv = am > 0.f ? 127.f / am : 0.f;
                if (F.lane == 0) QS[row] = rstd * am * (1.f / 127.f);
#pragma unroll
                for (int k = 0; k < 4; ++k) { const int ci = F.lane + 64 * k; typedef unsigned u32x2 __attribute__((ext_vector_type(2))); u32x2 o;
                    o.x = q8pack4(hv[k][0].x * inv, hv[k][0].y * inv, hv[k][0].z * inv, hv[k][0].w * inv); o.y = q8pack4(hv[k][1].x * inv, hv[k][1].y * inv, hv[k][1].z * inv, hv[k][1].w * inv);
                    *(GAS u32x2*)(HQ + (size_t)row * DM + 8 * ci) = o; }
            }
#pragma unroll
            for (int k = 0; k < 4; ++k) { const int ci = F.lane + 64 * k;
                v4u o; o.x = pk2(hv[k][0].x, hv[k][0].y); o.y = pk2(hv[k][0].z, hv[k][0].w); o.z = pk2(hv[k][1].x, hv[k][1].y); o.w = pk2(hv[k][1].z, hv[k][1].w);
                *(GAS v4u*)(H + (size_t)row * DM + 8 * ci) = o; }
        }
    }
    __syncthreads();
}

template <class Epi>
__device__ __forceinline__ void meta_gemm(LAS unsigned char* lds, const bf16* A, int lda, const bf16* Bt, int ldb, int N, int K, int vcu, int G, int tid, const Epi& E) {
    const int lane = tid & 63, w = __builtin_amdgcn_readfirstlane(tid >> 6), fr = lane & 15, fq = lane >> 4;
    const int kw = K >> 3;
    LAS f32x4* part = (LAS f32x4*)lds;
    for (int tile = vcu; tile < (N >> 4); tile += G) {
        const bf16* ap = A + (size_t)fr * lda + w * kw + 8 * fq;
        const bf16* bp = Bt + (size_t)(tile * 16 + fr) * ldb + w * kw + 8 * fq;
        f32x4 acc = (f32x4){0.f, 0.f, 0.f, 0.f};
        for (int k = 0; k < kw; k += 128) {
            bf16x8 a[4], b[4];
#pragma unroll
            for (int j = 0; j < 4; ++j) { a[j] = *(const GAS bf16x8*)(ap + k + 32 * j); b[j] = *(const GAS bf16x8*)(bp + k + 32 * j); }
#pragma unroll
            for (int j = 0; j < 4; ++j) acc = __builtin_amdgcn_mfma_f32_16x16x32_bf16(b[j], a[j], acc, 0, 0, 0);
        }
        part[w * 64 + lane] = acc;
        __syncthreads();
        if (w == 0) { f32x4 s = part[lane];
#pragma unroll
            for (int j = 1; j < 8; ++j) s += part[j * 64 + lane];
            E(fr, tile * 16 + 4 * fq, s); }
        __syncthreads();
    }
}
__device__ __forceinline__ void st4bf(bf16* p, f32x4 v) { typedef unsigned u32x2 __attribute__((ext_vector_type(2))); u32x2 o; o.x = pk2(v.x, v.y); o.y = pk2(v.z, v.w); *(GAS u32x2*)p = o; }
__device__ __forceinline__ f32x4 ld4bf(const bf16* p) { typedef unsigned u32x2 __attribute__((ext_vector_type(2))); const u32x2 u = *(const GAS u32x2*)p; return (f32x4){pg8::bf_lo(u.x), pg8::bf_hi(u.x), pg8::bf_lo(u.y), pg8::bf_hi(u.y)}; }
struct MEpiZ { bf16* Z; const float* rs; __device__ __forceinline__ void operator()(int r, int c, f32x4 v) const {
    v = v * rs[ROW_META + r];
    if (c < 1024 || (c >= 3072 && c < 4096)) v = v * QSCALE;
    else if (c >= C_GA) { v.x = pg8::sigmoidf_fast(v.x); v.y = pg8::sigmoidf_fast(v.y); v.z = pg8::sigmoidf_fast(v.z); v.w = pg8::sigmoidf_fast(v.w); }
    st4bf(Z + (size_t)(ROW_META + r) * INW + c, v); } };
template <int ACT> struct MEpiPlain { bf16* O; int ldc; const float* rs; __device__ __forceinline__ void operator()(int r, int c, f32x4 v) const {
    if (ACT == 1) { v = v * rs[ROW_META + r]; v.x = fmaxf(v.x, 0.f); v.y = fmaxf(v.y, 0.f); v.z = fmaxf(v.z, 0.f); v.w = fmaxf(v.w, 0.f); v = v * v; }
    st4bf(O + (size_t)(ROW_META + r) * ldc + c, v); } };
template <bool ADD_PREV> struct MEpiGate { bf16* O; const bf16* Gt; const bf16* Pv; __device__ __forceinline__ void operator()(int r, int c, f32x4 v) const {
    const size_t row = (size_t)(ROW_META + r); v = v * ld4bf(Gt + row * INW + c);
    if (ADD_PREV) v = v + ld4bf(Pv + row * DM + c);
    st4bf(O + row * DM + c, v); } };

__device__ __forceinline__ int t5_bucket(int dist) {
    const int n = dist < 0 ? 0 : dist;
    if (n < 16) return n;
    int large = 16 + (int)(logf((float)n * (1.f / 16.f)) / 2.0794415416798357f * 16.f);
    return large > 31 ? 31 : large;
}

constexpr int LUTN_G = 448, N_LUT_TABLES = 40;
__device__ __forceinline__ void build_lut_tables(Frame& F, const float* __restrict__ relb, float* __restrict__ lutg) {
    for (int i = F.vcu * NWAVES * 64 + F.tid; i < N_LUT_TABLES * LUTN_G; i += F.G * NWAVES * 64) {
        const int tb = i / LUTN_G, d = 255 - (i % LUTN_G); float v;
        if (tb < 8) { if (d < 0) v = NEGBIG; else if (d < 128) v = (relb[t5_bucket(d) * NBIAS + tb] - relb[31 * NBIAS + tb]) * LOG2E; else v = 0.f; }
        else { const int col = 8 + ((tb - 8) >> 1), kind = (tb - 8) & 1;
            if (d < 0) v = NEGBIG; else if (d < 128) v = relb[t5_bucket(d) * NBIAS + col] * LOG2E; else v = kind ? relb[31 * NBIAS + col] * LOG2E : NEGBIG; }
        lutg[i] = v;
    }
}

#if ATTN_NAIVE
template <bool DIFF>
__global__ void __launch_bounds__(512) naive_attn(const bf16* __restrict__ Z, bf16* __restrict__ YAB, const float* __restrict__ relb, const float* lq1, const float* lk1, const float* lq2, const float* lk2,
                                                   const float* __restrict__ dnorm, const float* __restrict__ sinks, int layer) {
    constexpr int KT = 16, DVT = DIFF ? 64 : 32, KW = DIFF ? 128 : 64, VW = DIFF ? 128 : 64;
    extern __shared__ __attribute__((aligned(16))) unsigned char smem[];
    float* Ksh = (float*)smem;
    float* Vsh = Ksh + 32 * 128;
    float* biasL = Vsh + 32 * 128;
    int* kposs = (int*)(biasL + 2 * 132);
    float* red = (float*)(kposs + 64);
    float* Osh = red + 8;
    const int tid = threadIdx.x, row = tid & 127, cj = (tid >> 7) & 1, dvh = tid >> 8;
    const int unit = blockIdx.x, hh = unit / 129, qb = unit % 129;
    const bool metablk = (qb == 128);
    const int qrow = metablk ? ROW_META + row : 128 * qb + row;
    const int qpos = metablk ? 112 + row : 128 + 128 * qb + row;
    float lam = 0.f, lam_init = 0.f;
    if (DIFF) {
        lam_init = 0.8f - 0.6f * expf(-0.3f * (float)layer);
        if (tid < 64) { float a = lq1[layer * 64 + tid] * lk1[layer * 64 + tid], b = lq2[layer * 64 + tid] * lk2[layer * 64 + tid];
#pragma unroll
            for (int o = 1; o < 64; o <<= 1) { a += __shfl_xor(a, o); b += __shfl_xor(b, o); }
            if (tid == 0) { red[0] = a; red[1] = b; } }
    }
    for (int i = tid; i < 2 * 129; i += 512) { const int j = i / 129, d = i % 129; const int col = DIFF ? hh : 8 + 2 * hh + j; biasL[j * 132 + d] = relb[t5_bucket(d) * NBIAS + col] * LOG2E; }
    __syncthreads();
    if (DIFF) lam = expf(red[0]) - expf(red[1]) + lam_init;
    const int qcol = DIFF ? C_QA + hh * 128 + cj * 64 : C_QB + (2 * hh + cj) * 64;
    const int kcol = DIFF ? C_KA + hh * 128 : C_KB + (hh >> 2) * 64;
    const int vcol = DIFF ? C_VA + hh * 128 : C_VB + (hh >> 2) * 64;
    float q[64];
    { const bf16* qp = Z + (size_t)qrow * INW + qcol;
#pragma unroll
      for (int i = 0; i < 64; ++i) q[i] = pg8::bf_lo((unsigned)qp[i]); }
    float o[DVT];
#pragma unroll
    for (int i = 0; i < DVT; ++i) o[i] = 0.f;
    float m = NEGBIG, l = 0.f;
    if (!DIFF) { m = sinks[layer * 16 + 2 * hh + cj] * LOG2E; l = 1.f; }
    const int t_s = DIFF ? 0 : (qb >= 1 && !metablk ? 128 * (qb - 1) : 0);
    const int nreal = metablk ? 0 : 128 * qb + 128 - t_s;
    const int ns = 16 + nreal;
    const float* bl = biasL + (DIFF ? 0 : cj) * 132;
    for (int s0 = 0; s0 < ns; s0 += KT) {
        __syncthreads();
        for (int i = tid; i < KT * KW; i += 512) { const int kk = i / KW, c = i % KW, s = s0 + kk; float v = 0.f;
            if (s < ns) { const int krow = s < 16 ? ROW_META + s : t_s + s - 16; v = pg8::bf_lo((unsigned)Z[(size_t)krow * INW + kcol + c]); } Ksh[kk * 128 + c] = v; }
        for (int i = tid; i < KT * VW; i += 512) { const int kk = i / VW, c = i % VW, s = s0 + kk; float v = 0.f;
            if (s < ns) { const int krow = s < 16 ? ROW_META + s : t_s + s - 16; v = pg8::bf_lo((unsigned)Z[(size_t)krow * INW + vcol + c]); } Vsh[kk * 128 + c] = v; }
        if (tid < KT) { const int s = s0 + tid; kposs[tid] = s >= ns ? (1 << 30) : (s < 16 ? 112 + s : 128 + t_s + s - 16); kposs[32 + tid] = (s < 16) ? 1 : 0; }
        __syncthreads();
        float sc[KT]; float tmax = NEGBIG;
#pragma unroll
        for (int kk = 0; kk < KT; ++kk) {
            const float* kr = Ksh + kk * 128 + (DIFF ? cj * 64 : 0); float a = 0.f;
#pragma unroll
            for (int i = 0; i < 64; ++i) a += q[i] * kr[i];
            const int dist = qpos - kposs[kk]; const bool ismeta = kposs[32 + kk] != 0;
            bool ok = dist >= 0; if (!DIFF && !ismeta) ok = ok && dist < 128;
            const int di = dist < 0 ? 0 : (dist > 128 ? 128 : dist);
            a = ok ? a + bl[di] : NEGBIG;
            sc[kk] = a; tmax = fmaxf(tmax, a);
        }
        const float mn = fmaxf(m, tmax), alpha = exp2f(m - mn);
        l *= alpha;
#pragma unroll
        for (int i = 0; i < DVT; ++i) o[i] *= alpha;
        m = mn;
#pragma unroll
        for (int kk = 0; kk < KT; ++kk) {
            const float p = sc[kk] > -1e29f ? exp2f(sc[kk] - m) : 0.f;
            l += p; const float* vr = Vsh + kk * 128 + dvh * DVT;
#pragma unroll
            for (int i = 0; i < DVT; ++i) o[i] += p * vr[i];
        }
    }
    const float rl = 1.f / l;
    if (DIFF) {
        __syncthreads();
        if (cj == 1) {
#pragma unroll
            for (int i = 0; i < DVT; ++i) Osh[row * 129 + dvh * 64 + i] = lam * o[i] * rl; }
        __syncthreads();
        if (cj == 0) {
#pragma unroll
            for (int i = 0; i < DVT; ++i) Osh[row * 129 + dvh * 64 + i] = o[i] * rl - Osh[row * 129 + dvh * 64 + i]; }
        __syncthreads();
        if (tid < 128 && (!metablk || tid < 16)) {
            float ss = 0.f;
            for (int d = 0; d < 128; ++d) { const float v = Osh[tid * 129 + d]; ss += v * v; }
            const float rstd = 1.0f / sqrtf(ss * (1.f / 128.f) + EPS) * (1.f - lam_init);
            const int orow = metablk ? ROW_META + tid : 128 * qb + tid;
            for (int d = 0; d < 128; ++d) YAB[(size_t)orow * DM + hh * 128 + d] = (bf16)f2bf(Osh[tid * 129 + d] * rstd * dnorm[layer * 128 + d]);
        }
    } else {
        if (!metablk || row < 16) {
#pragma unroll
            for (int i = 0; i < DVT; ++i) YAB[(size_t)qrow * DM + 1024 + (2 * hh + cj) * 64 + dvh * 32 + i] = (bf16)f2bf(o[i] * rl); }
    }
}
constexpr int NAIVE_LDS = (32 * 128 * 2 + 2 * 132 + 64 + 8 + 128 * 129) * 4;
#endif

namespace att {
typedef float f32x16 __attribute__((ext_vector_type(16)));
typedef short s16x4 __attribute__((ext_vector_type(4)));
typedef short v4i16_t __attribute__((ext_vector_type(4)));
constexpr int LUTN = 448;
constexpr int SLOT = 16384, CK = 8704, KSLOT = 2 * CK, L_K = 0, L_V = 3 * KSLOT, L_LUT = L_V + 3 * SLOT, L_WSF = L_LUT + 4 * LUTN * 4, L_SUBG = L_WSF + 8 * 256, L_END = L_SUBG + 512;
static_assert(L_END <= RING_BYTES, "attention LDS");
constexpr int XD_STRIDE = 132, XS_STRIDE = 68;
constexpr float THR = 30.0f;
__device__ __forceinline__ int crow(int r, int hi) { return (r & 3) + 8 * (r >> 2) + 4 * hi; }
__device__ __forceinline__ void glds16(const void* gsrc, unsigned lds_dst) { unsigned keep;
    asm volatile("s_mov_b32 %0, m0\n\ts_mov_b32 m0, %2\n\ts_nop 0\n\tglobal_load_lds_dwordx4 %1, off\n\ts_mov_b32 m0, %0" : "=&s"(keep) : "v"(gsrc), "s"(lds_dst) : "memory"); }
template <int IMM> __device__ __forceinline__ void glds16s(const void* sbase, unsigned voff, unsigned lds_dst_) { const unsigned lds_dst = lds_dst_ - (unsigned)IMM;
    asm volatile("s_mov_b32 m0, %2\n\ts_nop 0\n\tglobal_load_lds_dwordx4 %0, %1 offset:%c3" :: "v"(voff), "s"(sbase), "s"(lds_dst), "i"(IMM) : "memory", "m0"); }
__device__ __forceinline__ unsigned cvtpk(float lo, float hi) { typedef float f2 __attribute__((ext_vector_type(2))); typedef __bf16 b2 __attribute__((ext_vector_type(2))); f2 v = {lo, hi}; b2 b = __builtin_convertvector(v, b2); return __builtin_bit_cast(unsigned, b); }
__device__ __forceinline__ s16x4 vtr(const LAS unsigned char* p) { return __builtin_bit_cast(s16x4, __builtin_amdgcn_ds_read_tr16_b64_v4i16((LAS v4i16_t*)p)); }
__device__ __forceinline__ float swap_add(float v) { auto rr = __builtin_amdgcn_permlane32_swap(__float_as_uint(v), __float_as_uint(v), false, false); return __uint_as_float(rr[0]) + __uint_as_float(rr[1]); }
__device__ __forceinline__ float swap_max(float v) { auto rr = __builtin_amdgcn_permlane32_swap(__float_as_uint(v), __float_as_uint(v), false, false); return fmaxf(__uint_as_float(rr[0]), __uint_as_float(rr[1])); }
#define ATT_MFMA(a, b, c) __builtin_amdgcn_mfma_f32_32x32x16_bf16(a, b, c, 0, 0, 0)

template <bool DIFF>
__device__ __forceinline__ void attn_epilogue(LAS unsigned char* lds, bf16* __restrict__ YAB, f32x16 (&o)[DIFF ? 4 : 2], float lsum, int tid, int hh, int qb, float lam, float lam_scale);
template <bool DIFF, bool FAST>
__device__ __forceinline__ bool attn_body(LAS unsigned char* lds, const bf16* __restrict__ Z, bf16* __restrict__ YAB, const float* __restrict__ lutg,
                                          int hh, int qb, float lam, float lam_scale, float sink2, int tid_in, unsigned useq) {
    constexpr int NDB = DIFF ? 4 : 2;
    constexpr bool fast = FAST;
    int tid = tid_in; asm volatile("" : "+v"(tid));
    const int lane = tid & 63, w = __builtin_amdgcn_readfirstlane(tid >> 6), cj = w >> 2, wq = w & 3, l31 = lane & 31, hi = lane >> 5;
    const bool metablk = (qb == 128);
    const int qrow = (metablk ? ROW_META : 128 * qb) + 32 * wq + l31;
    const int qpos = (metablk ? 112 : 128 + 128 * qb) + 32 * wq + l31;
    const int qcol = DIFF ? C_QA + hh * 128 + cj * 64 : C_QB + (2 * hh + cj) * 64;
    const int kcol = DIFF ? C_KA + hh * 128 : C_KB + (hh >> 2) * 64;
    const int vcol = DIFF ? C_VA + hh * 128 : C_VB + (hh >> 2) * 64;
    const int rt0 = DIFF ? 0 : (2 * qb - 2 > 0 ? 2 * qb - 2 : 0);
    const int nreal = metablk ? 0 : 2 * qb + 2 - rt0;
    const int NT = 1 + nreal;
    const int rt_special = 2 * qb - 2;
    LAS float* LUT = (LAS float*)(lds + L_LUT);
    if (DIFF) { if (tid < LUTN) LUT[tid] = lutg[hh * LUTN + tid]; }
    else { for (int i = tid; i < 4 * LUTN; i += NWAVES * 64) { const int k = i / LUTN, e = i % LUTN; LUT[i] = lutg[(8 + 2 * (2 * hh + (k & 1)) + (k >> 1)) * LUTN + e]; } }
    const unsigned lds0 = (unsigned)(uintptr_t)lds;
    auto tile_row0 = [&](int t) { return t == 0 ? ROW_META : 64 * (rt0 + t - 1); };
    const unsigned koff = (unsigned)(((8 * w + (lane >> 3)) * INW + kcol + ((lane & 7) ^ (lane >> 3)) * 8) * 2);
    const unsigned voff = (unsigned)(((8 * w + ((lane >> 2) & 7)) * INW + vcol + (lane >> 5) * 32 + (lane & 3) * 8) * 2);
    const unsigned kgb = (unsigned)(w * 1024 + 128 * ((w >> 1) & 1) + 256 * (w >> 2));
    auto dma_k = [&](int t, int sl) {
        const char* zb = (const char*)Z + (size_t)tile_row0(t) * (INW * 2);
        const unsigned dst = (unsigned)__builtin_amdgcn_readfirstlane(lds0 + L_K + sl + (sl >> 4) + kgb);
        glds16s<0>(zb, koff, dst);
        if (DIFF) glds16s<128>(zb, koff, dst + CK);
    };
    auto dma_v = [&](int t, int sl) {
        const char* zb = (const char*)Z + (size_t)tile_row0(t) * (INW * 2);
        const unsigned dst = (unsigned)__builtin_amdgcn_readfirstlane(lds0 + L_V + sl + w * 2048);
        glds16s<0>(zb, voff, dst);
        if (DIFF) glds16s<128>(zb, voff, dst + 1024);
    };
    bf16x8 qr[4];
#pragma unroll
    for (int d0 = 0; d0 < 4; ++d0) qr[d0] = *(const bf16x8*)(Z + (size_t)qrow * INW + qcol + d0 * 16 + hi * 8);
    dma_k(0, 0); dma_v(0, 0); if (NT > 1) dma_k(1, SLOT); if (NT > 2) dma_k(2, 2 * SLOT);
    bool mz = fast || DIFF || (fabsf(sink2) <= THR);
    float m = mz ? 0.f : sink2, lsum = (!DIFF && hi == 0) ? (mz ? __builtin_amdgcn_exp2f(sink2) : 1.f) : 0.f;
    f32x16 o[NDB];
#pragma unroll
    for (int db = 0; db < NDB; ++db) o[db] = f32x16{};
    float nm = -m;
    LAS float* wsf = (LAS float*)(lds + L_WSF) + w * 64;
    const int kr_ = l31 & 7, kg_ = l31 >> 3, kt_ = kr_ ^ hi;
    const LAS unsigned char* kp0 = lds + L_K + (DIFF ? cj * CK : 0) + kg_ * 1024 + 128 * ((kg_ >> 1) & 1) + 128 * kr_;
    const int kx0 = 16 * (0 ^ kt_), kx1 = 16 * (2 ^ kt_), kx2 = 16 * (4 ^ kt_), kx3 = 16 * (6 ^ kt_);
    const LAS unsigned char* vp0 = lds + L_V + ((lane >> 4) & 1) * 32 + (lane & 3) * 8 + (4 * hi + ((lane & 15) >> 2)) * 64;
    bf16x8 kf[8];
    f32x16 pA0, pA1, pB0, pB1;
    v4u pw0, pw1, pw2, pw3;
    bool resc = false;
    int sl_prev = 0, sl_cur = 0, sl_next = SLOT;
#define ATT_SBAR() __builtin_amdgcn_sched_barrier(0)
#define ATT_PIN(x) asm volatile("" : "+v"(x))
#define ATT_ROT() do { sl_prev = sl_cur; sl_cur = sl_next; sl_next = (sl_next == 2 * SLOT) ? 0 : sl_next + SLOT; } while (0)
#define ATT_WAITBAR(N) asm volatile("s_waitcnt vmcnt(" #N ") lgkmcnt(0)\n\ts_barrier" ::: "memory")
#define ATT_KLD2(kp, j) do { kf[2 * (j)] = *(const LAS bf16x8*)((kp) + kx##j); kf[2 * (j) + 1] = *(const LAS bf16x8*)((kp) + kx##j + 4352); } while (0)
#define ATT_SPECIAL(C0, C1, t) do { const int rt_ = rt0 + (t) - 1; \
        if ((t) == 0) { const LAS float* lut_ = DIFF ? LUT : LUT + (2 + cj) * LUTN; const int base_ = 255 - (qpos - 112 - 4 * hi); \
            _Pragma("unroll") for (int r = 0; r < 16; ++r) { \
                if (r < 8) { int idx_ = base_ + ((r & 3) + 8 * (r >> 2)); idx_ = idx_ < 0 ? 0 : (idx_ > LUTN - 1 ? LUTN - 1 : idx_); C0[r] += lut_[idx_]; } else C0[r] = nb_; \
                C1[r] = nb_; } } \
        else if (!DIFF || rt_ >= rt_special) { int base_ = 255 - (qpos - (128 + 64 * rt_) - 4 * hi); base_ = base_ < 0 ? 0 : (base_ > LUTN - 96 ? LUTN - 96 : base_); \
            const LAS float* lut_ = (DIFF ? LUT : LUT + cj * LUTN) + base_; \
            _Pragma("unroll") for (int r = 0; r < 16; ++r) { C0[r] += lut_[(r & 3) + 8 * (r >> 2)]; C1[r] += lut_[(r & 3) + 8 * (r >> 2) + 32]; } } } while (0)
#define ATT_ROWMAX(C0, C1, rm) do { float a_ = fmaxf(fmaxf(C0[0], C0[1]), C1[0]), b_ = fmaxf(fmaxf(C0[2], C0[3]), C1[1]); a_ = fmaxf(fmaxf(a_, C1[2]), C1[3]); \
        _Pragma("unroll") for (int r = 4; r < 16; r += 4) { a_ = fmaxf(fmaxf(a_, C0[r]), C0[r + 1]); b_ = fmaxf(fmaxf(b_, C0[r + 2]), C0[r + 3]); a_ = fmaxf(fmaxf(a_, C1[r]), C1[r + 1]); b_ = fmaxf(fmaxf(b_, C1[r + 2]), C1[r + 3]); } \
        rm = swap_max(fmaxf(a_, b_)); } while (0)
#define ATT_RESC() do { if (resc) { asm volatile("s_waitcnt lgkmcnt(0)" ::: "memory"); \
        _Pragma("unroll") for (int g = 0; g < 4; ++g) { const f32x4 fv_ = *(const LAS f32x4*)(wsf + 8 * g + 4 * hi); \
            _Pragma("unroll") for (int db = 0; db < NDB; ++db) { o[db][4 * g + 0] *= fv_.x; o[db][4 * g + 1] *= fv_.y; o[db][4 * g + 2] *= fv_.z; o[db][4 * g + 3] *= fv_.w; } } } } while (0)
#define ATT_PK(P, B) cvtpk(P[B], P[(B) + 1])
#define ATT_PAF(k) __builtin_bit_cast(bf16x8, pw##k)
    float nb_ = NEGBIG; asm volatile("" : "+v"(nb_));
    asm volatile("s_waitcnt vmcnt(0)" ::: "memory");
    asm volatile("s_waitcnt lgkmcnt(0)\n\ts_barrier" ::: "memory");
    {
        const LAS unsigned char* kp = kp0;
        ATT_KLD2(kp, 0); ATT_KLD2(kp, 1); ATT_KLD2(kp, 2); ATT_KLD2(kp, 3);
        if (mz) { pA0 = ATT_MFMA(kf[0], qr[0], f32x16{}); pA1 = ATT_MFMA(kf[1], qr[0], f32x16{}); }
        else {
#pragma unroll
            for (int r = 0; r < 16; ++r) { pA0[r] = nm; pA1[r] = nm; }
            pA0 = ATT_MFMA(kf[0], qr[0], pA0); pA1 = ATT_MFMA(kf[1], qr[0], pA1); }
#pragma unroll
        for (int d0 = 1; d0 < 4; ++d0) { pA0 = ATT_MFMA(kf[2 * d0], qr[d0], pA0); pA1 = ATT_MFMA(kf[2 * d0 + 1], qr[d0], pA1); }
        asm volatile("s_waitcnt lgkmcnt(0)\n\ts_barrier" ::: "memory");
        if (3 < NT) dma_k(3, 0);
        if (1 < NT) dma_v(1, SLOT);
        ATT_SPECIAL(pA0, pA1, 0);
        float rm = 0.f; if (!fast) ATT_ROWMAX(pA0, pA1, rm);
        if (!fast && __any(rm > THR || (DIFF && rm < -THR))) {
            const float dl = DIFF ? rm : fmaxf(rm, 0.f);
            m += dl; mz = false;
#pragma unroll
            for (int r = 0; r < 16; ++r) { pA0[r] -= dl; pA1[r] -= dl; }
            nm = -m;
            if (!DIFF) lsum *= __builtin_amdgcn_exp2f(-dl);
        }
#pragma unroll
        for (int r = 0; r < 16; ++r) { pA0[r] = __builtin_amdgcn_exp2f(pA0[r]); pA1[r] = __builtin_amdgcn_exp2f(pA1[r]); }
        if (1 < NT) { const LAS unsigned char* kn = kp0 + KSLOT; ATT_KLD2(kn, 0); ATT_KLD2(kn, 1); ATT_KLD2(kn, 2); ATT_KLD2(kn, 3); }
        if (3 < NT) { if (DIFF) ATT_WAITBAR(4); else ATT_WAITBAR(2); } else if (1 < NT) { if (DIFF) ATT_WAITBAR(2); else ATT_WAITBAR(1); } else ATT_WAITBAR(0);
        ATT_ROT();
    }
#define ATT_GAPA(MF, A0, A1, A2, A3, W0, W1, PW) do { MF; sacc += A0; sacc += A1; sacc += A2; sacc += A3; ATT_PIN(sacc); W0; W1; ATT_PIN(PW); ATT_SBAR(); } while (0)
#define ATT_VRD(i, off) do { vlo##i = vtr(vp_ + (off)); vhi##i = vtr(vp_ + (off) + 2048); } while (0)
#define ATT_VFR(i) (bf16x8){vlo##i[0], vlo##i[1], vlo##i[2], vlo##i[3], vhi##i[0], vhi##i[1], vhi##i[2], vhi##i[3]}
#define ATT_EX2(X, B) do { X[B] = __builtin_amdgcn_exp2f(X[B]); X[(B) + 1] = __builtin_amdgcn_exp2f(X[(B) + 1]); } while (0)
#define ATT_EXF(C0, C1, f) do { if ((f) < 16) C0[(f) & 15] = __builtin_amdgcn_exp2f(C0[(f) & 15]); else C1[(f) & 15] = __builtin_amdgcn_exp2f(C1[(f) & 15]); } while (0)
#define ATT_EX4(X, B) do { ATT_EX2(X, B); ATT_EX2(X, (B) + 2); } while (0)
#define ATT_VOFF(j) (DIFF ? ((4 * ((j) >> 2) + (((j) & 3) >> 1)) * 1024 + ((j) & 1) * 512) : (4 * ((j) >> 1) * 1024 + ((j) & 1) * 512))
#define ATT_PVD(j, R, RN, PWK, X, B) do { if ((j) + 3 < 16) ATT_VRD(RN, ATT_VOFF((j) + 3)); ATT_SBAR(); o[(j) & 3] = ATT_MFMA(ATT_PAF(PWK), ATT_VFR(R), o[(j) & 3]); ATT_EX2(X, B); ATT_PIN(X); ATT_SBAR(); } while (0)
#define ATT_PVS(j, R, RN, PWK, X, B) do { if ((j) + 3 < 8) ATT_VRD(RN, ATT_VOFF((j) + 3)); ATT_SBAR(); o[(j) & 1] = ATT_MFMA(ATT_PAF(PWK), ATT_VFR(R), o[(j) & 1]); ATT_EX4(X, B); ATT_PIN(X); ATT_SBAR(); } while (0)
#define ATT_KRD(G, j) do { if (G) { ATT_KLD2(kn_, j); ATT_SBAR(); } } while (0)
#define ATT_STEP(C0, C1, P0, P1, t, GK, GV) do { ATT_SBAR(); \
        const bool gk_ = (GK), gv_ = (GV); \
        float sacc = P0[0] + P0[1]; \
        if (mz) { C0 = ATT_MFMA(kf[0], qr[0], f32x16{}); C1 = ATT_MFMA(kf[1], qr[0], f32x16{}); } \
        else { _Pragma("unroll") for (int r = 0; r < 16; ++r) { C0[r] = nm; C1[r] = nm; } C0 = ATT_MFMA(kf[0], qr[0], C0); C1 = ATT_MFMA(kf[1], qr[0], C1); } \
        ATT_SBAR(); \
        ATT_GAPA((void)0, P0[2], P0[3], P0[4], P0[5],     pw0[0] = ATT_PK(P0, 0),  pw0[1] = ATT_PK(P0, 2),  pw0); \
        ATT_GAPA((void)0, P0[6], P0[7], P0[8], P0[9],     pw0[2] = ATT_PK(P0, 4),  pw0[3] = ATT_PK(P0, 6),  pw0); \
        ATT_GAPA(C0 = ATT_MFMA(kf[2], qr[1], C0),   P0[10], P0[11], P0[12], P0[13], pw1[0] = ATT_PK(P0, 8),  pw1[1] = ATT_PK(P0, 10), pw1); \
        ATT_GAPA(C1 = ATT_MFMA(kf[3], qr[1], C1),   P0[14], P0[15], P1[0], P1[1],   pw1[2] = ATT_PK(P0, 12), pw1[3] = ATT_PK(P0, 14), pw1); \
        ATT_GAPA(C0 = ATT_MFMA(kf[4], qr[2], C0),   P1[2], P1[3], P1[4], P1[5],     pw2[0] = ATT_PK(P1, 0),  pw2[1] = ATT_PK(P1, 2),  pw2); \
        ATT_GAPA(C1 = ATT_MFMA(kf[5], qr[2], C1),   P1[6], P1[7], P1[8], P1[9],     pw2[2] = ATT_PK(P1, 4),  pw2[3] = ATT_PK(P1, 6),  pw2); \
        ATT_GAPA(C0 = ATT_MFMA(kf[6], qr[3], C0),   P1[10], P1[11], P1[12], P1[13], pw3[0] = ATT_PK(P1, 8),  pw3[1] = ATT_PK(P1, 10), pw3); \
        ATT_GAPA(C1 = ATT_MFMA(kf[7], qr[3], C1),   P1[14], P1[15], 0.f, 0.f,       pw3[2] = ATT_PK(P1, 12), pw3[3] = ATT_PK(P1, 14), pw3); \
        lsum += sacc; \
        ATT_SBAR(); \
          \
        { const LAS unsigned char* vp_ = vp0 + sl_prev; const LAS unsigned char* kn_ = kp0 + sl_next + (sl_next >> 4); s16x4 vlo0, vhi0, vlo1, vhi1, vlo2, vhi2, vlo3, vhi3; float rm_ = 0.f; \
          ATT_VRD(0, ATT_VOFF(0)); ATT_VRD(1, ATT_VOFF(1)); ATT_VRD(2, ATT_VOFF(2)); \
          if (DIFF) { \
            ATT_VRD(3, ATT_VOFF(3)); ATT_SBAR(); o[0] = ATT_MFMA(ATT_PAF(0), ATT_VFR(0), o[0]); ATT_SBAR(); \
            if (gk_) dma_k((t) + 3, sl_cur); if (gv_) dma_v((t) + 1, sl_next); \
            ATT_VRD(0, ATT_VOFF(4)); ATT_SBAR(); o[1] = ATT_MFMA(ATT_PAF(0), ATT_VFR(1), o[1]); ATT_SBAR(); \
            ATT_SPECIAL(C0, C1, t); \
            ATT_VRD(1, ATT_VOFF(5)); ATT_SBAR(); o[2] = ATT_MFMA(ATT_PAF(0), ATT_VFR(2), o[2]); ATT_SBAR(); \
            if (!fast) ATT_ROWMAX(C0, C1, rm_); \
            ATT_VRD(2, ATT_VOFF(6)); ATT_SBAR(); o[3] = ATT_MFMA(ATT_PAF(0), ATT_VFR(3), o[3]); ATT_SBAR(); \
            { resc = false; \
              if (!fast && __builtin_expect(__any(rm_ > THR), 0)) { const float dl_ = fmaxf(rm_, 0.f); m += dl_; mz = false; \
                  _Pragma("unroll") for (int r = 0; r < 16; ++r) { C0[r] -= dl_; C1[r] -= dl_; } \
                  nm = -m; \
                  const float f_ = __builtin_amdgcn_exp2f(-dl_); lsum *= f_; if (hi == 0) wsf[l31] = f_; resc = true; } } \
            ATT_SBAR(); \
            ATT_KRD(gv_, 0); ATT_VRD(3, ATT_VOFF(7)); ATT_SBAR(); o[0] = ATT_MFMA(ATT_PAF(1), ATT_VFR(0), o[0]); ATT_SBAR(); ATT_EXF(C0, C1, 0); ATT_EXF(C0, C1, 1); ATT_EXF(C0, C1, 2); ATT_PIN(C0); ATT_PIN(C1); ATT_SBAR(); \
            ATT_KRD(gv_, 1); ATT_VRD(0, ATT_VOFF(8)); ATT_SBAR(); o[1] = ATT_MFMA(ATT_PAF(1), ATT_VFR(1), o[1]); ATT_SBAR(); ATT_EXF(C0, C1, 3); ATT_EXF(C0, C1, 4); ATT_EXF(C0, C1, 5); ATT_PIN(C0); ATT_PIN(C1); ATT_SBAR(); \
            ATT_KRD(gv_, 2); ATT_VRD(1, ATT_VOFF(9)); ATT_SBAR(); o[2] = ATT_MFMA(ATT_PAF(1), ATT_VFR(2), o[2]); ATT_SBAR(); ATT_EXF(C0, C1, 6); ATT_EXF(C0, C1, 7); ATT_EXF(C0, C1, 8); ATT_PIN(C0); ATT_PIN(C1); ATT_SBAR(); \
            ATT_KRD(gv_, 3); ATT_VRD(2, ATT_VOFF(10)); ATT_SBAR(); o[3] = ATT_MFMA(ATT_PAF(1), ATT_VFR(3), o[3]); ATT_SBAR(); ATT_EXF(C0, C1, 9); ATT_EXF(C0, C1, 10); ATT_EXF(C0, C1, 11); ATT_PIN(C0); ATT_PIN(C1); ATT_SBAR(); \
            ATT_VRD(3, ATT_VOFF(11)); ATT_SBAR(); o[0] = ATT_MFMA(ATT_PAF(2), ATT_VFR(0), o[0]); ATT_SBAR(); ATT_EXF(C0, C1, 12); ATT_EXF(C0, C1, 13); ATT_EXF(C0, C1, 14); ATT_PIN(C0); ATT_PIN(C1); ATT_SBAR(); \
            ATT_VRD(0, ATT_VOFF(12)); ATT_SBAR(); o[1] = ATT_MFMA(ATT_PAF(2), ATT_VFR(1), o[1]); ATT_SBAR(); ATT_EXF(C0, C1, 15); ATT_EXF(C0, C1, 16); ATT_EXF(C0, C1, 17); ATT_PIN(C0); ATT_PIN(C1); ATT_SBAR(); \
            ATT_VRD(1, ATT_VOFF(13)); ATT_SBAR(); o[2] = ATT_MFMA(ATT_PAF(2), ATT_VFR(2), o[2]); ATT_SBAR(); ATT_EXF(C0, C1, 18); ATT_EXF(C0, C1, 19); ATT_EXF(C0, C1, 20); ATT_PIN(C0); ATT_PIN(C1); ATT_SBAR(); \
            ATT_VRD(2, ATT_VOFF(14)); ATT_SBAR(); o[3] = ATT_MFMA(ATT_PAF(2), ATT_VFR(3), o[3]); ATT_SBAR(); ATT_EXF(C0, C1, 21); ATT_EXF(C0, C1, 22); ATT_EXF(C0, C1, 23); ATT_PIN(C0); ATT_PIN(C1); ATT_SBAR(); \
            ATT_VRD(3, ATT_VOFF(15)); ATT_SBAR(); o[0] = ATT_MFMA(ATT_PAF(3), ATT_VFR(0), o[0]); ATT_SBAR(); ATT_EXF(C0, C1, 24); ATT_EXF(C0, C1, 25); ATT_PIN(C0); ATT_PIN(C1); ATT_SBAR(); \
            ATT_SBAR(); o[1] = ATT_MFMA(ATT_PAF(3), ATT_VFR(1), o[1]); ATT_SBAR(); ATT_EXF(C0, C1, 26); ATT_EXF(C0, C1, 27); ATT_PIN(C0); ATT_PIN(C1); ATT_SBAR(); \
            ATT_SBAR(); o[2] = ATT_MFMA(ATT_PAF(3), ATT_VFR(2), o[2]); ATT_SBAR(); ATT_EXF(C0, C1, 28); ATT_EXF(C0, C1, 29); ATT_PIN(C0); ATT_PIN(C1); ATT_SBAR(); \
            ATT_SBAR(); o[3] = ATT_MFMA(ATT_PAF(3), ATT_VFR(3), o[3]); ATT_SBAR(); ATT_EXF(C0, C1, 30); ATT_EXF(C0, C1, 31); ATT_PIN(C0); ATT_PIN(C1); ATT_SBAR(); \
          } else { \
            ATT_VRD(3, ATT_VOFF(3)); ATT_SBAR(); o[0] = ATT_MFMA(ATT_PAF(0), ATT_VFR(0), o[0]); ATT_SBAR(); \
            if (gk_) dma_k((t) + 3, sl_cur); if (gv_) dma_v((t) + 1, sl_next); \
            ATT_SPECIAL(C0, C1, t); \
            ATT_VRD(0, ATT_VOFF(4)); ATT_SBAR(); o[1] = ATT_MFMA(ATT_PAF(0), ATT_VFR(1), o[1]); ATT_SBAR(); \
            if (!fast) ATT_ROWMAX(C0, C1, rm_); \
            { resc = false; \
              if (!fast && __builtin_expect(__any(rm_ > THR), 0)) { const float dl_ = fmaxf(rm_, 0.f); m += dl_; mz = false; \
                  _Pragma("unroll") for (int r = 0; r < 16; ++r) { C0[r] -= dl_; C1[r] -= dl_; } \
                  nm = -m; \
                  const float f_ = __builtin_amdgcn_exp2f(-dl_); lsum *= f_; if (hi == 0) wsf[l31] = f_; resc = true; } } \
            ATT_SBAR(); \
            ATT_KRD(gv_, 0); ATT_VRD(1, ATT_VOFF(5)); ATT_SBAR(); o[0] = ATT_MFMA(ATT_PAF(1), ATT_VFR(2), o[0]); ATT_SBAR(); ATT_EXF(C0, C1, 0); ATT_EXF(C0, C1, 1); ATT_EXF(C0, C1, 2); ATT_EXF(C0, C1, 3); ATT_EXF(C0, C1, 4); ATT_EXF(C0, C1, 5); ATT_PIN(C0); ATT_PIN(C1); ATT_SBAR(); \
            ATT_KRD(gv_, 1); ATT_VRD(2, ATT_VOFF(6)); ATT_SBAR(); o[1] = ATT_MFMA(ATT_PAF(1), ATT_VFR(3), o[1]); ATT_SBAR(); ATT_EXF(C0, C1, 6); ATT_EXF(C0, C1, 7); ATT_EXF(C0, C1, 8); ATT_EXF(C0, C1, 9); ATT_EXF(C0, C1, 10); ATT_EXF(C0, C1, 11); ATT_PIN(C0); ATT_PIN(C1); ATT_SBAR(); \
            ATT_KRD(gv_, 2); ATT_VRD(3, ATT_VOFF(7)); ATT_SBAR(); o[0] = ATT_MFMA(ATT_PAF(2), ATT_VFR(0), o[0]); ATT_SBAR(); ATT_EXF(C0, C1, 12); ATT_EXF(C0, C1, 13); ATT_EXF(C0, C1, 14); ATT_EXF(C0, C1, 15); ATT_EXF(C0, C1, 16); ATT_PIN(C0); ATT_PIN(C1); ATT_SBAR(); \
            ATT_KRD(gv_, 3); ATT_SBAR(); o[1] = ATT_MFMA(ATT_PAF(2), ATT_VFR(1), o[1]); ATT_SBAR(); ATT_EXF(C0, C1, 17); ATT_EXF(C0, C1, 18); ATT_EXF(C0, C1, 19); ATT_EXF(C0, C1, 20); ATT_EXF(C0, C1, 21); ATT_PIN(C0); ATT_PIN(C1); ATT_SBAR(); \
            ATT_SBAR(); o[0] = ATT_MFMA(ATT_PAF(3), ATT_VFR(2), o[0]); ATT_SBAR(); ATT_EXF(C0, C1, 22); ATT_EXF(C0, C1, 23); ATT_EXF(C0, C1, 24); ATT_EXF(C0, C1, 25); ATT_EXF(C0, C1, 26); ATT_PIN(C0); ATT_PIN(C1); ATT_SBAR(); \
            ATT_SBAR(); o[1] = ATT_MFMA(ATT_PAF(3), ATT_VFR(3), o[1]); ATT_SBAR(); ATT_EXF(C0, C1, 27); ATT_EXF(C0, C1, 28); ATT_EXF(C0, C1, 29); ATT_EXF(C0, C1, 30); ATT_EXF(C0, C1, 31); ATT_PIN(C0); ATT_PIN(C1); ATT_SBAR(); \
          } } \
        if (gk_) { if (DIFF) ATT_WAITBAR(4); else ATT_WAITBAR(2); } else if (gv_) { if (DIFF) ATT_WAITBAR(2); else ATT_WAITBAR(1); } else ATT_WAITBAR(0); \
        ATT_RESC(); ATT_ROT(); } while (0)
    int t = 1;
    if (fast) for (; t + 4 < NT; t += 2) { ATT_STEP(pB0, pB1, pA0, pA1, t, true, true); ATT_STEP(pA0, pA1, pB0, pB1, t + 1, true, true); }
    for (; t + 1 < NT; t += 2) { ATT_STEP(pB0, pB1, pA0, pA1, t, (t) + 3 < NT, (t) + 1 < NT); ATT_STEP(pA0, pA1, pB0, pB1, t + 1, (t) + 4 < NT, (t) + 2 < NT); }
    if (t < NT) {
        ATT_STEP(pB0, pB1, pA0, pA1, t, (t) + 3 < NT, (t) + 1 < NT);
#pragma unroll
        for (int r = 0; r < 16; ++r) { pA0[r] = pB0[r]; pA1[r] = pB1[r]; }
    }
    {
        float sacc = 0.f;
#pragma unroll
        for (int r = 0; r < 16; ++r) sacc += pA0[r] + pA1[r];
        lsum += sacc;
        pw0 = (v4u){ATT_PK(pA0, 0), ATT_PK(pA0, 2), ATT_PK(pA0, 4), ATT_PK(pA0, 6)}; pw1 = (v4u){ATT_PK(pA0, 8), ATT_PK(pA0, 10), ATT_PK(pA0, 12), ATT_PK(pA0, 14)};
        pw2 = (v4u){ATT_PK(pA1, 0), ATT_PK(pA1, 2), ATT_PK(pA1, 4), ATT_PK(pA1, 6)}; pw3 = (v4u){ATT_PK(pA1, 8), ATT_PK(pA1, 10), ATT_PK(pA1, 12), ATT_PK(pA1, 14)};
        const LAS unsigned char* vb = vp0 + sl_prev;
#pragma unroll
        for (int db = 0; db < NDB; ++db) {
#pragma unroll
            for (int ks = 0; ks < 4; ++ks) {
                const s16x4 lo = vtr(vb + (4 * ks + (db >> 1)) * 1024 + (db & 1) * 512), hh4 = vtr(vb + (4 * ks + (db >> 1)) * 1024 + (db & 1) * 512 + 2048);
                const bf16x8 vf = (bf16x8){lo[0], lo[1], lo[2], lo[3], hh4[0], hh4[1], hh4[2], hh4[3]};
                const v4u pk = ks == 0 ? pw0 : ks == 1 ? pw1 : ks == 2 ? pw2 : pw3;
                o[db] = ATT_MFMA(__builtin_bit_cast(bf16x8, pk), vf, o[db]);
            }
        }
    }
#undef ATT_SBAR
#undef ATT_PIN
#undef ATT_ROT
#undef ATT_WAITBAR
#undef ATT_KLD2
#undef ATT_SPECIAL
#undef ATT_ROWMAX
#undef ATT_RESC
#undef ATT_PK
#undef ATT_PAF
#undef ATT_GAPA
#undef ATT_VRD
#undef ATT_VFR
#undef ATT_EX2
#undef ATT_EX4
#undef ATT_EXF
#undef ATT_VOFF
#undef ATT_PVD
#undef ATT_PVS
#undef ATT_KRD
#undef ATT_STEP
    int tid2 = tid; asm volatile("" : "+v"(tid2));
    if (fast) {
        volatile LAS unsigned* retry_ = (volatile LAS unsigned*)(lds + MISC_OFF + 96);
        const int l31b = tid2 & 31, wqb = (tid2 >> 6) & 3;
        const float lt = swap_add(lsum);
        const bool bad = (!metablk || (wqb == 0 && l31b < 16)) && !(lt > 0x1p-100f && lt < 0x1p100f);
        if (__any(bad)) { if ((tid2 & 63) == 0) retry_[0] = useq; }
        asm volatile("s_waitcnt lgkmcnt(0)\n\ts_barrier" ::: "memory");
        if ((unsigned)__builtin_amdgcn_readfirstlane((int)retry_[0]) == useq) return true;
    }
    attn_epilogue<DIFF>(lds, YAB, o, lsum, tid2, hh, qb, lam, lam_scale);
    return false;
}
template <bool DIFF>
__device__ __forceinline__ void attn_unit(LAS unsigned char* lds, const bf16* __restrict__ Z, bf16* __restrict__ YAB, const float* __restrict__ lutg,
                                          int hh, int qb, float lam, float lam_scale, float sink2, int tid_in, unsigned useq) {
    if (attn_body<DIFF, true>(lds, Z, YAB, lutg, hh, qb, lam, lam_scale, sink2, tid_in, useq))
        (void)attn_body<DIFF, false>(lds, Z, YAB, lutg, hh, qb, lam, lam_scale, sink2, tid_in, useq);
}
template <bool DIFF>
__device__ __forceinline__ void attn_epilogue(LAS unsigned char* lds, bf16* __restrict__ YAB, att::f32x16 (&o)[DIFF ? 4 : 2], float lsum, int tid, int hh, int qb, float lam, float lam_scale) {
    constexpr int NDB = DIFF ? 4 : 2;
    const int lane = tid & 63, w = __builtin_amdgcn_readfirstlane(tid >> 6), cj = w >> 2, wq = w & 3, l31 = lane & 31, hi = lane >> 5;
    const bool metablk = (qb == 128);
    const int qrow = (metablk ? ROW_META : 128 * qb) + 32 * wq + l31;
    LAS float* wsf = (LAS float*)(lds + L_WSF) + w * 64;
    const float ltot = swap_add(lsum);
    float sc = 1.0f / ltot; if (DIFF && cj == 1) sc *= lam;
    if (hi == 0) wsf[l31] = sc;
    asm volatile("s_waitcnt lgkmcnt(0)" ::: "memory");
#pragma unroll
    for (int g = 0; g < 4; ++g) { const f32x4 fv = *(const LAS f32x4*)(wsf + 8 * g + 4 * hi);
#pragma unroll
        for (int db = 0; db < NDB; ++db) { o[db][4 * g + 0] *= fv.x; o[db][4 * g + 1] *= fv.y; o[db][4 * g + 2] *= fv.z; o[db][4 * g + 3] *= fv.w; } }
    asm volatile("s_waitcnt lgkmcnt(0)\n\ts_barrier" ::: "memory");
    const bool store_ok = !metablk || (wq == 0 && l31 < 16);
    if (DIFF) {
        LAS float* X = (LAS float*)lds + wq * 32 * XD_STRIDE;
        if (cj == 1) {
#pragma unroll
            for (int db = 0; db < NDB; ++db)
#pragma unroll
                for (int r = 0; r < 16; ++r) X[crow(r, hi) * XD_STRIDE + 32 * db + l31] = o[db][r];
        }
        asm volatile("s_waitcnt lgkmcnt(0)\n\ts_barrier" ::: "memory");
        if (cj == 0) {
#pragma unroll
            for (int db = 0; db < NDB; ++db)
#pragma unroll
                for (int r = 0; r < 16; ++r) { LAS float* xp = X + crow(r, hi) * XD_STRIDE + 32 * db + l31; *xp = o[db][r] - *xp; }
            asm volatile("s_waitcnt lgkmcnt(0)" ::: "memory");
            const LAS float* xr = X + l31 * XD_STRIDE + 64 * hi; const LAS float* sg = (const LAS float*)(lds + L_SUBG) + 64 * hi;
            f32x4 xv[16]; float ss = 0.f;
#pragma unroll
            for (int i = 0; i < 16; ++i) { xv[i] = *(const LAS f32x4*)(xr + 4 * i); ss += (xv[i].x * xv[i].x + xv[i].y * xv[i].y) + (xv[i].z * xv[i].z + xv[i].w * xv[i].w); }
            ss = swap_add(ss);
            const float rstd = lam_scale / sqrtf(ss * (1.f / 128.f) + EPS);
            if (store_ok) {
                bf16* op = YAB + (size_t)qrow * DM + hh * 128 + 64 * hi;
#pragma unroll
                for (int k = 0; k < 8; ++k) { const f32x4 g0 = *(const LAS f32x4*)(sg + 8 * k), g1 = *(const LAS f32x4*)(sg + 8 * k + 4); const f32x4 a = xv[2 * k], b = xv[2 * k + 1];
                    v4u ov; ov.x = cvtpk(a.x * rstd * g0.x, a.y * rstd * g0.y); ov.y = cvtpk(a.z * rstd * g0.z, a.w * rstd * g0.w); ov.z = cvtpk(b.x * rstd * g1.x, b.y * rstd * g1.y); ov.w = cvtpk(b.z * rstd * g1.z, b.w * rstd * g1.w);
                    *(GAS v4u*)(op + 8 * k) = ov; }
            }
        }
    } else {
        LAS float* X = (LAS float*)lds + w * 32 * XS_STRIDE;
#pragma unroll
        for (int db = 0; db < NDB; ++db)
#pragma unroll
            for (int r = 0; r < 16; ++r) X[crow(r, hi) * XS_STRIDE + 32 * db + l31] = o[db][r];
        asm volatile("s_waitcnt lgkmcnt(0)" ::: "memory");
        const LAS float* xr = X + l31 * XS_STRIDE + 32 * hi;
        if (store_ok) {
            bf16* op = YAB + (size_t)qrow * DM + 1024 + (2 * hh + cj) * 64 + 32 * hi;
#pragma unroll
            for (int k = 0; k < 4; ++k) { const f32x4 a = *(const LAS f32x4*)(xr + 8 * k), b = *(const LAS f32x4*)(xr + 8 * k + 4);
                v4u ov; ov.x = cvtpk(a.x, a.y); ov.y = cvtpk(a.z, a.w); ov.z = cvtpk(b.x, b.y); ov.w = cvtpk(b.z, b.w);
                *(GAS v4u*)(op + 8 * k) = ov; }
        }
    }
    asm volatile("s_waitcnt lgkmcnt(0)\n\ts_barrier" ::: "memory");
}

__device__ __forceinline__ void attn_phase(Frame& F, const bf16* Z, bf16* YAB, CPtrs PP, int layer, int bx) {
    const int tid = F.tid;
    asm volatile("" : "+s"(Z), "+s"(YAB));
    const int lane = tid & 63;
    auto uni = [](float v) { return __builtin_bit_cast(float, __builtin_amdgcn_readfirstlane(__builtin_bit_cast(int, v))); };
    const float lam_init = uni(0.8f - 0.6f * expf(-0.3f * (float)layer));
    asm volatile("" : "+s"(PP));
    const float lam = uni(expf(wave_sum(PP->lq1[layer * 64 + lane] * PP->lk1[layer * 64 + lane])) - expf(wave_sum(PP->lq2[layer * 64 + lane] * PP->lk2[layer * 64 + lane])) + lam_init);
    if (tid < 128) ((LAS float*)(F.lds + L_SUBG))[tid] = PP->dnorm[layer * 128 + tid];
    const float* relb = (const float*)(PP->ws + WS_LUTG); const float* sinks = PP->sinks;
    __syncthreads();
    const int w = __builtin_amdgcn_readfirstlane(tid >> 6);
    const bool deal256 = (F.G == 256);
    unsigned useq = (unsigned)layer * 4096u;
    for (int it = F.vcu; it < 512; it += F.G) {
        for (int sub = 0; sub < 2; ++sub) { const int s = it & 63; attn_unit<true>(F.lds, Z, YAB, relb, it >> 6, sub ? s : 127 - s, lam, 1.f - lam_init, 0.f, tid, ++useq); }
    }
    constexpr int EH = 302;
    const int e0 = deal256 ? (bx < 128 ? bx : EH + (bx - 128)) : F.vcu, estep = deal256 ? 128 : F.G, elim = (deal256 && bx < 128) ? EH : 1040;
    const bool last_layer = (layer == DEPTH - 1);
    for (int e = e0; e < elim; e += estep) {
        if (last_layer && (e >= 1032 || (e % 129) == 128)) continue;
        if (e < 1032) attn_unit<false>(F.lds, Z, YAB, relb, e / 129, e % 129, 0.f, 0.f, uni(sinks[layer * 16 + 2 * (e / 129) + (w >> 2)] * LOG2E), tid, ++useq);
        else attn_unit<true>(F.lds, Z, YAB, relb, e - 1032, 128, lam, 1.f - lam_init, 0.f, tid, ++useq);
    }
}
#undef ATT_MFMA
}

#ifndef FFN_SPLIT_N
#define FFN_SPLIT_N 2
#endif
constexpr int FFN_SPLIT = ONE_LAUNCH ? FFN_SPLIT_N : 1;
constexpr int NT_IN_A = 19;
constexpr int PH_PER_LAYER = 9, N_PHASES = 1 + DEPTH * PH_PER_LAYER;
struct Args { Ptrs p; int ph_lo, ph_hi; };

__global__ void __launch_bounds__(NWAVES * 64, 2) fwd_kernel(Args args) {
    extern __shared__ __attribute__((aligned(16))) unsigned char lds[];
    Frame F;
    F.lds = (LAS unsigned char*)lds;
    F.MISC = (volatile LAS unsigned*)(F.lds + MISC_OFF);
    F.tid = threadIdx.x; F.lane = F.tid & 63; F.wave = __builtin_amdgcn_readfirstlane(F.tid >> 6);
    F.G = gridDim.x; { const int bx = blockIdx.x; F.vcu = (F.G % 8 == 0) ? (bx % 8) * (F.G / 8) + bx / 8 : bx; }
    CPtrs PP = (CPtrs)__builtin_amdgcn_kernarg_segment_ptr();
#define LDP(field) ({ CPtrs q_ = PP; asm volatile("" : "+s"(q_)); q_->field; })
#define WSP(off) ({ unsigned char* w_ = LDP(ws); (bf16*)(w_ + (off)); })
    F.ctl = (gu32*)(LDP(ws) + WS_CTL);
    for (int u = F.tid; u < (LDS_BYTES - LDSCTL_OFF) / 4; u += NWAVES * 64) ((LAS unsigned*)(F.lds + LDSCTL_OFF))[u] = 0u;
    __syncthreads();
    const int lo = args.ph_lo, hi = args.ph_hi;
    const bool multi = (hi - lo) > 1;
    XcdBarrier bar; bar.bar = (unsigned*)(F.ctl + CW_BAR); bar.x = 0; bar.st = nullptr;
    if (multi) bar = xcd_barrier_post((unsigned*)(F.ctl + CW_BAR), F.MISC + 8);
#define IN(k) (lo <= (k) && (k) < hi)
#define SEAM(k) do { if (IN(k) && IN((k) + 1)) { xcd_barrier(bar); if (NREP(10) == 2) xcd_barrier(bar); } } while (0)

#define RSP ((float*)(LDP(ws) + WS_HMETA))

    if (IN(0)) {
        gate_colmax_pass(F, LDP(w_in), LDP(n_attn_pre), (unsigned*)(F.ctl + CW_CMAX));
        if (multi) xcd_barrier(bar);
        p0_transposes(F, PP);
        gate_quant_pass(F, LDP(w_in), LDP(n_attn_pre), (signed char*)(LDP(ws) + WS_WQ), (const unsigned*)(F.ctl + CW_CMAX), (float*)(LDP(ws) + WS_CS));
        build_lut_tables(F, LDP(relb), (float*)(LDP(ws) + WS_LUTG));
        __syncthreads();
        resid_phase<0>(F, LDP(x), LDP(meta), WSP(WS_U), RSP, nullptr, nullptr, nullptr, (signed char*)(LDP(ws) + WS_HQ), (float*)(LDP(ws) + WS_QS));
        SEAM(0);
    }
    for (int l = 0; l < DEPTH; ++l) {
        const int pb = 1 + PH_PER_LAYER * l;
        if (pb + PH_PER_LAYER <= lo || pb >= hi) continue;
#define FRESH(Fs) Frame Fs = F; asm volatile("" : "+s"(Fs.vcu), "+s"(Fs.G), "+s"(Fs.wave), "+v"(Fs.tid)); Fs.lane = Fs.tid & 63; int bx_ = blockIdx.x; asm volatile("" : "+s"(bx_))
#define OPQ(p) asm volatile("" : "+s"(p))
        if (IN(pb + 0)) {
            for (int rep = 0; rep < NREP(0); ++rep) {
            const bf16* A_ = WSP(WS_U); const bf16* B_ = WSP(WS_WIN) + (size_t)l * INW * DM; bf16* O_ = WSP(WS_Z); OPQ(A_); OPQ(B_); OPQ(O_);
            FRESH(Fs); for (int mrep = 0; mrep < NREP(11); ++mrep) meta_gemm(Fs.lds, A_ + (size_t)ROW_META * DM, DM, B_, DM, INW, DM, Fs.vcu, Fs.G, Fs.tid, MEpiZ{O_, RSP});
            {
            pg8::Gemm g{A_, B_, SEQ, 8 * 256, DM, DM, DM}; pg8::StaticOrder S; S.init(SEQ, 8 * 256, Fs.G, bx_);
            pg8::EpiZ E{O_, INW, RSP, 0};
            pg8::gemm_phase<pg8::EpiZ, pg8::StaticOrder, true>(F.lds + RING_OFF, g, S, E); }
            {
            const bf16* B2_ = B_ + (size_t)12 * 256 * DM; OPQ(B2_);
            pg8::Gemm g{A_, B2_, SEQ, 5 * 256, DM, DM, DM}; pg8::StaticOrder S; S.init(SEQ, 5 * 256, Fs.G, bx_);
            pg8::EpiZ E{O_, INW, RSP, 12};
            pg8::gemm_phase<pg8::EpiZ, pg8::StaticOrder, true>(F.lds + RING_OFF, g, S, E); }
            if (Fs.G != 256 || bx_ >= 64) {
                const bf16* AQ_ = WSP(WS_HQ); const bf16* BQ_ = (const bf16*)(LDP(ws) + WS_WQ + (size_t)l * NQ * DM); const float* QS_ = (const float*)(LDP(ws) + WS_QS); const float* CS_ = (const float*)(LDP(ws) + WS_CS) + l * NQ; OPQ(AQ_); OPQ(BQ_); OPQ(QS_); OPQ(CS_);
                pg8::Gemm gq{AQ_, BQ_, SEQ, 6 * 256, 1024, 1024, 1024}; pg8::StaticOrder Sq; if (Fs.G == 256) Sq.init(SEQ, 6 * 256, 192, bx_ - 64); else Sq.init(SEQ, 6 * 256, Fs.G, bx_);
                pg8::EpiZ Eq{O_, INW, QS_, 8, CS_, 4, 5};
                pg8::gemm_phase<pg8::EpiZ, pg8::StaticOrder, true, true>(F.lds + RING_OFF, gq, Sq, Eq);
            }
            }
            SEAM(pb + 0);
        }
        if (IN(pb + 1)) {
#if !ATTN_NAIVE
            for (int rep = 0; rep < NREP(1); ++rep) { FRESH(Fs);
                att::attn_phase(Fs, WSP(WS_Z), WSP(WS_YAB), PP, l, bx_);
                {
                    constexpr int QR0 = 6 * 256;
                    const bf16* AQ_ = WSP(WS_HQ); const bf16* BQ_ = (const bf16*)(LDP(ws) + WS_WQ + ((size_t)l * NQ + QR0) * DM); bf16* O_ = WSP(WS_Z); const float* QS_ = (const float*)(LDP(ws) + WS_QS); const float* CS_ = (const float*)(LDP(ws) + WS_CS) + l * NQ + QR0; OPQ(AQ_); OPQ(BQ_); OPQ(O_); OPQ(QS_); OPQ(CS_);
                    pg8::Gemm gq{AQ_, BQ_, SEQ, 14 * 256, 1024, 1024, 1024}; pg8::StaticOrder Sq; Sq.init(SEQ, 14 * 256, Fs.G, bx_);
                    pg8::EpiZ Eq{O_, INW, QS_, 19, CS_};
                    pg8::gemm_phase<pg8::EpiZ, pg8::StaticOrder, true, true>(F.lds + RING_OFF, gq, Sq, Eq);
                } }
#endif
            SEAM(pb + 1);
        }
        if (IN(pb + 2)) {
            for (int rep = 0; rep < NREP(2); ++rep) {
            const bf16* A_ = WSP(WS_YAB); const bf16* B_ = WSP(WS_WA) + (size_t)l * DM * 1024; bf16* O_ = WSP(WS_T); const bf16* G_ = WSP(WS_Z) + C_GA; OPQ(A_); OPQ(B_); OPQ(O_); OPQ(G_);
            FRESH(Fs); if (l + 1 < DEPTH) for (int mrep = 0; mrep < NREP(11); ++mrep) meta_gemm(Fs.lds, A_ + (size_t)ROW_META * DM, DM, B_, 1024, DM, 1024, Fs.vcu, Fs.G, Fs.tid, MEpiGate<false>{O_, G_, O_});
            pg8::Gemm g{A_, B_, SEQ, DM, 1024, DM, 1024}; pg8::StaticOrder S; S.init(SEQ, DM, Fs.G, bx_);
            pg8::EpiGate<false> E{O_, DM, G_, INW, O_};
            pg8::gemm_phase<pg8::EpiGate<false>, pg8::StaticOrder, true>(F.lds + RING_OFF, g, S, E);
            }
            SEAM(pb + 2);
        }
        if (IN(pb + 3)) {
            for (int rep = 0; rep < NREP(3); ++rep) {
            const bf16* A_ = WSP(WS_YAB) + 1024; const bf16* B_ = WSP(WS_WB) + (size_t)l * DM * 1024; bf16* O_ = WSP(WS_MIX); const bf16* G_ = WSP(WS_Z) + C_GB; const bf16* P_ = WSP(WS_T); OPQ(A_); OPQ(B_); OPQ(O_); OPQ(G_); OPQ(P_);
            FRESH(Fs); if (l + 1 < DEPTH) for (int mrep = 0; mrep < NREP(11); ++mrep) meta_gemm(Fs.lds, A_ + (size_t)ROW_META * DM, DM, B_, 1024, DM, 1024, Fs.vcu, Fs.G, Fs.tid, MEpiGate<true>{O_, G_, P_});
            pg8::Gemm g{A_, B_, SEQ, DM, 1024, DM, 1024}; pg8::StaticOrder S; S.init(SEQ, DM, Fs.G, bx_);
            pg8::EpiGate<true> E{O_, DM, G_, INW, P_};
            pg8::gemm_phase<pg8::EpiGate<true>, pg8::StaticOrder, true>(F.lds + RING_OFF, g, S, E);
            }
            SEAM(pb + 3);
        }
        if (IN(pb + 4)) {
            for (int rep = 0; rep < NREP(4); ++rep) {
            const bf16* A_ = WSP(WS_MIX); const bf16* B_ = WSP(WS_WOUT) + (size_t)l * DM * DM; bf16* O_ = WSP(WS_T); OPQ(A_); OPQ(B_); OPQ(O_);
            FRESH(Fs); if (l + 1 < DEPTH) for (int mrep = 0; mrep < NREP(11); ++mrep) meta_gemm(Fs.lds, A_ + (size_t)ROW_META * DM, DM, B_, DM, DM, DM, Fs.vcu, Fs.G, Fs.tid, MEpiPlain<0>{O_, DM, nullptr});
            pg8::Gemm g{A_, B_, SEQ, DM, DM, DM, DM}; pg8::StaticOrder S; S.init(SEQ, DM, Fs.G, bx_);
            pg8::EpiBf16<0> E{O_, DM, nullptr};
            pg8::gemm_phase<pg8::EpiBf16<0>, pg8::StaticOrder, true>(F.lds + RING_OFF, g, S, E);
            }
            SEAM(pb + 4);
        }
        if (IN(pb + 5)) {
            for (int rep = 0; rep < ((l == 0) ? NREP(5) : 1); ++rep) {
            FRESH(Fs); resid_phase<1>(Fs, nullptr, nullptr, WSP(WS_U), RSP, WSP(WS_T), LDP(n_attn_post) + l * DM, nullptr);
            }
            SEAM(pb + 5);
        }
        if (IN(pb + 6) || IN(pb + 7)) {
            constexpr int PROWS = SEQ / FFN_SPLIT;
            for (int part = 0; part < FFN_SPLIT; ++part) {
                if (IN(pb + 6)) {
                    for (int rep = 0; rep < NREP(6); ++rep) {
                    const bf16* A_ = WSP(WS_U); const bf16* B_ = WSP(WS_W1) + (size_t)l * DFF * DM; bf16* O_ = WSP(WS_Z); const float* R_ = RSP; OPQ(A_); OPQ(B_); OPQ(O_); OPQ(R_);
                    FRESH(Fs); if (l + 1 < DEPTH && part == 0) for (int mrep = 0; mrep < NREP(11); ++mrep) meta_gemm(Fs.lds, A_ + (size_t)ROW_META * DM, DM, B_, DM, DFF, DM, Fs.vcu, Fs.G, Fs.tid, MEpiPlain<1>{O_, DFF, R_});
                    pg8::Gemm g{A_ + (size_t)part * PROWS * DM, B_, PROWS, DFF, DM, DM, DM}; pg8::StaticOrder S; S.init(PROWS, DFF, Fs.G, bx_);
                    pg8::EpiBf16<1> E{O_ + (size_t)part * PROWS * DFF, DFF, R_ + part * PROWS};
                    pg8::gemm_phase<pg8::EpiBf16<1>, pg8::StaticOrder, true>(F.lds + RING_OFF, g, S, E);
                    }
                    if (IN(pb + 7) && multi) xcd_barrier(bar);
                }
                if (IN(pb + 7)) {
                    for (int rep = 0; rep < NREP(7); ++rep) {
                    const bf16* A_ = WSP(WS_Z); const bf16* B_ = WSP(WS_W2) + (size_t)l * DM * DFF; bf16* O_ = WSP(WS_T); OPQ(A_); OPQ(B_); OPQ(O_);
                    FRESH(Fs); if (l + 1 < DEPTH && part == 0) for (int mrep = 0; mrep < NREP(11); ++mrep) meta_gemm(Fs.lds, A_ + (size_t)ROW_META * DFF, DFF, B_, DFF, DM, DFF, Fs.vcu, Fs.G, Fs.tid, MEpiPlain<0>{O_, DM, nullptr});
                    pg8::Gemm g{A_ + (size_t)part * PROWS * DFF, B_, PROWS, DM, DFF, DFF, DFF}; pg8::StaticOrder S; S.init(PROWS, DM, Fs.G, bx_);
                    pg8::EpiBf16<0> E{O_ + (size_t)part * PROWS * DM, DM, nullptr};
                    pg8::gemm_phase<pg8::EpiBf16<0>, pg8::StaticOrder, true>(F.lds + RING_OFF, g, S, E);
                    }
                    if (part + 1 < FFN_SPLIT && IN(pb + 6) && multi) xcd_barrier(bar);
                }
            }
            SEAM(pb + 7);
        }
        if (IN(pb + 8)) {
            FRESH(Fs);
            if (l + 1 < DEPTH) resid_phase<1>(Fs, nullptr, nullptr, WSP(WS_U), RSP, WSP(WS_T), LDP(n_ff_post) + l * DM, nullptr, (signed char*)(LDP(ws) + WS_HQ), (float*)(LDP(ws) + WS_QS));
            else resid_phase<2>(Fs, nullptr, nullptr, WSP(WS_U), RSP, WSP(WS_T), LDP(n_ff_post) + l * DM, LDP(out));
            SEAM(pb + 8);
        }
    }
#undef OPQ
#undef FRESH
#undef LDP
#undef WSP
#undef RSP
#undef IN
#undef SEAM
}

extern "C" void kernel_launch(void* const* d_in, const int* in_sizes, int n_in, void* d_out, int out_size, void* d_ws, size_t ws_size, hipStream_t stream) {
    static int grid = 0;
    if (grid == 0) {
        if (n_in != 19 || in_sizes[0] != SEQ * DM || out_size != SEQ * DM || ws_size < WS_END) { fprintf(stderr, "kernel_launch: unexpected shapes (n_in %d, ws %zu)\n", n_in, ws_size); grid = -1; return; }
        int dev = 0, cus = 0;
        if (hipGetDevice(&dev) != hipSuccess || hipDeviceGetAttribute(&cus, hipDeviceAttributeMultiprocessorCount, dev) != hipSuccess) { grid = -1; return; }
        if (hipFuncSetAttribute((const void*)fwd_kernel, hipFuncAttributeMaxDynamicSharedMemorySize, LDS_BYTES) != hipSuccess) { grid = -1; return; }
#if ATTN_NAIVE
        (void)hipFuncSetAttribute((const void*)naive_attn<true>, hipFuncAttributeMaxDynamicSharedMemorySize, NAIVE_LDS);
        (void)hipFuncSetAttribute((const void*)naive_attn<false>, hipFuncAttributeMaxDynamicSharedMemorySize, NAIVE_LDS);
#endif
        int per_cu = 0;
        (void)hipOccupancyMaxActiveBlocksPerMultiprocessor(&per_cu, (const void*)fwd_kernel, NWAVES * 64, LDS_BYTES);
        (void)hipGetLastError();
        grid = cus;
    }
    if (grid < 0) return;
    if (hipMemsetAsync((char*)d_ws + WS_CTL, 0, CTL_ZERO_BYTES, stream) != hipSuccess) return;
    Args a{};
    a.p.x = (const float*)d_in[0]; a.p.meta = (const float*)d_in[1]; a.p.relb = (const float*)d_in[2]; a.p.w_in = (const float*)d_in[3]; a.p.w_a = (const float*)d_in[4];
    a.p.w_b = (const float*)d_in[5]; a.p.w_out = (const float*)d_in[6]; a.p.lq1 = (const float*)d_in[7]; a.p.lk1 = (const float*)d_in[8]; a.p.lq2 = (const float*)d_in[9];
    a.p.lk2 = (const float*)d_in[10]; a.p.dnorm = (const float*)d_in[11]; a.p.sinks = (const float*)d_in[12]; a.p.n_attn_pre = (const float*)d_in[13]; a.p.n_attn_post = (const float*)d_in[14];
    a.p.w_ff1 = (const float*)d_in[15]; a.p.w_ff2 = (const float*)d_in[16]; a.p.n_ff_pre = (const float*)d_in[17]; a.p.n_ff_post = (const float*)d_in[18];
    a.p.out = (float*)d_out; a.p.ws = (unsigned char*)d_ws;
#if ONE_LAUNCH
    a.ph_lo = 0; a.ph_hi = N_PHASES;
    hipLaunchKernelGGL(fwd_kernel, dim3(grid), dim3(NWAVES * 64), LDS_BYTES, stream, a);
#else
    for (int ph = 0; ph < N_PHASES; ++ph) {
        const int l = (ph - 1) / PH_PER_LAYER, i = (ph - 1) % PH_PER_LAYER;
#if ATTN_NAIVE
        if (ph >= 1 && i == 1) {
            const bf16* Z = (const bf16*)((unsigned char*)d_ws + WS_Z); bf16* YAB = (bf16*)((unsigned char*)d_ws + WS_YAB);
            hipLaunchKernelGGL(naive_attn<true>, dim3(8 * 129), dim3(512), NAIVE_LDS, stream, Z, YAB, a.p.relb, a.p.lq1, a.p.lk1, a.p.lq2, a.p.lk2, a.p.dnorm, a.p.sinks, l);
            hipLaunchKernelGGL(naive_attn<false>, dim3(8 * 129), dim3(512), NAIVE_LDS, stream, Z, YAB, a.p.relb, a.p.lq1, a.p.lk1, a.p.lq2, a.p.lk2, a.p.dnorm, a.p.sinks, l);
            continue;
        }
#endif
        a.ph_lo = ph; a.ph_hi = ph + 1;
        hipLaunchKernelGGL(fwd_kernel, dim3(grid), dim3(NWAVES * 64), LDS_BYTES, stream, a);
    }
#endif
    (void)hipPeekAtLastError();
}
```
